# Optimizing an MI355X kernel written in HIP

```python
import jax, jax.numpy as jnp
from jax import lax
import numpy as np

D_MODEL = 1024
BATCH = 8
SEQ = 2048
DEPTH = 4
DEC_BATCH = 128
DEC_SEQ = 4
PAST_LEN = 16384
PAGE_SIZE = 128

A_HEADS = 4
A_DK = D_MODEL // A_HEADS
A_DV = D_MODEL // A_HEADS
A_WIDTH = A_HEADS * A_DV
A_CHUNK = 128
B_WIDTH = D_MODEL
B_GROUPS = 4
B_CHUNK = 128
C_WIDTH = D_MODEL
C_BLOCKS = 8
C_BLK = C_WIDTH // C_BLOCKS
CONV_W = 4
LRU_C = 8.0
N_BRANCH = 3
ALPHA = float((2 * DEPTH) ** 0.25)
BETA = float((8 * DEPTH) ** -0.25)
LN_EPS = 1e-5
IN_WIDTH = 5 * A_WIDTH + 2 * A_HEADS + 3 * B_WIDTH + 2 * C_WIDTH + N_BRANCH * D_MODEL
F_OFF = 5 * A_WIDTH + A_HEADS

kernel_name = 'hybrid_mlstm_chunkmlp_rglru_step'


def _split_points():
    sizes = (A_WIDTH,) * 5 + (A_HEADS,) * 2 + (B_WIDTH,) * 3 + (C_WIDTH,) * 2 + (D_MODEL,) * N_BRANCH
    return [int(s) for s in np.cumsum(sizes)[:-1]]


def layer_norm(x, g, b):
    xf = x.astype(jnp.float32)
    mu = xf.mean(-1, keepdims=True)
    var = jnp.mean(jnp.square(xf - mu), -1, keepdims=True)
    return ((xf - mu) * lax.rsqrt(var + LN_EPS) * g.astype(jnp.float32) + b.astype(jnp.float32)).astype(x.dtype)


def head_norm(h, g):
    mu = h.mean(-1, keepdims=True)
    var = jnp.mean(jnp.square(h - mu), -1, keepdims=True)
    y = (h - mu) * lax.rsqrt(var + LN_EPS) * g.reshape(A_HEADS, A_DV).astype(jnp.float32)
    return y.reshape(h.shape[0], h.shape[1], A_WIDTH)


def mlstm_chunk(carry, inp):
    c0, n0, m0 = carry
    q, k, v, it, lf = inp
    L = q.shape[2]
    b = jnp.cumsum(lf, axis=-1)
    g = it - b
    m = b + jnp.maximum(m0[..., None], lax.cummax(g, axis=2))
    causal = jnp.tril(jnp.ones((L, L), dtype=bool))
    logd = b[..., :, None] + g[..., None, :] - m[..., :, None]
    dmat = jnp.exp(jnp.where(causal, logd, -jnp.inf))
    s = jnp.einsum('bhtd,bhsd->bhts', q, k) * dmat
    inter = jnp.exp(b + m0[..., None] - m)
    num = inter[..., None] * jnp.einsum('bhtd,bhde->bhte', q, c0) + jnp.einsum('bhts,bhse->bhte', s, v)
    den = inter * jnp.einsum('bhtd,bhd->bht', q, n0) + s.sum(-1)
    h = num / jnp.maximum(jnp.abs(den), jnp.exp(-m))[..., None]
    m_new = m[..., -1]
    w = jnp.exp(b[..., -1:] + g - m_new[..., None])
    decay = jnp.exp(b[..., -1] + m0 - m_new)
    c_new = decay[..., None, None] * c0 + jnp.einsum('bhs,bhsd,bhse->bhde', w, k, v)
    n_new = decay[..., None] * n0 + jnp.einsum('bhs,bhsd->bhd', w, k)
    return (c_new, n_new, m_new), h


def mlstm_seq(q, k, v, it, lf, c0, n0, m0):
    bsz, T = q.shape[0], q.shape[1]
    L = min(A_CHUNK, T)
    nch = T // L

    def to_chunks(a):
        a = jnp.swapaxes(a, 1, 2)
        a = a.reshape(a.shape[:2] + (nch, L) + a.shape[3:])
        return jnp.moveaxis(a, 2, 0)

    (c, n, m), h = lax.scan(mlstm_chunk, (c0, n0, m0),
                            (to_chunks(q), to_chunks(k), to_chunks(v), to_chunks(it), to_chunks(lf)))
    h = jnp.moveaxis(h, 0, 2).reshape(bsz, A_HEADS, T, A_DV)
    return jnp.swapaxes(h, 1, 2), c, n, m


def chunk_spatial_gate(u, v, ws, bs):
    bsz, T, _ = v.shape
    Tp = -(-T // B_CHUNK) * B_CHUNK
    vp = jnp.pad(v, ((0, 0), (0, Tp - T), (0, 0)))
    vc = vp.reshape(bsz, Tp // B_CHUNK, B_CHUNK, B_GROUPS, B_WIDTH // B_GROUPS)
    wm = ws * jnp.tril(jnp.ones((B_CHUNK, B_CHUNK), ws.dtype))
    mixed = jnp.einsum('gts,bnsgc->bntgc', wm, vc) + bs.T[None, None, :, :, None]
    mixed = mixed.reshape(bsz, Tp, B_WIDTH)[:, :T]
    return u * mixed


def causal_conv(x, buf, w, b):
    T = x.shape[1]
    xp = jnp.concatenate([buf.astype(x.dtype), x], axis=1)
    y = b + w[0] * xp[:, 0:T]
    for j in range(1, CONV_W):
        y = y + w[j] * xp[:, j:j + T]
    return y, xp[:, -(CONV_W - 1):]


def rg_lru(x, h0, wa, ba, wx, bx, lam, reset_first):
    bsz, T, _ = x.shape
    xf = x.astype(jnp.float32)
    xb = xf.reshape(bsz, T, C_BLOCKS, C_BLK)
    r = jax.nn.sigmoid(jnp.einsum('btni,nij->btnj', xb, wa.astype(jnp.float32)).reshape(bsz, T, C_WIDTH) + ba)
    i = jax.nn.sigmoid(jnp.einsum('btni,nij->btnj', xb, wx.astype(jnp.float32)).reshape(bsz, T, C_WIDTH) + bx)
    log_a = LRU_C * r * jax.nn.log_sigmoid(lam.astype(jnp.float32))
    a = jnp.exp(log_a)
    mult = jnp.sqrt(-jnp.expm1(2.0 * log_a))
    if reset_first:
        mult = mult.at[:, 0].set(1.0)
    bterm = mult * i * xf
    if h0 is not None:
        bterm = bterm.at[:, 0].add(a[:, 0] * h0.astype(jnp.float32))

    def combine(lhs, rhs):
        a1, b1 = lhs
        a2, b2 = rhs
        return a1 * a2, a2 * b1 + b2

    _, h = lax.associative_scan(combine, (a, bterm), axis=1)
    return h, h[:, -1]


def mixer_layer(x, p, c0, n0, m0, conv_buf, h0, reset_first):
    bsz, T, _ = x.shape
    proj = jnp.einsum('btd,de->bte', x, p['w_in']) + p['b_in']
    (q, k, v_a, o_a, z_a, i_pre, f_pre, u_b, v_b, z_b, x_c, z_c,
     g_a, g_b, g_c) = jnp.split(proj, _split_points(), axis=-1)
    f32 = jnp.float32
    qh = q.astype(f32).reshape(bsz, T, A_HEADS, A_DK)
    kh = k.astype(f32).reshape(bsz, T, A_HEADS, A_DK) * (A_DK ** -0.5)
    vh = v_a.astype(f32).reshape(bsz, T, A_HEADS, A_DV)
    it = i_pre.astype(f32)
    lf = jax.nn.log_sigmoid(f_pre.astype(f32))
    h_a, c_new, n_new, m_new = mlstm_seq(qh, kh, vh, it, lf, c0, n0, m0)
    h_a = jax.nn.sigmoid(o_a.astype(f32)).reshape(bsz, T, A_HEADS, A_DV) * h_a
    y_a = (head_norm(h_a, p['mlstm_norm_g']) * jax.nn.silu(z_a.astype(f32))).astype(x.dtype)
    vn = layer_norm(v_b, p['gmlp_ln_g'], p['gmlp_ln_b'])
    y_b = chunk_spatial_gate(u_b, vn, p['gmlp_ws'], p['gmlp_bs']) * jax.nn.silu(z_b)
    xc, conv_new = causal_conv(x_c, conv_buf, p['lru_conv_w'], p['lru_conv_b'])
    h_c, h_last = rg_lru(xc, h0, p['lru_wa'], p['lru_ba'], p['lru_wx'], p['lru_bx'], p['lru_lambda'], reset_first)
    y_c = (h_c * jax.nn.silu(z_c.astype(f32))).astype(x.dtype)
    merged = (jax.nn.sigmoid(g_a) * (y_a @ p['w_proj_a'])
              + jax.nn.sigmoid(g_b) * (y_b @ p['w_proj_b'])
              + jax.nn.sigmoid(g_c) * (y_c @ p['w_proj_c']))
    out = merged @ p['w_out']
    x_new = layer_norm(ALPHA * x + out, p['ln_g'], p['ln_b'])
    return x_new, c_new, n_new, m_new, conv_new, h_last, vn


def setup_inputs(seed: int = 0) -> dict:
    key = jax.random.key(seed)
    ks = jax.random.split(key, 32)
    f32 = jnp.float32
    nrm = lambda k, shape, s: jax.random.normal(k, shape, f32) * s
    b_in = nrm(ks[8], (DEPTH, IN_WIDTH), 0.01)
    f_bias = jnp.linspace(3.0, 6.0, A_HEADS, dtype=f32)[None, :] + nrm(ks[9], (DEPTH, A_HEADS), 0.01)
    b_in = b_in.at[:, F_OFF:F_OFF + A_HEADS].set(f_bias)
    u = jax.random.uniform(ks[10], (DEPTH, C_WIDTH), f32, 0.9, 0.999)
    s = u ** (1.0 / LRU_C)
    lam = jnp.log(s) - jnp.log1p(-s)
    return {
        'x_prompt': nrm(ks[0], (BATCH, SEQ, D_MODEL), 1.0),
        'x_sample': nrm(ks[1], (DEC_BATCH, DEC_SEQ, D_MODEL), 1.0),
        'state_mlstm_c': nrm(ks[2], (DEPTH, DEC_BATCH, A_HEADS, A_DK, A_DV), 0.1),
        'state_mlstm_n': nrm(ks[3], (DEPTH, DEC_BATCH, A_HEADS, A_DK), 0.5),
        'state_mlstm_m': nrm(ks[4], (DEPTH, DEC_BATCH, A_HEADS), 1.0),
        'state_lru_conv': nrm(ks[5], (DEPTH, DEC_BATCH, CONV_W - 1, C_WIDTH), 1.0),
        'state_lru_h': nrm(ks[6], (DEPTH, DEC_BATCH, C_WIDTH), 0.5),
        'w_in': nrm(ks[7], (DEPTH, D_MODEL, IN_WIDTH), D_MODEL ** -0.5),
        'b_in': b_in,
        'mlstm_norm_g': 1.0 + nrm(ks[11], (DEPTH, A_WIDTH), 0.01),
        'gmlp_ln_g': 1.0 + nrm(ks[12], (DEPTH, B_WIDTH), 0.01),
        'gmlp_ln_b': nrm(ks[13], (DEPTH, B_WIDTH), 0.01),
        'gmlp_ws': nrm(ks[14], (DEPTH, B_GROUPS, B_CHUNK, B_CHUNK), 0.5 * B_CHUNK ** -0.5),
        'gmlp_bs': 1.0 + nrm(ks[15], (DEPTH, B_GROUPS, B_CHUNK), 0.01),
        'lru_conv_w': nrm(ks[16], (DEPTH, CONV_W, C_WIDTH), CONV_W ** -0.5),
        'lru_conv_b': nrm(ks[17], (DEPTH, C_WIDTH), 0.01),
        'lru_wa': nrm(ks[18], (DEPTH, C_BLOCKS, C_BLK, C_BLK), C_BLK ** -0.5),
        'lru_ba': nrm(ks[19], (DEPTH, C_WIDTH), 0.01),
        'lru_wx': nrm(ks[20], (DEPTH, C_BLOCKS, C_BLK, C_BLK), C_BLK ** -0.5),
        'lru_bx': nrm(ks[21], (DEPTH, C_WIDTH), 0.01),
        'lru_lambda': lam,
        'w_proj_a': nrm(ks[22], (DEPTH, A_WIDTH, D_MODEL), BETA * A_WIDTH ** -0.5),
        'w_proj_b': nrm(ks[23], (DEPTH, B_WIDTH, D_MODEL), BETA * B_WIDTH ** -0.5),
        'w_proj_c': nrm(ks[24], (DEPTH, C_WIDTH, D_MODEL), BETA * C_WIDTH ** -0.5),
        'w_out': nrm(ks[25], (DEPTH, D_MODEL, D_MODEL), BETA * D_MODEL ** -0.5),
        'ln_g': 1.0 + nrm(ks[26], (DEPTH, D_MODEL), 0.01),
        'ln_b': nrm(ks[27], (DEPTH, D_MODEL), 0.01),
    }


def reference(x_prompt, x_sample, state_mlstm_c, state_mlstm_n, state_mlstm_m, state_lru_conv, state_lru_h,
              w_in, b_in, mlstm_norm_g, gmlp_ln_g, gmlp_ln_b, gmlp_ws, gmlp_bs, lru_conv_w, lru_conv_b,
              lru_wa, lru_ba, lru_wx, lru_bx, lru_lambda, w_proj_a, w_proj_b, w_proj_c, w_out, ln_g, ln_b):
    f32 = jnp.float32
    bp = x_prompt.shape[0]
    xp, xs = x_prompt, x_sample
    cp_l, np_l, mp_l, convp_l, hp_l = [], [], [], [], []
    cs_l, ns_l, ms_l, convs_l, hs_l, vs_l = [], [], [], [], [], []
    for l in range(DEPTH):
        p = {'w_in': w_in[l], 'b_in': b_in[l], 'mlstm_norm_g': mlstm_norm_g[l],
             'gmlp_ln_g': gmlp_ln_g[l], 'gmlp_ln_b': gmlp_ln_b[l], 'gmlp_ws': gmlp_ws[l], 'gmlp_bs': gmlp_bs[l],
             'lru_conv_w': lru_conv_w[l], 'lru_conv_b': lru_conv_b[l], 'lru_wa': lru_wa[l], 'lru_ba': lru_ba[l],
             'lru_wx': lru_wx[l], 'lru_bx': lru_bx[l], 'lru_lambda': lru_lambda[l],
             'w_proj_a': w_proj_a[l], 'w_proj_b': w_proj_b[l], 'w_proj_c': w_proj_c[l],
             'w_out': w_out[l], 'ln_g': ln_g[l], 'ln_b': ln_b[l]}
        xp, c, n, m, conv, h, _ = mixer_layer(
            xp, p,
            jnp.zeros((bp, A_HEADS, A_DK, A_DV), f32), jnp.zeros((bp, A_HEADS, A_DK), f32),
            jnp.zeros((bp, A_HEADS), f32), jnp.zeros((bp, CONV_W - 1, C_WIDTH), xp.dtype), None, True)
        cp_l.append(c); np_l.append(n); mp_l.append(m); convp_l.append(conv); hp_l.append(h)
        xs, c, n, m, conv, h, vn = mixer_layer(
            xs, p,
            state_mlstm_c[l].astype(f32), state_mlstm_n[l].astype(f32), state_mlstm_m[l].astype(f32),
            state_lru_conv[l], state_lru_h[l], False)
        cs_l.append(c); ns_l.append(n); ms_l.append(m); convs_l.append(conv); hs_l.append(h); vs_l.append(vn)
    return (xp, xs,
            jnp.stack(cp_l), jnp.stack(np_l), jnp.stack(mp_l), jnp.stack(convp_l), jnp.stack(hp_l),
            jnp.stack(cs_l), jnp.stack(ns_l), jnp.stack(ms_l), jnp.stack(convs_l), jnp.stack(hs_l),
            jnp.stack(vs_l))
```

```cpp
#include <hip/hip_runtime.h>
#include <hip/hip_cooperative_groups.h>
#include <cstdio>
#include <cstdint>
namespace cg = cooperative_groups;

typedef unsigned short bf16_t;
typedef short bf16x8 __attribute__((ext_vector_type(8)));
typedef short s16x4 __attribute__((ext_vector_type(4)));
typedef float f32x4 __attribute__((ext_vector_type(4)));
#define LDSP(T) __attribute__((address_space(3))) T*

constexpr int D = 1024, NPR = 16384, NSM = 512, MT = 16896, NL = 4, SEQ = 2048;
constexpr int INW = 13320, NPJ = 13312;
constexpr int C_Q = 0, C_K = 1024, C_V = 2048, C_O = 3072, C_ZA = 4096, C_UB = 5120, C_VB = 6144, C_ZB = 7168,
              C_XC = 8192, C_ZC = 9216, C_GA = 10240;
constexpr float ALPHA = 1.6817928305074292f;
constexpr float EPS = 1e-5f;
constexpr int LDS_TOTAL = 150 * 1024;
#ifndef DUP_PHASE
#define DUP_PHASE -1
#endif
#define GSYNC xcd_barrier(xb)
#define REP(k) for (int rep_ = 0; rep_ < ((DUP_PHASE == (k)) ? 2 : 1); ++rep_)

constexpr size_t W_WTIN = 0;
constexpr size_t W_WTP = W_WTIN + (size_t)NL * NPJ * D * 2;
constexpr size_t W_WTL = W_WTP + (size_t)NL * 4 * D * D * 2;
constexpr size_t W_WM = W_WTL + (size_t)NL * 2 * 8 * 128 * 128 * 2;
constexpr size_t W_XB = W_WM + (size_t)NL * 4 * 128 * 128 * 2;
constexpr size_t W_XF = W_XB + (size_t)MT * D * 2;
constexpr size_t W_GATE = W_XF + (size_t)MT * D * 4;
constexpr size_t W_P = W_GATE + (size_t)MT * 8 * 4;
constexpr size_t W_PRE = W_P + (size_t)MT * NPJ * 2;
constexpr size_t W_MF = W_PRE + (size_t)MT * D * 4;
constexpr size_t W_MB = W_MF + (size_t)MT * D * 4;
constexpr size_t W_Y = W_MB + (size_t)MT * D * 2;
constexpr size_t W_G = W_Y + (size_t)3 * MT * D * 2;
constexpr size_t W_MX = W_G + (size_t)32 * 2048 * 4;
constexpr size_t W_EM = W_MX + (size_t)32 * 2048 * 4;
constexpr size_t W_LH = W_EM + (size_t)32 * 2048 * 4;
constexpr size_t W_LA = W_LH + (size_t)NPR * D * 2;
constexpr size_t W_LE = W_LA + (size_t)NPR * D * 2;
constexpr size_t W_BAR = W_LE + (size_t)8 * 16 * 1024 * 2 * 4;
constexpr size_t W_QCT = W_BAR + 3456 * 4;
constexpr size_t W_CTL_END = W_QCT + 4 * 256;
constexpr size_t W_END = W_CTL_END;

constexpr size_t O_Y = 0;
constexpr size_t O_CP = (size_t)MT * D;
constexpr size_t O_NP = O_CP + (size_t)NL * 8 * 4 * 256 * 256;
constexpr size_t O_MP = O_NP + (size_t)NL * 8 * 4 * 256;
constexpr size_t O_CONVP = O_MP + (size_t)NL * 8 * 4;
constexpr size_t O_HP = O_CONVP + (size_t)NL * 8 * 3 * 1024;
constexpr size_t O_CS = O_HP + (size_t)NL * 8 * 1024;
constexpr size_t O_NS = O_CS + (size_t)NL * 128 * 4 * 256 * 256;
constexpr size_t O_MS = O_NS + (size_t)NL * 128 * 4 * 256;
constexpr size_t O_CONVS = O_MS + (size_t)NL * 128 * 4;
constexpr size_t O_HS = O_CONVS + (size_t)NL * 128 * 3 * 1024;
constexpr size_t O_VS = O_HS + (size_t)NL * 128 * 1024;
constexpr size_t O_END = O_VS + (size_t)NL * 128 * 4 * 1024;

enum { I_XP = 0, I_XS, I_SC, I_SN, I_SM, I_SCONV, I_SH, I_WIN, I_BIN, I_NORMG, I_GLNG, I_GLNB, I_GWS, I_GBS, I_CONVW,
       I_CONVB, I_WA, I_BA, I_WX, I_BX, I_LAM, I_WPA, I_WPB, I_WPC, I_WOUT, I_LNG, I_LNB };

struct Params {
  const float* in[27];
  float* out;
  char* ws;
};

__device__ __forceinline__ bf16_t f2bf(float f) {
  unsigned u = __float_as_uint(f);
  u += 0x7fffu + ((u >> 16) & 1u);
  return (bf16_t)(u >> 16);
}
__device__ __forceinline__ float bf2f(bf16_t h) { return __uint_as_float(((unsigned)h) << 16); }
__device__ __forceinline__ unsigned pk2(float a, float b) {
  unsigned r;
  asm("v_cvt_pk_bf16_f32 %0, %1, %2" : "=v"(r) : "v"(a), "v"(b));
  return r;
}
__device__ __forceinline__ float bflo(unsigned u) { return __uint_as_float(u << 16); }
__device__ __forceinline__ float bfhi(unsigned u) { return __uint_as_float(u & 0xffff0000u); }
__device__ __forceinline__ float sigm(float x) { return __builtin_amdgcn_rcpf(1.f + __expf(-x)); }
__device__ __forceinline__ float silu(float x) { return x * sigm(x); }
__device__ __forceinline__ float logsig(float x) { return fminf(x, 0.f) - log1pf(__expf(-fabsf(x))); }
__device__ __forceinline__ float shf(float v, int src) {
  return __int_as_float(__builtin_amdgcn_ds_bpermute(src << 2, __float_as_int(v)));
}
#define SHX(v, o) shf((v), lane ^ (o))
#define SHU(v, o) shf((v), (lane >= (o)) ? lane - (o) : lane)
__device__ __forceinline__ float wave_sum_l(float v, int lane) {
#pragma unroll
  for (int o = 1; o < 64; o <<= 1) v += shf(v, lane ^ o);
  return v;
}
#define wave_sum(v) wave_sum_l((v), lane)
__device__ __forceinline__ f32x4 mfma16(bf16x8 a, bf16x8 b, f32x4 c) {
  return __builtin_amdgcn_mfma_f32_16x16x32_bf16(a, b, c, 0, 0, 0);
}
__device__ __forceinline__ bf16x8 frag_t(const bf16_t* T, int stride, int r0, int k0, int lane) {
  const int fr = lane & 15, fq = lane >> 4;
  const bf16_t* q = T + (k0 + fq * 8 + (fr >> 2)) * stride + r0 + (fr & 3) * 4;
  s16x4 a = __builtin_amdgcn_ds_read_tr16_b64_v4i16((LDSP(s16x4))q);
  s16x4 b = __builtin_amdgcn_ds_read_tr16_b64_v4i16((LDSP(s16x4))(q + 4 * stride));
  bf16x8 r = {a[0], a[1], a[2], a[3], b[0], b[1], b[2], b[3]};
  return r;
}
__device__ __forceinline__ void unpack8(uint4 v, float* f) {
  f[0] = bflo(v.x); f[1] = bfhi(v.x); f[2] = bflo(v.y); f[3] = bfhi(v.y);
  f[4] = bflo(v.z); f[5] = bfhi(v.z); f[6] = bflo(v.w); f[7] = bfhi(v.w);
}
__device__ __forceinline__ uint4 pack8(const float* f) {
  uint4 o; o.x = pk2(f[0], f[1]); o.y = pk2(f[2], f[3]); o.z = pk2(f[4], f[5]); o.w = pk2(f[6], f[7]);
  return o;
}

__device__ __forceinline__ int otid() { int t = threadIdx.x; asm volatile("" : "+v"(t)); return t; }

__device__ __forceinline__ void tconv_item(const float* src, int lds_, bf16_t* dst, int ldd, int k0, int n0s, int n0d,
                                           float* scr, int lane) {
#pragma unroll 8
  for (int i = 0; i < 32; ++i) {
    const int kk = 2 * i + (lane >> 5);
    scr[kk * 33 + (lane & 31)] = src[(size_t)(k0 + kk) * lds_ + n0s + (lane & 31)];
  }
  const int c = lane & 7;
#pragma unroll
  for (int j = 0; j < 4; ++j) {
    const int n = (lane >> 3) + 8 * j;
    const float* t = scr + (8 * c) * 33 + n;
    uint4 o;
    o.x = pk2(t[0 * 33], t[1 * 33]); o.y = pk2(t[2 * 33], t[3 * 33]);
    o.z = pk2(t[4 * 33], t[5 * 33]); o.w = pk2(t[6 * 33], t[7 * 33]);
    *(uint4*)(dst + (size_t)(n0d + n) * ldd + k0 + 8 * c) = o;
  }
}

__device__ __forceinline__ void phase_convert(const Params& p, char* smem, int l_lo, int l_hi) {
  const int tid = otid(), lane = tid & 63, wid = tid >> 6;
  float* scr = (float*)smem + wid * (64 * 33);
  constexpr int N_IN = NL * 16 * 416, N_PJ = NL * 4 * 16 * 32, N_LR = NL * 2 * 8 * 8;
  for (int it = blockIdx.x * 8 + wid; it < N_IN + N_PJ + N_LR; it += gridDim.x * 8) {
    int r = it;
    if (r < N_IN) {
      int l = r / (16 * 416), q = r % (16 * 416), kt = q / 416, nt = q % 416;
      if (l < l_lo || l >= l_hi) continue;
      int n0d = nt * 32, n0s = n0d + (n0d >= 5120 ? 8 : 0);
      tconv_item(p.in[I_WIN] + (size_t)l * D * INW, INW, (bf16_t*)(p.ws + W_WTIN) + (size_t)l * NPJ * D, D, kt * 64, n0s,
                 n0d, scr, lane);
      continue;
    }
    r -= N_IN;
    if (r < N_PJ) {
      int lm = r >> 9, q = r & 511, kt = q >> 5, nt = q & 31, l = lm >> 2, mat = lm & 3;
      if (l < l_lo || l >= l_hi) continue;
      const float* src = p.in[I_WPA + mat] + (size_t)l * D * D;
      tconv_item(src, D, (bf16_t*)(p.ws + W_WTP) + (size_t)lm * D * D, D, kt * 64, nt * 32, nt * 32, scr, lane);
      continue;
    }
    r -= N_PJ;
    {
      int q = r & 7, lmn = r >> 3, n = lmn & 7, mat = (lmn >> 3) & 1, l = lmn >> 4;
      if (l < l_lo || l >= l_hi) continue;
      const float* src = p.in[mat ? I_WX : I_WA] + (size_t)(l * 8 + n) * 16384;
      tconv_item(src, 128, (bf16_t*)(p.ws + W_WTL) + (size_t)((l * 2 + mat) * 8 + n) * 16384, 128, (q >> 2) * 64,
                 (q & 3) * 32, (q & 3) * 32, scr, lane);
    }
  }
  __syncthreads();
  if (l_lo != 0) return;
  bf16_t* wm = (bf16_t*)(p.ws + W_WM);
  const float* gws = p.in[I_GWS];
  for (int idx = blockIdx.x * 512 + otid(); idx < NL * 4 * 128 * 128; idx += gridDim.x * 512) {
    int t = (idx >> 7) & 127, s = idx & 127;
    wm[idx] = f2bf(s <= t ? gws[idx] : 0.f);
  }
}

__device__ __forceinline__ void row_pass(const Params& p, int l, char* smem) {
  const int tid = otid(), lane = tid & 63, wid = tid >> 6;
  float* sWg = (float*)smem;
  if (l < NL) {
    const float* w = p.in[I_WIN] + (size_t)l * D * INW;
    for (int idx = tid; idx < 8192; idx += 512) {
      int j = idx >> 10, k = idx & 1023;
      sWg[idx] = w[(size_t)k * INW + 5120 + j];
    }
  }
  __syncthreads();
  bf16_t* XB = (bf16_t*)(p.ws + W_XB);
  float* XF = (float*)(p.ws + W_XF);
  const float* PRE = (const float*)(p.ws + W_PRE);
  float* GATE = (float*)(p.ws + W_GATE);
  for (int r = blockIdx.x * 8 + wid; r < MT; r += gridDim.x * 8) {
    float4 v[4];
    if (l == 0) {
      const float* src = r < NPR ? p.in[I_XP] + (size_t)r * D : p.in[I_XS] + (size_t)(r - NPR) * D;
#pragma unroll
      for (int i = 0; i < 4; ++i) v[i] = ((const float4*)src)[lane + 64 * i];
    } else {
      const float* src = PRE + (size_t)r * D;
      float s = 0.f;
#pragma unroll
      for (int i = 0; i < 4; ++i) { v[i] = ((const float4*)src)[lane + 64 * i]; s += (v[i].x + v[i].y) + (v[i].z + v[i].w); }
      const float mean = wave_sum(s) * (1.f / D);
      float s2 = 0.f;
#pragma unroll
      for (int i = 0; i < 4; ++i) {
        v[i].x -= mean; v[i].y -= mean; v[i].z -= mean; v[i].w -= mean;
        s2 += (v[i].x * v[i].x + v[i].y * v[i].y) + (v[i].z * v[i].z + v[i].w * v[i].w);
      }
      const float rstd = rsqrtf(wave_sum(s2) * (1.f / D) + EPS);
      const float4* g4 = (const float4*)(p.in[I_LNG] + (size_t)(l - 1) * D);
      const float4* b4 = (const float4*)(p.in[I_LNB] + (size_t)(l - 1) * D);
      float* dst = (l == NL) ? p.out + O_Y + (size_t)r * D : XF + (size_t)r * D;
#pragma unroll
      for (int i = 0; i < 4; ++i) {
        float4 g = g4[lane + 64 * i], b = b4[lane + 64 * i];
        v[i].x = v[i].x * rstd * g.x + b.x; v[i].y = v[i].y * rstd * g.y + b.y;
        v[i].z = v[i].z * rstd * g.z + b.z; v[i].w = v[i].w * rstd * g.w + b.w;
        ((float4*)dst)[lane + 64 * i] = v[i];
      }
    }
    if (l < NL) {
#pragma unroll
      for (int i = 0; i < 4; ++i) {
        uint2 o; o.x = pk2(v[i].x, v[i].y); o.y = pk2(v[i].z, v[i].w);
        ((uint2*)(XB + (size_t)r * D))[lane + 64 * i] = o;
      }
      float ga[8];
#pragma unroll
      for (int j = 0; j < 8; ++j) {
        float a = 0.f;
#pragma unroll
        for (int i = 0; i < 4; ++i) {
          float4 w = ((const float4*)(sWg + j * 1024))[lane + 64 * i];
          a += v[i].x * w.x + v[i].y * w.y + v[i].z * w.z + v[i].w * w.w;
        }
        ga[j] = wave_sum(a);
      }
      if (lane == 0) {
        const float* bi = p.in[I_BIN] + (size_t)l * INW + 5120;
        float4 o0 = {ga[0] + bi[0], ga[1] + bi[1], ga[2] + bi[2], ga[3] + bi[3]};
        float4 o1 = {ga[4] + bi[4], ga[5] + bi[5], ga[6] + bi[6], ga[7] + bi[7]};
        ((float4*)(GATE + (size_t)r * 8))[0] = o0;
        ((float4*)(GATE + (size_t)r * 8))[1] = o1;
      }
    }
  }
  __syncthreads();
}

constexpr int KD = 1024, BK = 64, HALF = 128, HTB = HALF * BK * 2;
__device__ __forceinline__ int lds_byte(int r, int c) {
  int st = (r >> 4) * 2 + (c >> 5), rr = r & 15, cc = c & 31, ob = rr * 64 + cc * 2;
  return st * 1024 + (ob ^ (((ob >> 9) & 1) << 5));
}
__device__ __forceinline__ void stage_rc(int b, int& R, int& C) {
  int st = b / 1024, sb = b % 1024, swz = sb ^ (((sb >> 9) & 1) << 5);
  R = (st >> 1) * 16 + swz / 64;
  C = (st & 1) * 32 + (swz % 64) / 2;
}
__device__ __forceinline__ void tile_map(int L, int nM, int nN, int& pm, int& pn, int WGM_ = 8) {
  int nwg = nM * nN, q = nwg / 8, r = nwg % 8, xcd = L % 8, off = L / 8;
  int wgid = (xcd < r ? xcd * (q + 1) : r * (q + 1) + (xcd - r) * q) + off;
  int nig = WGM_ * nN, gid = wgid / nig, fm = gid * WGM_, gsz = min(nM - fm, WGM_);
  pm = fm + ((wgid % nig) % gsz);
  pn = (wgid % nig) / gsz;
}

__device__ __forceinline__ void gemm_tile(const bf16_t* __restrict__ A, const bf16_t* __restrict__ Bt, int brow, int bcol,
                                          char* shm, f32x4 (&acc)[2][2][4][2], bool primed = false, bool prime_only = false) {
#define SAO(b, h) (((b) * 2 + (h)) * HTB)
#define SBO(b, h) ((4 + (b) * 2 + (h)) * HTB)
#define STAGE(BO, BASE, br, kt)                                                                              \
  do {                                                                                                       \
    const char* _gb = (const char*)(BASE) + ((size_t)(br) * KD + (size_t)(kt) * BK) * 2;                     \
    __builtin_amdgcn_global_load_lds((const unsigned*)(_gb + toff0), (unsigned*)(shm + (BO) + tb0), 16, 0, 0); \
    __builtin_amdgcn_global_load_lds((const unsigned*)(_gb + toff1), (unsigned*)(shm + (BO) + tb1), 16, 0, 0); \
  } while (0)
#define LDA(dst, b, h)                                                                                         \
  _Pragma("unroll") for (int m = 0; m < 4; ++m) _Pragma("unroll") for (int k = 0; k < 2; ++k) dst[m][k] =      \
      *reinterpret_cast<const bf16x8*>(shm + SAO(b, h) + lds_byte(wr * 64 + m * 16 + fr, k * 32 + fq * 8))
#define LDB(dst, b, h)                                                                                         \
  _Pragma("unroll") for (int n = 0; n < 2; ++n) _Pragma("unroll") for (int k = 0; k < 2; ++k) dst[n][k] =      \
      *reinterpret_cast<const bf16x8*>(shm + SBO(b, h) + lds_byte(wc * 32 + n * 16 + fr, k * 32 + fq * 8))
#define MMA(ai, bj, At_, Bt_)                                                                               \
  do {                                                                                                      \
    __builtin_amdgcn_s_setprio(1);                                                                          \
    _Pragma("unroll") for (int m = 0; m < 4; ++m) _Pragma("unroll") for (int n = 0; n < 2; ++n)             \
        _Pragma("unroll") for (int k = 0; k < 2; ++k) acc[ai][bj][m][n] =                                   \
            __builtin_amdgcn_mfma_f32_16x16x32_bf16(Bt_[n][k], At_[m][k], acc[ai][bj][m][n], 0, 0, 0);     \
    __builtin_amdgcn_s_setprio(0);                                                                          \
  } while (0)
#define WAIT_V(n) asm volatile("s_waitcnt vmcnt(" #n ")" ::: "memory")
#define WAIT_L(n) asm volatile("s_waitcnt lgkmcnt(" #n ")" ::: "memory")
#define BAR __builtin_amdgcn_s_barrier()
#define SCHED __builtin_amdgcn_sched_barrier(0)
  const int tidg = otid();
  const int wid = tidg >> 6, lane = tidg & 63, wr = wid >> 2, wc = wid & 3, fr = lane & 15, fq = lane >> 4;
  const int tb0 = tidg * 16, tb1 = tb0 + 8192;
  unsigned toff0, toff1;
  {
    int r_, c_;
    stage_rc(tb0, r_, c_); toff0 = (unsigned)(r_ * KD + c_) * 2u;
    stage_rc(tb1, r_, c_); toff1 = (unsigned)(r_ * KD + c_) * 2u;
  }
  if (prime_only) {
    STAGE(SBO(0, 0), Bt, bcol, 0); STAGE(SAO(0, 0), A, brow, 0);
    STAGE(SBO(0, 1), Bt, bcol + HALF, 0); STAGE(SAO(0, 1), A, brow + HALF, 0);
    STAGE(SBO(1, 0), Bt, bcol, 1); STAGE(SAO(1, 0), A, brow, 1); STAGE(SBO(1, 1), Bt, bcol + HALF, 1);
    return;
  }
#pragma unroll
  for (int a = 0; a < 2; ++a)
#pragma unroll
    for (int b = 0; b < 2; ++b)
#pragma unroll
      for (int m = 0; m < 4; ++m)
#pragma unroll
        for (int n = 0; n < 2; ++n) acc[a][b][m][n] = f32x4{0.f, 0.f, 0.f, 0.f};
  bf16x8 At[4][2], B0[2][2], B1[2][2];
  constexpr int nt = KD / BK;
  if (!primed) {
    __syncthreads();
    STAGE(SBO(0, 0), Bt, bcol, 0); STAGE(SAO(0, 0), A, brow, 0);
    STAGE(SBO(0, 1), Bt, bcol + HALF, 0); STAGE(SAO(0, 1), A, brow + HALF, 0);
    STAGE(SBO(1, 0), Bt, bcol, 1); STAGE(SAO(1, 0), A, brow, 1); STAGE(SBO(1, 1), Bt, bcol + HALF, 1);
  }
  if (wr == 1) BAR;
  WAIT_V(0); BAR;
  BAR;
#pragma unroll 1
  for (int t = 0; t < nt - 2; t += 2) {
    LDB(B0, 0, 0); SCHED; LDA(At, 0, 0); STAGE(SAO(1, 1), A, brow + HALF, t + 1);
    WAIT_L(8); BAR; WAIT_L(0); MMA(0, 0, At, B0); BAR; SCHED;
    LDB(B1, 0, 1); STAGE(SBO(0, 0), Bt, bcol, t + 2);
    BAR; WAIT_L(0); MMA(0, 1, At, B1); BAR;
    LDA(At, 0, 1); STAGE(SAO(0, 0), A, brow, t + 2);
    BAR; WAIT_L(0); MMA(1, 0, At, B0); BAR; SCHED;
    STAGE(SBO(0, 1), Bt, bcol + HALF, t + 2);
    WAIT_V(6); BAR; MMA(1, 1, At, B1); BAR;
    LDB(B0, 1, 0); SCHED; LDA(At, 1, 0); STAGE(SAO(0, 1), A, brow + HALF, t + 2);
    WAIT_L(8); BAR; WAIT_L(0); MMA(0, 0, At, B0); BAR; SCHED;
    LDB(B1, 1, 1); STAGE(SBO(1, 0), Bt, bcol, t + 3);
    BAR; WAIT_L(0); MMA(0, 1, At, B1); BAR;
    LDA(At, 1, 1); STAGE(SAO(1, 0), A, brow, t + 3);
    BAR; WAIT_L(0); MMA(1, 0, At, B0); BAR; SCHED;
    STAGE(SBO(1, 1), Bt, bcol + HALF, t + 3);
    WAIT_V(6); BAR; MMA(1, 1, At, B1); BAR;
  }
  {
    LDB(B0, 0, 0); LDA(At, 0, 0); STAGE(SAO(1, 1), A, brow + HALF, nt - 1);
    BAR; WAIT_L(0); MMA(0, 0, At, B0); BAR;
    LDB(B1, 0, 1); BAR; WAIT_L(0); MMA(0, 1, At, B1); BAR;
    LDA(At, 0, 1); WAIT_V(4); BAR; WAIT_L(0); MMA(1, 0, At, B0); MMA(1, 1, At, B1); BAR;
  }
  {
    LDB(B0, 1, 0); LDA(At, 1, 0); WAIT_V(2); BAR; WAIT_L(0); MMA(0, 0, At, B0); BAR;
    LDB(B1, 1, 1); WAIT_V(0); BAR; WAIT_L(0); MMA(0, 1, At, B1); BAR;
    LDA(At, 1, 1); BAR; WAIT_L(0); MMA(1, 0, At, B0); MMA(1, 1, At, B1); BAR;
  }
  if (wr == 0) BAR;
}
#define EPI_IDX const int tide = otid(), wid = tide >> 6, lane = tide & 63, wr = wid >> 2, wc = wid & 3, fr = lane & 15, fq = lane >> 4;
#define EPI_LOOP                                                                     \
  _Pragma("unroll") for (int ai = 0; ai < 2; ++ai) _Pragma("unroll") for (int bj = 0; bj < 2; ++bj) \
      _Pragma("unroll") for (int m = 0; m < 4; ++m) _Pragma("unroll") for (int n = 0; n < 2; ++n)

__device__ __forceinline__ void mlstm_scalars(const Params& p, int l, int bh, char* smem) {
  const int tid = otid(), lane = tid & 63, wid = tid >> 6;
  float* sred = (float*)smem;
  const float* GATE = (const float*)(p.ws + W_GATE);
  const int b = bh >> 2, h = bh & 3;
  float itv[4], c[4];
#pragma unroll
  for (int r = 0; r < 4; ++r) {
    size_t row = (size_t)b * SEQ + tid * 4 + r;
    itv[r] = GATE[row * 8 + h];
    c[r] = logsig(GATE[row * 8 + 4 + h]);
  }
  c[1] += c[0]; c[2] += c[1]; c[3] += c[2];
  float inc = c[3];
#pragma unroll
  for (int o = 1; o < 64; o <<= 1) { float t = SHU(inc, o); if (lane >= o) inc += t; }
  if (lane == 63) sred[wid] = inc;
  __syncthreads();
  float base = 0.f;
  for (int w = 0; w < wid; ++w) base += sred[w];
  __syncthreads();
  const float excl = base + inc - c[3];
  float g[4], mx[4];
#pragma unroll
  for (int r = 0; r < 4; ++r) { c[r] += excl; g[r] = itv[r] - c[r]; }
  mx[0] = g[0]; mx[1] = fmaxf(mx[0], g[1]); mx[2] = fmaxf(mx[1], g[2]); mx[3] = fmaxf(mx[2], g[3]);
  float minc = mx[3];
#pragma unroll
  for (int o = 1; o < 64; o <<= 1) { float t = SHU(minc, o); if (lane >= o) minc = fmaxf(minc, t); }
  if (lane == 63) sred[wid] = minc;
  __syncthreads();
  float mb = 0.f;
  for (int w = 0; w < wid; ++w) mb = fmaxf(mb, sred[w]);
  float prev = SHU(minc, 1);
  if (lane > 0) mb = fmaxf(mb, prev);
  __syncthreads();
  float* G = (float*)(p.ws + W_G) + (size_t)bh * SEQ;
  float* MX = (float*)(p.ws + W_MX) + (size_t)bh * SEQ;
  float* EM = (float*)(p.ws + W_EM) + (size_t)bh * SEQ;
  float4 og, om, oe;
  float mxv[4], mv[4];
#pragma unroll
  for (int r = 0; r < 4; ++r) { mxv[r] = fmaxf(mb, mx[r]); mv[r] = c[r] + mxv[r]; }
  og = float4{g[0], g[1], g[2], g[3]};
  om = float4{mxv[0], mxv[1], mxv[2], mxv[3]};
  oe = float4{__expf(-mv[0]), __expf(-mv[1]), __expf(-mv[2]), __expf(-mv[3])};
  ((float4*)G)[tid] = og; ((float4*)MX)[tid] = om; ((float4*)EM)[tid] = oe;
  if (tid == 511) p.out[O_MP + (size_t)l * 32 + bh] = mv[3];
}

__device__ __forceinline__ void mlstm_flash(const Params& p, int l, int bh, int qi, char* smem) {
  const int tid = otid(), lane = tid & 63, wid = tid >> 6, fr = lane & 15, fq = lane >> 4, wr = wid >> 1, wc = wid & 1;
  const int b = bh >> 2, h = bh & 3;
  char* sKb = smem;
  char* sVb = smem + 65536;
  bf16_t* sP = (bf16_t*)(smem + 131072);
  float* sRed = (float*)(smem + 131072);
  const bf16_t* P = (const bf16_t*)(p.ws + W_P);
  const float* G = (const float*)(p.ws + W_G) + (size_t)bh * SEQ;
  const float* MX = (const float*)(p.ws + W_MX) + (size_t)bh * SEQ;
  const float* EM = (const float*)(p.ws + W_EM) + (size_t)bh * SEQ;
  const size_t rowbase = (size_t)b * SEQ;
  const int nblk = 2 * qi + 2;
#define FL_ISSUE(jb)                                                                                              \
  do {                                                                                                            \
    const int buf_ = (jb) & 1;                                                                                    \
    const bf16_t* rp0_ = P + (rowbase + (size_t)(jb) * 64) * NPJ + h * 256;                                       \
    _Pragma("unroll") for (int i_ = 0; i_ < 4; ++i_) {                                                            \
      const int r_ = (wid * 4 + i_) * 2 + (lane >> 5), cs_ = lane & 31;                                           \
      const int ck_ = cs_ ^ (r_ & 31), cv_ = cs_ ^ (((r_ & 3) << 1) | (r_ & 8));                                  \
      __builtin_amdgcn_global_load_lds((const unsigned*)(rp0_ + (size_t)r_ * NPJ + C_K + ck_ * 8),                \
                                       (unsigned*)(sKb + buf_ * 32768 + (wid * 4 + i_) * 1024 + lane * 16), 16, 0, 0); \
      __builtin_amdgcn_global_load_lds((const unsigned*)(rp0_ + (size_t)r_ * NPJ + C_V + cv_ * 8),                \
                                       (unsigned*)(sVb + buf_ * 32768 + (wid * 4 + i_) * 1024 + lane * 16), 16, 0, 0); \
    }                                                                                                             \
  } while (0)
  FL_ISSUE(0);
  bf16x8 qf[2][8];
  float mxr[2];
#pragma unroll
  for (int m = 0; m < 2; ++m) {
    const int t = qi * 128 + wr * 32 + m * 16 + fr;
    const bf16_t* qp = P + (rowbase + t) * NPJ + C_Q + h * 256 + fq * 8;
#pragma unroll
    for (int kk = 0; kk < 8; ++kk) qf[m][kk] = *(const bf16x8*)(qp + kk * 32);
    mxr[m] = MX[t];
  }
  f32x4 oacc[2][8];
#pragma unroll
  for (int m = 0; m < 2; ++m)
#pragma unroll
    for (int n = 0; n < 8; ++n) oacc[m][n] = f32x4{0.f, 0.f, 0.f, 0.f};
  float den[2] = {0.f, 0.f};
#pragma unroll 1
  for (int j = 0; j < nblk; ++j) {
    asm volatile("s_waitcnt vmcnt(0)" ::: "memory");
    __syncthreads();
    if (j + 1 < nblk) FL_ISSUE(j + 1);
    const char* sK = sKb + (j & 1) * 32768;
    const char* sV = sVb + (j & 1) * 32768;
    f32x4 sacc[2][2];
#pragma unroll
    for (int m = 0; m < 2; ++m)
#pragma unroll
      for (int n = 0; n < 2; ++n) sacc[m][n] = f32x4{0.f, 0.f, 0.f, 0.f};
#pragma unroll
    for (int kk = 0; kk < 8; ++kk)
#pragma unroll
      for (int n = 0; n < 2; ++n) {
        const int row = wc * 32 + n * 16 + fr, c = kk * 4 + fq;
        bf16x8 kf = *(const bf16x8*)(sK + row * 512 + ((c ^ (row & 31)) << 4));
        sacc[0][n] = mfma16(kf, qf[0][kk], sacc[0][n]);
        sacc[1][n] = mfma16(kf, qf[1][kk], sacc[1][n]);
      }
#pragma unroll
    for (int n = 0; n < 2; ++n) {
      const int s0 = j * 64 + wc * 32 + n * 16 + fq * 4;
      const float4 g4 = *(const float4*)(G + s0);
      const float gs[4] = {g4.x, g4.y, g4.z, g4.w};
#pragma unroll
      for (int m = 0; m < 2; ++m) {
        const int t = qi * 128 + wr * 32 + m * 16 + fr;
        float v[4];
#pragma unroll
        for (int r = 0; r < 4; ++r) {
          float w = (s0 + r <= t) ? __expf(gs[r] - mxr[m]) : 0.f;
          v[r] = sacc[m][n][r] * 0.0625f * w;
          den[m] += v[r];
        }
        uint2 pk; pk.x = pk2(v[0], v[1]); pk.y = pk2(v[2], v[3]);
        *(uint2*)(sP + (wr * 32 + m * 16 + fr) * 72 + wc * 32 + n * 16 + fq * 4) = pk;
      }
    }
    __syncthreads();
#pragma unroll
    for (int kk = 0; kk < 2; ++kk) {
      bf16x8 pf0 = *(const bf16x8*)(sP + (wr * 32 + fr) * 72 + kk * 32 + fq * 8);
      bf16x8 pf1 = *(const bf16x8*)(sP + (wr * 32 + 16 + fr) * 72 + kk * 32 + fq * 8);
      const int srow = kk * 32 + fq * 8 + (fr >> 2);
      const int swz = ((srow & 3) << 1) | (srow & 8);
#pragma unroll
      for (int n2 = 0; n2 < 8; ++n2) {
        const int ch = ((wc * 128 + n2 * 16) >> 3) + ((fr & 3) >> 1);
        const char* va = sV + srow * 512 + ((ch ^ swz) << 4) + (fr & 1) * 8;
        s16x4 a = __builtin_amdgcn_ds_read_tr16_b64_v4i16((LDSP(s16x4))va);
        s16x4 bq = __builtin_amdgcn_ds_read_tr16_b64_v4i16((LDSP(s16x4))(va + 4 * 512));
        bf16x8 vf = {a[0], a[1], a[2], a[3], bq[0], bq[1], bq[2], bq[3]};
        oacc[0][n2] = mfma16(vf, pf0, oacc[0][n2]);
        oacc[1][n2] = mfma16(vf, pf1, oacc[1][n2]);
      }
    }
  }
  __syncthreads();
#undef FL_ISSUE
  float dn[2];
#pragma unroll
  for (int m = 0; m < 2; ++m) {
    float v = den[m];
    v += SHX(v, 16); v += SHX(v, 32);
    if (fq == 0) sRed[wc * 128 + wr * 32 + m * 16 + fr] = v;
  }
  __syncthreads();
#pragma unroll
  for (int m = 0; m < 2; ++m) {
    const int tl = wr * 32 + m * 16 + fr;
    float d = sRed[tl] + sRed[128 + tl];
    dn[m] = 1.f / fmaxf(fabsf(d), EM[qi * 128 + tl]);
  }
  float s1[2] = {0.f, 0.f}, s2[2] = {0.f, 0.f};
#pragma unroll
  for (int m = 0; m < 2; ++m) {
    const size_t row = rowbase + qi * 128 + wr * 32 + m * 16 + fr;
#pragma unroll
    for (int n2 = 0; n2 < 8; ++n2) {
      const int col = h * 256 + wc * 128 + n2 * 16 + fq * 4;
      const uint2 ov = *(const uint2*)(P + row * NPJ + C_O + col);
      const float o[4] = {bflo(ov.x), bfhi(ov.x), bflo(ov.y), bfhi(ov.y)};
#pragma unroll
      for (int r = 0; r < 4; ++r) {
        float hv = oacc[m][n2][r] * dn[m] * sigm(o[r]);
        oacc[m][n2][r] = hv;
        s1[m] += hv; s2[m] += hv * hv;
      }
    }
  }
#pragma unroll
  for (int m = 0; m < 2; ++m) {
    float a = s1[m], q = s2[m];
    a += SHX(a, 16); a += SHX(a, 32);
    q += SHX(q, 16); q += SHX(q, 32);
    if (fq == 0) { sRed[256 + wc * 128 + wr * 32 + m * 16 + fr] = a; sRed[512 + wc * 128 + wr * 32 + m * 16 + fr] = q; }
  }
  __syncthreads();
  bf16_t* Y0 = (bf16_t*)(p.ws + W_Y);
  const float* ng = p.in[I_NORMG] + (size_t)l * D;
#pragma unroll
  for (int m = 0; m < 2; ++m) {
    const int tl = wr * 32 + m * 16 + fr;
    const float mean = (sRed[256 + tl] + sRed[256 + 128 + tl]) * (1.f / 256.f);
    const float var = (sRed[512 + tl] + sRed[512 + 128 + tl]) * (1.f / 256.f) - mean * mean;
    const float rstd = rsqrtf(fmaxf(var, 0.f) + EPS);
    const size_t row = rowbase + qi * 128 + tl;
#pragma unroll
    for (int n2 = 0; n2 < 8; ++n2) {
      const int col = h * 256 + wc * 128 + n2 * 16 + fq * 4;
      const uint2 zv = *(const uint2*)(P + row * NPJ + C_ZA + col);
      const float4 g4 = *(const float4*)(ng + col);
      const float z[4] = {bflo(zv.x), bfhi(zv.x), bflo(zv.y), bfhi(zv.y)};
      const float gg[4] = {g4.x, g4.y, g4.z, g4.w};
      float y[4];
#pragma unroll
      for (int r = 0; r < 4; ++r) y[r] = (oacc[m][n2][r] - mean) * rstd * gg[r] * silu(z[r]);
      uint2 o; o.x = pk2(y[0], y[1]); o.y = pk2(y[2], y[3]);
      *(uint2*)(Y0 + row * D + col) = o;
    }
  }
  __syncthreads();
}

__device__ __forceinline__ void mlstm_final(const Params& p, int l, int bh, int dq, char* smem) {
  const int tid = otid(), lane = tid & 63, wid = tid >> 6, fr = lane & 15, fq = lane >> 4, wr = wid >> 2, wc = wid & 3;
  const int b = bh >> 2, h = bh & 3;
  bf16_t* sKw = (bf16_t*)smem;
  bf16_t* sV = (bf16_t*)(smem + 18432);
  float* sW = (float*)(smem + 18432 + 69632);
  const bf16_t* P = (const bf16_t*)(p.ws + W_P);
  const float* G = (const float*)(p.ws + W_G) + (size_t)bh * SEQ;
  const float mxl = ((const float*)(p.ws + W_MX))[(size_t)bh * SEQ + SEQ - 1];
  const size_t rowbase = (size_t)b * SEQ;
  f32x4 acc[2][4];
#pragma unroll
  for (int m = 0; m < 2; ++m)
#pragma unroll
    for (int n = 0; n < 4; ++n) acc[m][n] = f32x4{0.f, 0.f, 0.f, 0.f};
  float nacc = 0.f;
#pragma unroll 1
  for (int ch = 0; ch < 16; ++ch) {
    if (tid < 128) sW[tid] = __expf(G[ch * 128 + tid] - mxl) * 0.0625f;
    __syncthreads();
#pragma unroll
    for (int i = 0; i < 2; ++i) {
      int c = tid + 512 * i, r = c >> 3, c8 = c & 7;
      uint4 kv = *(const uint4*)(P + (rowbase + ch * 128 + r) * NPJ + C_K + h * 256 + dq * 64 + c8 * 8);
      float f[8]; unpack8(kv, f);
      const float w = sW[r];
#pragma unroll
      for (int e = 0; e < 8; ++e) f[e] *= w;
      *(uint4*)(sKw + r * 72 + c8 * 8) = pack8(f);
    }
#pragma unroll
    for (int i = 0; i < 8; ++i) {
      int c = tid + 512 * i, r = c >> 5, c8 = c & 31;
      *(uint4*)(sV + r * 272 + c8 * 8) = *(const uint4*)(P + (rowbase + ch * 128 + r) * NPJ + C_V + h * 256 + c8 * 8);
    }
    __syncthreads();
#pragma unroll
    for (int kk = 0; kk < 4; ++kk) {
      bf16x8 kf0 = frag_t(sKw, 72, wr * 32, kk * 32, lane);
      bf16x8 kf1 = frag_t(sKw, 72, wr * 32 + 16, kk * 32, lane);
#pragma unroll
      for (int n = 0; n < 4; ++n) {
        bf16x8 vf = frag_t(sV, 272, wc * 64 + n * 16, kk * 32, lane);
        acc[0][n] = mfma16(vf, kf0, acc[0][n]);
        acc[1][n] = mfma16(vf, kf1, acc[1][n]);
      }
    }
    {
      float a = 0.f;
#pragma unroll
      for (int s = 0; s < 16; ++s) a += bf2f(sKw[(wid * 16 + s) * 72 + lane]);
      nacc += a;
    }
    __syncthreads();
  }
  float* oc = p.out + O_CP + ((size_t)l * 32 + bh) * 65536;
#pragma unroll
  for (int m = 0; m < 2; ++m)
#pragma unroll
    for (int n = 0; n < 4; ++n) {
      const int d = dq * 64 + wr * 32 + m * 16 + fr, e = wc * 64 + n * 16 + fq * 4;
      *(float4*)(oc + (size_t)d * 256 + e) = float4{acc[m][n][0], acc[m][n][1], acc[m][n][2], acc[m][n][3]};
    }
  sW[tid] = nacc;
  __syncthreads();
  if (tid < 64) {
    float a = 0.f;
#pragma unroll
    for (int w8 = 0; w8 < 8; ++w8) a += sW[w8 * 64 + tid];
    p.out[O_NP + ((size_t)l * 32 + bh) * 256 + dq * 64 + tid] = a;
  }
  __syncthreads();
}

__device__ __forceinline__ void mlstm_sample(const Params& p, int l, int b, int h, char* smem) {
  const int tid = otid(), lane = tid & 63, wid = tid >> 6;
  float* sq = (float*)smem;
  float* sk = sq + 1024;
  float* sv = sk + 1024;
  float* sn0 = sv + 1024;
  float* sqk = sn0 + 256;
  float* ssc = sqk + 32;
  float* sst = ssc + 32;
  float* snum = sst + 32;
  const bf16_t* P = (const bf16_t*)(p.ws + W_P);
  const float* GATE = (const float*)(p.ws + W_GATE);
  const size_t R0 = (size_t)NPR + b * 4;
  const size_t sidx = ((size_t)l * 128 + b) * 4 + h;
#pragma unroll
  for (int i = 0; i < 6; ++i) {
    int idx = tid + 512 * i, which = idx >> 10, t = (idx >> 8) & 3, d = idx & 255;
    sq[idx] = bf2f(P[(R0 + t) * NPJ + which * 1024 + h * 256 + d]);
  }
  if (tid < 256) sn0[tid] = p.in[I_SN][sidx * 256 + tid];
  const float m0 = p.in[I_SM][sidx];
  float g[4], cm[4], mm[4];
  {
    float bc = 0.f, run = m0;
#pragma unroll
    for (int t = 0; t < 4; ++t) {
      float itv = GATE[(R0 + t) * 8 + h];
      bc += logsig(GATE[(R0 + t) * 8 + 4 + h]);
      g[t] = itv - bc;
      run = fmaxf(run, g[t]);
      cm[t] = run;
      mm[t] = bc + run;
    }
  }
  __syncthreads();
  {
    const int pp = tid >> 5, li = tid & 31, t = pp >> 2, s = pp & 3;
    float part = 0.f;
#pragma unroll
    for (int d8 = 0; d8 < 8; ++d8) part += sq[t * 256 + li * 8 + d8] * sk[s * 256 + li * 8 + d8];
#pragma unroll
    for (int o = 16; o >= 1; o >>= 1) part += SHX(part, o);
    if (li == 0) sqk[pp] = part * 0.0625f;
    float part2 = 0.f;
    const int t2 = pp & 3;
#pragma unroll
    for (int d8 = 0; d8 < 8; ++d8) part2 += sq[t2 * 256 + li * 8 + d8] * sn0[li * 8 + d8];
#pragma unroll
    for (int o = 16; o >= 1; o >>= 1) part2 += SHX(part2, o);
    if (li == 0 && pp < 4) sqk[16 + pp] = part2;
  }
  __syncthreads();
  float w[4];
#pragma unroll
  for (int s = 0; s < 4; ++s) w[s] = __expf(g[s] - cm[3]) * 0.0625f;
  const float decay = __expf(m0 - cm[3]);
  if (tid == 0) {
#pragma unroll
    for (int t = 0; t < 4; ++t) {
      const float inter = __expf(m0 - cm[t]);
      float dsum = inter * sqk[16 + t];
#pragma unroll
      for (int s = 0; s < 4; ++s) {
        float st = (s <= t) ? sqk[t * 4 + s] * __expf(g[s] - cm[t]) : 0.f;
        ssc[t * 4 + s] = st;
        dsum += st;
      }
      ssc[16 + t] = inter;
      ssc[20 + t] = 1.f / fmaxf(fabsf(dsum), __expf(-mm[t]));
    }
  }
#pragma unroll
  for (int i = 0; i < 2; ++i) {
    int idx = tid + 512 * i;
    sk[idx] *= w[idx >> 8];
  }
  __syncthreads();
  {
    const int e4 = lane * 4, d0 = wid * 32;
    float4 vv[4], np[4];
#pragma unroll
    for (int s = 0; s < 4; ++s) { vv[s] = *(const float4*)(sv + s * 256 + e4); np[s] = float4{0.f, 0.f, 0.f, 0.f}; }
    const float* c0p = p.in[I_SC] + sidx * 65536;
    float* cop = p.out + O_CS + sidx * 65536;
#pragma unroll 1
    for (int dd = 0; dd < 32; dd += 8) {
      float4 c[8];
#pragma unroll
      for (int u = 0; u < 8; ++u) c[u] = *(const float4*)(c0p + (size_t)(d0 + dd + u) * 256 + e4);
#pragma unroll
      for (int u = 0; u < 8; ++u) {
        const int d = d0 + dd + u;
        float4 cn = {decay * c[u].x, decay * c[u].y, decay * c[u].z, decay * c[u].w};
#pragma unroll
        for (int t = 0; t < 4; ++t) {
          const float qv = sq[t * 256 + d], kv = sk[t * 256 + d];
          np[t].x += qv * c[u].x; np[t].y += qv * c[u].y; np[t].z += qv * c[u].z; np[t].w += qv * c[u].w;
          cn.x += kv * vv[t].x; cn.y += kv * vv[t].y; cn.z += kv * vv[t].z; cn.w += kv * vv[t].w;
        }
        *(float4*)(cop + (size_t)d * 256 + e4) = cn;
      }
    }
#pragma unroll
    for (int t = 0; t < 4; ++t) *(float4*)(snum + (wid * 4 + t) * 256 + e4) = np[t];
  }
  __syncthreads();
  {
    const int t = tid >> 7, e2 = (tid & 127) * 2;
    float hv[2];
    const unsigned ov = *(const unsigned*)(P + (R0 + t) * NPJ + C_O + h * 256 + e2);
    const float o2[2] = {bflo(ov), bfhi(ov)};
    const float inter = ssc[16 + t], dnm = ssc[20 + t];
#pragma unroll
    for (int k = 0; k < 2; ++k) {
      const int e = e2 + k;
      float a = 0.f;
#pragma unroll
      for (int w8 = 0; w8 < 8; ++w8) a += snum[(w8 * 4 + t) * 256 + e];
      float x = inter * a;
#pragma unroll
      for (int s = 0; s < 4; ++s) x += ssc[t * 4 + s] * sv[s * 256 + e];
      hv[k] = x * dnm * sigm(o2[k]);
    }
    float a1 = wave_sum(hv[0] + hv[1]), a2 = wave_sum(hv[0] * hv[0] + hv[1] * hv[1]);
    if (lane == 0) { sst[wid * 2] = a1; sst[wid * 2 + 1] = a2; }
    __syncthreads();
    const float mean = (sst[(2 * t) * 2] + sst[(2 * t + 1) * 2]) * (1.f / 256.f);
    const float var = (sst[(2 * t) * 2 + 1] + sst[(2 * t + 1) * 2 + 1]) * (1.f / 256.f) - mean * mean;
    const float rstd = rsqrtf(fmaxf(var, 0.f) + EPS);
    const unsigned zv = *(const unsigned*)(P + (R0 + t) * NPJ + C_ZA + h * 256 + e2);
    const float* ng = p.in[I_NORMG] + (size_t)l * D + h * 256 + e2;
    float y0 = (hv[0] - mean) * rstd * ng[0] * silu(bflo(zv));
    float y1 = (hv[1] - mean) * rstd * ng[1] * silu(bfhi(zv));
    *(unsigned*)((bf16_t*)(p.ws + W_Y) + (R0 + t) * D + h * 256 + e2) = pk2(y0, y1);
  }
  if (tid < 256) {
    float nn = decay * sn0[tid];
#pragma unroll
    for (int s = 0; s < 4; ++s) nn += sk[s * 256 + tid];
    p.out[O_NS + sidx * 256 + tid] = nn;
  }
  if (tid == 0) p.out[O_MS + sidx] = mm[3];
  __syncthreads();
}

__device__ __forceinline__ void gmlp_prompt(const Params& p, int l, int b, int chunk, int g, char* smem) {
  const int tid = otid(), lane = tid & 63, wid = tid >> 6, fr = lane & 15, fq = lane >> 4, wr = wid >> 2, wc = wid & 3;
  bf16_t* sVn = (bf16_t*)smem;
  bf16_t* sW = (bf16_t*)(smem + 69632);
  float* sMu = (float*)(smem + 69632 + 34816);
  float* sRs = sMu + 128;
  const bf16_t* P = (const bf16_t*)(p.ws + W_P);
  const size_t R0 = (size_t)b * SEQ + chunk * 128;
  for (int rr = 0; rr < 16; ++rr) {
    const int s = wid * 16 + rr;
    const bf16_t* rp = P + (R0 + s) * NPJ + C_VB;
    float f[16];
    unpack8(*(const uint4*)(rp + lane * 8), f);
    unpack8(*(const uint4*)(rp + 512 + lane * 8), f + 8);
    float a = 0.f, q = 0.f;
#pragma unroll
    for (int e = 0; e < 16; ++e) { a += f[e]; q += f[e] * f[e]; }
    a = wave_sum(a); q = wave_sum(q);
    if (lane == 0) {
      const float mean = a * (1.f / D);
      sMu[s] = mean;
      sRs[s] = rsqrtf(fmaxf(q * (1.f / D) - mean * mean, 0.f) + EPS);
    }
  }
  __syncthreads();
  const float* lg = p.in[I_GLNG] + (size_t)l * D + g * 256;
  const float* lb = p.in[I_GLNB] + (size_t)l * D + g * 256;
#pragma unroll
  for (int i = 0; i < 8; ++i) {
    int c = tid + 512 * i, r = c >> 5, c8 = c & 31;
    float f[8];
    unpack8(*(const uint4*)(P + (R0 + r) * NPJ + C_VB + g * 256 + c8 * 8), f);
    const float mu = sMu[r], rs = sRs[r];
    const float4 g0 = *(const float4*)(lg + c8 * 8), g1 = *(const float4*)(lg + c8 * 8 + 4);
    const float4 b0 = *(const float4*)(lb + c8 * 8), b1 = *(const float4*)(lb + c8 * 8 + 4);
    f[0] = (f[0] - mu) * rs * g0.x + b0.x; f[1] = (f[1] - mu) * rs * g0.y + b0.y;
    f[2] = (f[2] - mu) * rs * g0.z + b0.z; f[3] = (f[3] - mu) * rs * g0.w + b0.w;
    f[4] = (f[4] - mu) * rs * g1.x + b1.x; f[5] = (f[5] - mu) * rs * g1.y + b1.y;
    f[6] = (f[6] - mu) * rs * g1.z + b1.z; f[7] = (f[7] - mu) * rs * g1.w + b1.w;
    *(uint4*)(sVn + r * 272 + c8 * 8) = pack8(f);
  }
  const bf16_t* wm = (const bf16_t*)(p.ws + W_WM) + (size_t)(l * 4 + g) * 16384;
#pragma unroll
  for (int i = 0; i < 4; ++i) {
    int c = tid + 512 * i, r = c >> 4, c8 = c & 15;
    *(uint4*)(sW + r * 136 + c8 * 8) = *(const uint4*)(wm + r * 128 + c8 * 8);
  }
  __syncthreads();
  f32x4 acc[4][4];
#pragma unroll
  for (int m = 0; m < 4; ++m)
#pragma unroll
    for (int n = 0; n < 4; ++n) acc[m][n] = f32x4{0.f, 0.f, 0.f, 0.f};
#pragma unroll
  for (int kk = 0; kk < 4; ++kk) {
    bf16x8 tf[4];
#pragma unroll
    for (int m = 0; m < 4; ++m) tf[m] = *(const bf16x8*)(sW + (wr * 64 + m * 16 + fr) * 136 + kk * 32 + fq * 8);
#pragma unroll
    for (int n = 0; n < 4; ++n) {
      bf16x8 cf = frag_t(sVn, 272, wc * 64 + n * 16, kk * 32, lane);
#pragma unroll
      for (int m = 0; m < 4; ++m) acc[m][n] = mfma16(cf, tf[m], acc[m][n]);
    }
  }
  bf16_t* Y1 = (bf16_t*)(p.ws + W_Y) + (size_t)MT * D;
  const float* bs = p.in[I_GBS] + (size_t)(l * 4 + g) * 128;
#pragma unroll
  for (int m = 0; m < 4; ++m) {
    const int t = wr * 64 + m * 16 + fr;
    const float bsv = bs[t];
    const size_t row = R0 + t;
#pragma unroll
    for (int n = 0; n < 4; ++n) {
      const int col = g * 256 + wc * 64 + n * 16 + fq * 4;
      const uint2 uv = *(const uint2*)(P + row * NPJ + C_UB + col);
      const uint2 zv = *(const uint2*)(P + row * NPJ + C_ZB + col);
      const float u[4] = {bflo(uv.x), bfhi(uv.x), bflo(uv.y), bfhi(uv.y)};
      const float z[4] = {bflo(zv.x), bfhi(zv.x), bflo(zv.y), bfhi(zv.y)};
      float y[4];
#pragma unroll
      for (int r = 0; r < 4; ++r) y[r] = u[r] * (acc[m][n][r] + bsv) * silu(z[r]);
      uint2 o; o.x = pk2(y[0], y[1]); o.y = pk2(y[2], y[3]);
      *(uint2*)(Y1 + row * D + col) = o;
    }
  }
  __syncthreads();
}

__device__ __forceinline__ void gmlp_sample(const Params& p, int l, int b, char* smem) {
  const int tid = otid(), lane = tid & 63, wid = tid >> 6;
  float* svn = (float*)smem;
  const bf16_t* P = (const bf16_t*)(p.ws + W_P);
  const size_t R0 = (size_t)NPR + b * 4;
  if (wid < 4) {
    const int t = wid;
    const bf16_t* rp = P + (R0 + t) * NPJ + C_VB;
    float f[16];
    unpack8(*(const uint4*)(rp + lane * 8), f);
    unpack8(*(const uint4*)(rp + 512 + lane * 8), f + 8);
    float a = 0.f;
#pragma unroll
    for (int e = 0; e < 16; ++e) a += f[e];
    const float mean = wave_sum(a) * (1.f / D);
    float q = 0.f;
#pragma unroll
    for (int e = 0; e < 16; ++e) { f[e] -= mean; q += f[e] * f[e]; }
    const float rs = rsqrtf(wave_sum(q) * (1.f / D) + EPS);
    const float* lg = p.in[I_GLNG] + (size_t)l * D;
    const float* lb = p.in[I_GLNB] + (size_t)l * D;
    float* ov = p.out + O_VS + (((size_t)l * 128 + b) * 4 + t) * D;
#pragma unroll
    for (int hh = 0; hh < 2; ++hh) {
      const int c0 = hh * 512 + lane * 8;
#pragma unroll
      for (int e = 0; e < 8; ++e) f[hh * 8 + e] = f[hh * 8 + e] * rs * lg[c0 + e] + lb[c0 + e];
      *(float4*)(svn + t * 1024 + c0) = float4{f[hh * 8], f[hh * 8 + 1], f[hh * 8 + 2], f[hh * 8 + 3]};
      *(float4*)(svn + t * 1024 + c0 + 4) = float4{f[hh * 8 + 4], f[hh * 8 + 5], f[hh * 8 + 6], f[hh * 8 + 7]};
      *(float4*)(ov + c0) = float4{f[hh * 8], f[hh * 8 + 1], f[hh * 8 + 2], f[hh * 8 + 3]};
      *(float4*)(ov + c0 + 4) = float4{f[hh * 8 + 4], f[hh * 8 + 5], f[hh * 8 + 6], f[hh * 8 + 7]};
    }
  }
  __syncthreads();
  bf16_t* Y1 = (bf16_t*)(p.ws + W_Y) + (size_t)MT * D;
#pragma unroll
  for (int i = 0; i < 8; ++i) {
    const int idx = tid + 512 * i, t = idx >> 10, c = idx & 1023, g = c >> 8;
    const float* wrow = p.in[I_GWS] + ((size_t)(l * 4 + g) * 128 + t) * 128;
    float mixed = p.in[I_GBS][(size_t)(l * 4 + g) * 128 + t];
#pragma unroll
    for (int s = 0; s < 4; ++s)
      if (s <= t) mixed += wrow[s] * svn[s * 1024 + c];
    const float u = bf2f(P[(R0 + t) * NPJ + C_UB + c]), z = bf2f(P[(R0 + t) * NPJ + C_ZB + c]);
    Y1[(R0 + t) * D + c] = f2bf(u * mixed * silu(z));
  }
  __syncthreads();
}

__device__ __forceinline__ void lru_gemm_pass(const Params& p, int l, int mat, int cp, const bf16_t* sX, bf16_t* sWt,
                                              f32x4 (&acc)[8][2]) {
  const int tid = otid(), lane = tid & 63, wid = tid >> 6, fr = lane & 15, fq = lane >> 4;
  const bf16_t* src = (const bf16_t*)(p.ws + W_WTL) + (size_t)((l * 2 + mat) * 8 + cp * 2) * 16384;
  __syncthreads();
#pragma unroll
  for (int i = 0; i < 8; ++i) {
    int c = tid + 512 * i, r = c >> 4, c8 = c & 15;
    *(uint4*)(sWt + r * 136 + c8 * 8) = *(const uint4*)(src + r * 128 + c8 * 8);
  }
  __syncthreads();
  const int kb = (wid >> 2) * 128;
#pragma unroll
  for (int m = 0; m < 8; ++m) { acc[m][0] = f32x4{0.f, 0.f, 0.f, 0.f}; acc[m][1] = f32x4{0.f, 0.f, 0.f, 0.f}; }
#pragma unroll
  for (int kk = 0; kk < 4; ++kk) {
    bf16x8 wf0 = *(const bf16x8*)(sWt + (wid * 32 + fr) * 136 + kk * 32 + fq * 8);
    bf16x8 wf1 = *(const bf16x8*)(sWt + (wid * 32 + 16 + fr) * 136 + kk * 32 + fq * 8);
#pragma unroll
    for (int m = 0; m < 8; ++m) {
      bf16x8 xf = *(const bf16x8*)(sX + (m * 16 + fr) * 264 + kb + kk * 32 + fq * 8);
      acc[m][0] = mfma16(xf, wf0, acc[m][0]);
      acc[m][1] = mfma16(xf, wf1, acc[m][1]);
    }
  }
}

__device__ __forceinline__ void lru_tile(const Params& p, int l, int tile, int cp, bool sample, char* smem) {
  const int tid = otid(), lane = tid & 63, wid = tid >> 6, fr = lane & 15, fq = lane >> 4;
  bf16_t* sX = (bf16_t*)smem;
  bf16_t* sWt = (bf16_t*)(smem + 67584);
  const bf16_t* P = (const bf16_t*)(p.ws + W_P);
  {
    const int cg8 = tid & 31, tg = tid >> 5, c = cp * 256 + cg8 * 8;
    float w0[8], w1[8], w2[8], w3[8], bb[8];
    const float* cw = p.in[I_CONVW] + (size_t)l * 4 * D + c;
#pragma unroll
    for (int e = 0; e < 8; ++e) { w0[e] = cw[e]; w1[e] = cw[D + e]; w2[e] = cw[2 * D + e]; w3[e] = cw[3 * D + e]; bb[e] = p.in[I_CONVB][(size_t)l * D + c + e]; }
    if (!sample) {
      const int b = tile >> 4, tt0 = (tile & 15) * 128 + tg * 8;
      const size_t rb = (size_t)b * SEQ;
      float x3[8], x2[8], x1[8], cur[8];
#pragma unroll
      for (int e = 0; e < 8; ++e) { x3[e] = 0.f; x2[e] = 0.f; x1[e] = 0.f; }
      if (tt0 > 0) {
        unpack8(*(const uint4*)(P + (rb + tt0 - 3) * NPJ + C_XC + c), x3);
        unpack8(*(const uint4*)(P + (rb + tt0 - 2) * NPJ + C_XC + c), x2);
        unpack8(*(const uint4*)(P + (rb + tt0 - 1) * NPJ + C_XC + c), x1);
      }
#pragma unroll
      for (int i = 0; i < 8; ++i) {
        unpack8(*(const uint4*)(P + (rb + tt0 + i) * NPJ + C_XC + c), cur);
        float xc[8];
#pragma unroll
        for (int e = 0; e < 8; ++e) xc[e] = bb[e] + w0[e] * x3[e] + w1[e] * x2[e] + w2[e] * x1[e] + w3[e] * cur[e];
        *(uint4*)(sX + (tg * 8 + i) * 264 + cg8 * 8) = pack8(xc);
        if ((tile & 15) == 15 && tg == 15 && i >= 5) {
          float* o = p.out + O_CONVP + (((size_t)l * 8 + b) * 3 + (i - 5)) * D + c;
          *(float4*)o = float4{cur[0], cur[1], cur[2], cur[3]};
          *(float4*)(o + 4) = float4{cur[4], cur[5], cur[6], cur[7]};
        }
#pragma unroll
        for (int e = 0; e < 8; ++e) { x3[e] = x2[e]; x2[e] = x1[e]; x1[e] = cur[e]; }
      }
    } else {
#pragma unroll
      for (int q = 0; q < 2; ++q) {
        const int bbi = tile * 32 + tg * 2 + q;
        const float* cb = p.in[I_SCONV] + ((size_t)l * 128 + bbi) * 3 * D + c;
        float x3[8], x2[8], x1[8], cur[8];
#pragma unroll
        for (int e = 0; e < 8; ++e) { x3[e] = cb[e]; x2[e] = cb[D + e]; x1[e] = cb[2 * D + e]; }
#pragma unroll
        for (int i = 0; i < 4; ++i) {
          unpack8(*(const uint4*)(P + ((size_t)NPR + bbi * 4 + i) * NPJ + C_XC + c), cur);
          float xc[8];
#pragma unroll
          for (int e = 0; e < 8; ++e) xc[e] = bb[e] + w0[e] * x3[e] + w1[e] * x2[e] + w2[e] * x1[e] + w3[e] * cur[e];
          *(uint4*)(sX + (tg * 8 + q * 4 + i) * 264 + cg8 * 8) = pack8(xc);
          if (i >= 1) {
            float* o = p.out + O_CONVS + (((size_t)l * 128 + bbi) * 3 + (i - 1)) * D + c;
            *(float4*)o = float4{cur[0], cur[1], cur[2], cur[3]};
            *(float4*)(o + 4) = float4{cur[4], cur[5], cur[6], cur[7]};
          }
#pragma unroll
          for (int e = 0; e < 8; ++e) { x3[e] = x2[e]; x2[e] = x1[e]; x1[e] = cur[e]; }
        }
      }
    }
  }
  f32x4 racc[8][2], iacc[8][2];
  lru_gemm_pass(p, l, 0, cp, sX, sWt, racc);
  lru_gemm_pass(p, l, 1, cp, sX, sWt, iacc);
  const bool first = (!sample) && ((tile & 15) == 0);
#pragma unroll
  for (int n = 0; n < 2; ++n) {
    const int jl = wid * 32 + n * 16 + fr, c = cp * 256 + jl;
    const float bav = p.in[I_BA][(size_t)l * D + c], bxv = p.in[I_BX][(size_t)l * D + c];
    const float ls8 = 8.f * logsig(p.in[I_LAM][(size_t)l * D + c]);
#pragma unroll
    for (int m = 0; m < 8; ++m) {
      int mo = m * 16 + fq * 4;
      asm volatile("" : "+v"(mo));
#pragma unroll
      for (int r = 0; r < 4; ++r) {
        const int t = mo + r;
        const float rg = sigm(racc[m][n][r] + bav), ig = sigm(iacc[m][n][r] + bxv);
        const float av = __expf(ls8 * rg);
        float mult = __builtin_amdgcn_sqrtf(fmaxf(1.f - av * av, 0.f));
        if (first && t == 0) mult = 1.f;
        racc[m][n][r] = av;
        iacc[m][n][r] = mult * ig * bf2f(sX[t * 264 + jl]);
      }
    }
  }
  if (sample) {
    bf16_t* Y2 = (bf16_t*)(p.ws + W_Y) + (size_t)2 * MT * D;
#pragma unroll
    for (int n = 0; n < 2; ++n) {
      const int c = cp * 256 + wid * 32 + n * 16 + fr;
#pragma unroll
      for (int m = 0; m < 8; ++m) {
        int bbi = tile * 32 + m * 4 + fq;
        asm volatile("" : "+v"(bbi));
        float hh = p.in[I_SH][((size_t)l * 128 + bbi) * D + c];
#pragma unroll
        for (int r = 0; r < 4; ++r) {
          hh = racc[m][n][r] * hh + iacc[m][n][r];
          const size_t row = (size_t)NPR + bbi * 4 + r;
          const float z = bf2f(P[row * NPJ + C_ZC + c]);
          Y2[row * D + c] = f2bf(hh * silu(z));
        }
        p.out[O_HS + ((size_t)l * 128 + bbi) * D + c] = hh;
      }
    }
  } else {
    bf16_t* LH = (bf16_t*)(p.ws + W_LH);
    bf16_t* LA = (bf16_t*)(p.ws + W_LA);
    const size_t rb = (size_t)(tile >> 4) * SEQ + (tile & 15) * 128;
#pragma unroll
    for (int n = 0; n < 2; ++n) {
      const int c = cp * 256 + wid * 32 + n * 16 + fr;
      float cA = 1.f, cH = 0.f;
#pragma unroll
      for (int m = 0; m < 8; ++m) {
        int mo = m * 16 + fq * 4;
        asm volatile("" : "+v"(mo));
        float la_[4], lh_[4];
        la_[0] = racc[m][n][0]; lh_[0] = iacc[m][n][0];
#pragma unroll
        for (int r = 1; r < 4; ++r) { la_[r] = la_[r - 1] * racc[m][n][r]; lh_[r] = racc[m][n][r] * lh_[r - 1] + iacc[m][n][r]; }
        float A = la_[3], H = lh_[3];
        float pA = SHU(A, 16), pH = SHU(H, 16);
        if (fq >= 1) { H = A * pH + H; A = A * pA; }
        pA = SHU(A, 32); pH = SHU(H, 32);
        if (fq >= 2) { H = A * pH + H; A = A * pA; }
        float eA = SHU(A, 16), eH = SHU(H, 16);
        if (fq == 0) { eA = 1.f; eH = 0.f; }
        const float tA = shf(A, 48 + fr), tH = shf(H, 48 + fr);
        const float PA = cA * eA, PH = eA * cH + eH;
#pragma unroll
        for (int r = 0; r < 4; ++r) {
          const size_t row = rb + mo + r;
          LA[row * D + c] = f2bf(PA * la_[r]);
          LH[row * D + c] = f2bf(la_[r] * PH + lh_[r]);
        }
        cH = tA * cH + tH;
        cA = cA * tA;
      }
      if (fq == 0) {
        float* LE = (float*)(p.ws + W_LE) + ((size_t)tile * D + c) * 2;
        LE[0] = cA; LE[1] = cH;
      }
    }
  }
  __syncthreads();
}

__device__ __forceinline__ void lru_fix(const Params& p, int l, int tile, int half) {
  const int tid = otid(), c = tid * 2;
  const int b = tile >> 4, seg = tile & 15;
  const float* LE = (const float*)(p.ws + W_LE);
  float H0 = 0.f, H1 = 0.f;
  for (int k = 0; k < seg; ++k) {
    const float4 e = *(const float4*)(LE + ((size_t)(b * 16 + k) * D + c) * 2);
    H0 = e.x * H0 + e.y;
    H1 = e.z * H1 + e.w;
  }
  const bf16_t* P = (const bf16_t*)(p.ws + W_P);
  const bf16_t* LH = (const bf16_t*)(p.ws + W_LH);
  const bf16_t* LA = (const bf16_t*)(p.ws + W_LA);
  bf16_t* Y2 = (bf16_t*)(p.ws + W_Y) + (size_t)2 * MT * D;
  const size_t R0 = (size_t)b * SEQ + seg * 128 + half * 64;
#pragma unroll 8
  for (int rr = 0; rr < 64; ++rr) {
    const size_t row = R0 + rr;
    const unsigned hl = *(const unsigned*)(LH + row * D + c);
    const unsigned al = *(const unsigned*)(LA + row * D + c);
    const unsigned zv = *(const unsigned*)(P + row * NPJ + C_ZC + c);
    const float h0 = bflo(hl) + bflo(al) * H0, h1 = bfhi(hl) + bfhi(al) * H1;
    *(unsigned*)(Y2 + row * D + c) = pk2(h0 * silu(bflo(zv)), h1 * silu(bfhi(zv)));
  }
  if (seg == 15 && half == 1) {
    const float4 e = *(const float4*)(LE + ((size_t)(b * 16 + 15) * D + c) * 2);
    float2 o = {e.x * H0 + e.y, e.z * H1 + e.w};
    *(float2*)(p.out + O_HP + ((size_t)l * 8 + b) * D + c) = o;
  }
}

__device__ __forceinline__ void x4_unit(const Params& p, int l, int pm, int pn, char* smem) {
  float* MF = (float*)(p.ws + W_MF);
  bf16_t* MB = (bf16_t*)(p.ws + W_MB);
  const bf16_t* const P = (const bf16_t*)(p.ws + W_P);
#pragma unroll 1
  for (int br = 0; br < 3; ++br) {
    const bf16_t* A = (const bf16_t*)(p.ws + W_Y) + (size_t)br * MT * D;
    const bf16_t* Bt = (const bf16_t*)(p.ws + W_WTP) + (size_t)(l * 4 + br) * D * D;
    f32x4 acc[2][2][4][2];
    gemm_tile(A, Bt, pm * 256, pn * 256, smem, acc);
    EPI_IDX
    EPI_LOOP {
      const int row = pm * 256 + ai * 128 + wr * 64 + m * 16 + fr, col = pn * 256 + bj * 128 + wc * 32 + n * 16 + fq * 4;
      const uint2 gv = *(const uint2*)(P + (size_t)row * NPJ + C_GA + br * 1024 + col);
      float4 v = {acc[ai][bj][m][n][0] * sigm(bflo(gv.x)), acc[ai][bj][m][n][1] * sigm(bfhi(gv.x)),
                  acc[ai][bj][m][n][2] * sigm(bflo(gv.y)), acc[ai][bj][m][n][3] * sigm(bfhi(gv.y))};
      uint2* mf = (uint2*)((bf16_t*)MF + (size_t)row * D + col);
      if (br == 0) {
        uint2 ob; ob.x = pk2(v.x, v.y); ob.y = pk2(v.z, v.w); *mf = ob;
      } else {
        const uint2 o = *mf;
        v.x += bflo(o.x); v.y += bfhi(o.x); v.z += bflo(o.y); v.w += bfhi(o.y);
        uint2 ob; ob.x = pk2(v.x, v.y); ob.y = pk2(v.z, v.w);
        if (br == 1) *mf = ob;
        else *(uint2*)(MB + (size_t)row * D + col) = ob;
      }
    }
  }
}
__device__ __forceinline__ void x5_unit(const Params& p, int l, int pm, int pn, char* smem) {
  const bf16_t* A = (const bf16_t*)(p.ws + W_MB);
  const bf16_t* Bt = (const bf16_t*)(p.ws + W_WTP) + (size_t)(l * 4 + 3) * D * D;
  float* PRE = (float*)(p.ws + W_PRE);
  const float* XF = (const float*)(p.ws + W_XF);
  f32x4 acc[2][2][4][2];
  gemm_tile(A, Bt, pm * 256, pn * 256, smem, acc);
  EPI_IDX
  EPI_LOOP {
    const int row = pm * 256 + ai * 128 + wr * 64 + m * 16 + fr, col = pn * 256 + bj * 128 + wc * 32 + n * 16 + fq * 4;
    const float* xr = (l == 0) ? (row < NPR ? p.in[I_XP] + (size_t)row * D : p.in[I_XS] + (size_t)(row - NPR) * D)
                               : XF + (size_t)row * D;
    const float4 xv = *(const float4*)(xr + col);
    float4 v = {ALPHA * xv.x + acc[ai][bj][m][n][0], ALPHA * xv.y + acc[ai][bj][m][n][1],
                ALPHA * xv.z + acc[ai][bj][m][n][2], ALPHA * xv.w + acc[ai][bj][m][n][3]};
    *(float4*)(PRE + (size_t)row * D + col) = v;
  }
}
__device__ __forceinline__ void dep_signal(unsigned* ctr) {
  asm volatile("s_waitcnt vmcnt(0)" ::: "memory");
  __syncthreads();
  if (threadIdx.x == 0) {
    __builtin_amdgcn_fence(__ATOMIC_RELEASE, "agent");
    asm volatile("s_waitcnt vmcnt(0)" ::: "memory");
    (void)__hip_atomic_fetch_add(ctr, 1u, __ATOMIC_RELAXED, __HIP_MEMORY_SCOPE_AGENT);
  }
}
__device__ __forceinline__ void dep_wait(unsigned* ctr, unsigned target) {
  if (threadIdx.x == 0) {
    unsigned sp = 0;
    while (__hip_atomic_load(ctr, __ATOMIC_RELAXED, __HIP_MEMORY_SCOPE_AGENT) < target) {
      __builtin_amdgcn_s_sleep(2);
      if (++sp > (1u << 24)) break;
    }
    __builtin_amdgcn_fence(__ATOMIC_ACQUIRE, "agent");
    asm volatile("s_waitcnt vmcnt(0)" ::: "memory");
  }
  __syncthreads();
}

#define XB_TMO 128
#define XB_XCNT(j) (256 + 64 * (j))
#define XB_XSUB(j) (1280 + 64 * (j))
#define XB_XGEN(j) (2304 + 64 * (j))
#define XB_TOP 3328
#define XB_TOPGEN 3392
#define XCD_BAR_WORDS 3456
#define XB_SPIN_CAP (1u << 22)
__device__ __forceinline__ unsigned xb_ld(unsigned* p) { return __hip_atomic_load(p, __ATOMIC_RELAXED, __HIP_MEMORY_SCOPE_AGENT); }
__device__ __forceinline__ unsigned xb_add(unsigned* p, unsigned v) { return __hip_atomic_fetch_add(p, v, __ATOMIC_RELAXED, __HIP_MEMORY_SCOPE_AGENT); }
__device__ __forceinline__ unsigned xb_xcc_id() { return (unsigned)__builtin_amdgcn_s_getreg((3 << 11) | 20) & 0xFu; }
#define XB_SPIN(cond, bar) do { unsigned _sp = 0; while (cond) { __builtin_amdgcn_s_sleep(1); \
    if ((++_sp & 255u) == 0u) { if (xb_ld(&(bar)[XB_TMO])) break; if (_sp > XB_SPIN_CAP) { atomicAdd(&(bar)[XB_TMO], 1u); break; } } } } while (0)
struct XcdBarrier { unsigned* bar; unsigned x; volatile LDSP(unsigned) st; };
__device__ __forceinline__ XcdBarrier xcd_barrier_post(unsigned* bar, volatile LDSP(unsigned) st) {
  XcdBarrier b; b.bar = bar; b.x = xb_xcc_id(); b.st = st;
  if (threadIdx.x == 0) (void)xb_add(&bar[XB_XCNT(b.x)], 1u);
  return b;
}
__device__ __forceinline__ void xcd_barrier_complete(unsigned* bar, unsigned x, unsigned& nloc, unsigned& nx) {
  const unsigned G = gridDim.x * gridDim.y * gridDim.z;
  unsigned sum, cnt, mine, sp = 0u;
  for (;;) {
    sum = 0u; cnt = 0u; mine = 0u;
#pragma unroll
    for (unsigned j = 0; j < 16; ++j) { const unsigned c = xb_ld(&bar[XB_XCNT(j)]); sum += c; cnt += (c > 0u) ? 1u : 0u; mine = (j == x) ? c : mine; }
    if (sum == G) break;
    __builtin_amdgcn_s_sleep(1);
    if ((++sp & 255u) == 0u) { if (xb_ld(&bar[XB_TMO])) break; if (sp > XB_SPIN_CAP) { atomicAdd(&bar[XB_TMO], 1u); break; } }
  }
  nloc = mine > 0u ? mine : 1u; nx = cnt > 0u ? cnt : 1u;
}
__device__ __forceinline__ void xcd_barrier(const XcdBarrier& b) {
  asm volatile("s_waitcnt vmcnt(0)" ::: "memory");
  __syncthreads();
  if (threadIdx.x == 0) {
    unsigned* bar = b.bar;
    __builtin_amdgcn_s_waitcnt(0);
    unsigned nloc = b.st[0], nx = b.st[1];
    if (nloc == 0u) { xcd_barrier_complete(bar, b.x, nloc, nx); b.st[0] = nloc; b.st[1] = nx; }
    const unsigned old = xb_add(&bar[XB_XSUB(b.x)], 1u);
    const unsigned gen = old / nloc;
    if (old + 1u == (gen + 1u) * nloc) {
      __builtin_amdgcn_fence(__ATOMIC_RELEASE, "agent");
      asm volatile("s_waitcnt vmcnt(0)" ::: "memory");
      const unsigned og = xb_add(&bar[XB_TOP], 1u);
      const unsigned tg = og / nx;
      if (og + 1u == (tg + 1u) * nx) xb_add(&bar[XB_TOPGEN], 1u);
      else XB_SPIN(xb_ld(&bar[XB_TOPGEN]) == tg, bar);
      __builtin_amdgcn_fence(__ATOMIC_ACQUIRE, "agent");
      xb_add(&bar[XB_XGEN(b.x)], 1u);
      asm volatile("s_waitcnt vmcnt(0)" ::: "memory");
    } else {
      XB_SPIN(xb_ld(&bar[XB_XGEN(b.x)]) == gen, bar);
      __builtin_amdgcn_fence(__ATOMIC_ACQUIRE, "agent");
      asm volatile("s_waitcnt vmcnt(0)" ::: "memory");
    }
  }
  __syncthreads();
}

__global__ void __launch_bounds__(512) mega(Params p) {
  extern __shared__ __attribute__((aligned(16))) char smem[];
  cg::grid_group grid = cg::this_grid();
  const int G = gridDim.x, bid = blockIdx.x;
  volatile LDSP(unsigned) xst = (volatile LDSP(unsigned))(smem + LDS_TOTAL - 16);
  if (threadIdx.x == 0) { xst[0] = 0u; xst[1] = 0u; xst[2] = 0u; xst[3] = 0u; }
  __syncthreads();
  XcdBarrier xb = xcd_barrier_post((unsigned*)(p.ws + W_BAR), xst);
  phase_convert(p, smem, 0, 1);
  row_pass(p, 0, smem);
  grid.sync();
#pragma unroll 1
  for (int l = 0; l < NL; ++l) {
    for (int it = bid; it < 32; it += G) mlstm_scalars(p, l, it, smem);
    REP(0) {
      const bf16_t* A = (const bf16_t*)(p.ws + W_XB);
      const bf16_t* Bt = (const bf16_t*)(p.ws + W_WTIN) + (size_t)l * NPJ * D;
      const float* bias = p.in[I_BIN] + (size_t)l * INW;
      bf16_t* const P = (bf16_t*)(p.ws + W_P);
      bool primed = false;
#pragma unroll 1
      for (int L = bid; L < 66 * 52; L += G) {
        int pm, pn; tile_map(L, 66, 52, pm, pn, 4);
        f32x4 acc[2][2][4][2];
        gemm_tile(A, Bt, pm * 256, pn * 256, smem, acc, primed);
        EPI_IDX
        float4 bvv[2][2];
#pragma unroll
        for (int bj = 0; bj < 2; ++bj)
#pragma unroll
          for (int n = 0; n < 2; ++n) {
            const int col = pn * 256 + bj * 128 + wc * 32 + n * 16 + fq * 4;
            bvv[bj][n] = *(const float4*)(bias + col + (col >= 5120 ? 8 : 0));
          }
        asm volatile("s_waitcnt vmcnt(0)" ::: "memory");
        primed = (L + G < 66 * 52);
        if (primed) { int pm2, pn2; tile_map(L + G, 66, 52, pm2, pn2, 4); gemm_tile(A, Bt, pm2 * 256, pn2 * 256, smem, acc, false, true); }
        EPI_LOOP {
          const int row = pm * 256 + ai * 128 + wr * 64 + m * 16 + fr, col = pn * 256 + bj * 128 + wc * 32 + n * 16 + fq * 4;
          const float4 bv = bvv[bj][n];
          uint2 o;
          o.x = pk2(acc[ai][bj][m][n][0] + bv.x, acc[ai][bj][m][n][1] + bv.y);
          o.y = pk2(acc[ai][bj][m][n][2] + bv.z, acc[ai][bj][m][n][3] + bv.w);
          *(uint2*)(P + (size_t)row * NPJ + col) = o;
        }
      }
    }
    GSYNC;
    {
      constexpr int Q_S = 656, Q_X4 = Q_S + 8, Q_F1 = Q_X4 + 256, Q_X5 = Q_F1 + 8, Q_FN = Q_X5 + 128, Q_F2 = Q_FN + 128, Q_LR = Q_F2 + 512,
                    Q_F3 = Q_LR + 128, Q_G2 = Q_F3 + 512;
      unsigned* qbase = (unsigned*)(p.ws + W_QCT) + l * 64;
      volatile LDSP(int) qslot = (volatile LDSP(int))(smem + LDS_TOTAL - 32);
      if (threadIdx.x == 0) qslot[0] = (int)xb_add(qbase, 1u);
      __syncthreads();
      int it = qslot[0];
#pragma unroll 1
      while (it < Q_G2) {
        __syncthreads();
        int nxt = 0;
        int r = it, fq_ = -1, fbh = 0;
        if (r >= Q_X4 && r < Q_F1) { fq_ = 15 - ((r - Q_X4) >> 5); fbh = (r - Q_X4) & 31; }
        else if (r >= Q_FN && r < Q_F2) { fq_ = 7 - ((r - Q_FN) >> 5); fbh = (r - Q_FN) & 31; }
        else if (r >= Q_LR && r < Q_F3) { fq_ = 3 - ((r - Q_LR) >> 5); fbh = (r - Q_LR) & 31; }
        if (fq_ < 0 && threadIdx.x == 0) nxt = (int)xb_add(qbase, 1u);
        if (fq_ >= 0) { mlstm_flash(p, l, fbh, fq_, smem); if (threadIdx.x == 0) nxt = (int)xb_add(qbase, 1u); }
        else if (r < Q_S) {
          if (r < 512) mlstm_sample(p, l, r >> 2, r & 3, smem);
          else if (r < 640) gmlp_sample(p, l, r - 512, smem);
          else lru_tile(p, l, (r - 640) >> 2, r & 3, true, smem);
          dep_signal(qbase + 16);
        }
        else if (r < Q_X4) { r -= Q_S; dep_wait(qbase + 16, 656u); x4_unit(p, l, 64 + (r >> 2), r & 3, smem); dep_signal(qbase + 32 + 16 * (r >> 2)); }
        else if (r < Q_X5) { r -= Q_F1; dep_wait(qbase + 32 + 16 * (r >> 2), 4u); x5_unit(p, l, 64 + (r >> 2), r & 3, smem); }
        else if (r < Q_FN) { r -= Q_X5; mlstm_final(p, l, r >> 2, r & 3, smem); }
        else if (r < Q_LR) { r -= Q_F2; lru_tile(p, l, r >> 2, r & 3, false, smem); }
        else { r -= Q_F3; gmlp_prompt(p, l, r >> 6, (r >> 2) & 15, r & 3, smem); }
        if (threadIdx.x == 0) qslot[0] = nxt;
        __syncthreads();
        it = qslot[0];
      }
      if (l == 0) phase_convert(p, smem, 1, NL);
    }
    GSYNC;
    for (int it = bid; it < 256; it += G) lru_fix(p, l, it >> 1, it & 1);
    GSYNC;
#pragma unroll 1
    for (int L = bid; L < 64 * 4; L += G) { int pm, pn; tile_map(L, 64, 4, pm, pn); x4_unit(p, l, pm, pn, smem); }
    GSYNC;
#pragma unroll 1
    for (int L = bid; L < 64 * 4; L += G) { int pm, pn; tile_map(L, 64, 4, pm, pn); x5_unit(p, l, pm, pn, smem); }
    GSYNC;
    row_pass(p, l + 1, smem);
    GSYNC;
  }
}

extern "C" void kernel_launch(void* const* d_in, const int* in_sizes, int n_in, void* d_out, int out_size, void* d_ws,
                              size_t ws_size, hipStream_t stream) {
  constexpr size_t kLds = LDS_TOTAL;
  static int grid_blocks = 0;
  if (!grid_blocks) {
    int dev = 0, cus = 0, per_cu = 0;
    (void)hipGetDevice(&dev);
    (void)hipDeviceGetAttribute(&cus, hipDeviceAttributeMultiprocessorCount, dev);
    (void)hipFuncSetAttribute((const void*)mega, hipFuncAttributeMaxDynamicSharedMemorySize, (int)kLds);
    (void)hipOccupancyMaxActiveBlocksPerMultiprocessor(&per_cu, (const void*)mega, 512, kLds);
    if (per_cu < 1) per_cu = 1;
    grid_blocks = cus * per_cu;
    if (grid_blocks % 8) grid_blocks -= grid_blocks % 8;
    if (ws_size < W_END || n_in != 27 || (size_t)out_size != O_END)
      fprintf(stderr, "kernel_launch: unexpected sizes ws %zu (need %zu) n_in %d out %d (expect %zu)\n", ws_size,
              (size_t)W_END, n_in, out_size, (size_t)O_END);
  }
  (void)hipMemsetAsync((char*)d_ws + W_BAR, 0, W_CTL_END - W_BAR, stream);
  Params p{};
  for (int i = 0; i < 27; ++i) p.in[i] = (const float*)d_in[i];
  p.out = (float*)d_out;
  p.ws = (char*)d_ws;
  void* args[] = {&p};
  hipError_t e = hipLaunchCooperativeKernel((const void*)mega, dim3(grid_blocks), dim3(512), args, kLds, stream);
  if (e != hipSuccess) fprintf(stderr, "cooperative launch failed: %s (grid %d)\n", hipGetErrorString(e), grid_blocks);
}
```

```cpp
#include <hip/hip_runtime.h>
#include <hip/hip_cooperative_groups.h>
#include <cstdio>
#include <cstdint>
namespace cg = cooperative_groups;

typedef unsigned short bf16_t;
typedef short bf16x8 __attribute__((ext_vector_type(8)));
typedef short s16x4 __attribute__((ext_vector_type(4)));
typedef float f32x4 __attribute__((ext_vector_type(4)));
#define LDSP(T) __attribute__((address_space(3))) T*

constexpr int D = 1024, NPR = 16384, NSM = 512, MT = 16896, NL = 4, SEQ = 2048;
constexpr int INW = 13320, NPJ = 13312;
constexpr int C_Q = 0, C_K = 1024, C_V = 2048, C_O = 3072, C_ZA = 4096, C_UB = 5120, C_VB = 6144, C_ZB = 7168,
              C_XC = 8192, C_ZC = 9216, C_GA = 10240;
constexpr float ALPHA = 1.6817928305074292f;
constexpr float EPS = 1e-5f;
constexpr int LDS_TOTAL = 150 * 1024;
#ifndef DUP_PHASE
#define DUP_PHASE -1
#endif
#define GSYNC xcd_barrier(xb)
#define REP(k) for (int rep_ = 0; rep_ < ((DUP_PHASE == (k)) ? 2 : 1); ++rep_)

constexpr size_t W_WTIN = 0;
constexpr size_t W_WTP = W_WTIN + (size_t)NL * NPJ * D * 2;
constexpr size_t W_WTL = W_WTP + (size_t)NL * 4 * D * D * 2;
constexpr size_t W_WM = W_WTL + (size_t)NL * 2 * 8 * 128 * 128 * 2;
constexpr size_t W_XB = W_WM + (size_t)NL * 4 * 128 * 128 * 2;
constexpr size_t W_XF = W_XB + (size_t)MT * D * 2;
constexpr size_t W_GATE = W_XF + (size_t)MT * D * 4;
constexpr size_t W_P = W_GATE + (size_t)MT * 8 * 4;
constexpr size_t W_PRE = W_P + (size_t)MT * NPJ * 2;
constexpr size_t W_MF = W_PRE + (size_t)MT * D * 4;
constexpr size_t W_MB = W_MF + (size_t)MT * D * 4;
constexpr size_t W_Y = W_MB + (size_t)MT * D * 2;
constexpr size_t W_G = W_Y + (size_t)3 * MT * D * 2;
constexpr size_t W_MX = W_G + (size_t)32 * 2048 * 4;
constexpr size_t W_EM = W_MX + (size_t)32 * 2048 * 4;
constexpr size_t W_LH = W_EM + (size_t)32 * 2048 * 4;
constexpr size_t W_LA = W_LH + (size_t)NPR * D * 2;
constexpr size_t W_LE = W_LA + (size_t)NPR * D * 2;
constexpr size_t W_BAR = W_LE + (size_t)8 * 16 * 1024 * 2 * 4;
constexpr size_t W_QCT = W_BAR + 3456 * 4;
constexpr size_t W_CTL_END = W_QCT + 4 * 256;
constexpr size_t W_END = W_CTL_END;

constexpr size_t O_Y = 0;
constexpr size_t O_CP = (size_t)MT * D;
constexpr size_t O_NP = O_CP + (size_t)NL * 8 * 4 * 256 * 256;
constexpr size_t O_MP = O_NP + (size_t)NL * 8 * 4 * 256;
constexpr size_t O_CONVP = O_MP + (size_t)NL * 8 * 4;
constexpr size_t O_HP = O_CONVP + (size_t)NL * 8 * 3 * 1024;
constexpr size_t O_CS = O_HP + (size_t)NL * 8 * 1024;
constexpr size_t O_NS = O_CS + (size_t)NL * 128 * 4 * 256 * 256;
constexpr size_t O_MS = O_NS + (size_t)NL * 128 * 4 * 256;
constexpr size_t O_CONVS = O_MS + (size_t)NL * 128 * 4;
constexpr size_t O_HS = O_CONVS + (size_t)NL * 128 * 3 * 1024;
constexpr size_t O_VS = O_HS + (size_t)NL * 128 * 1024;
constexpr size_t O_END = O_VS + (size_t)NL * 128 * 4 * 1024;

enum { I_XP = 0, I_XS, I_SC, I_SN, I_SM, I_SCONV, I_SH, I_WIN, I_BIN, I_NORMG, I_GLNG, I_GLNB, I_GWS, I_GBS, I_CONVW,
       I_CONVB, I_WA, I_BA, I_WX, I_BX, I_LAM, I_WPA, I_WPB, I_WPC, I_WOUT, I_LNG, I_LNB };

struct Params {
  const float* in[27];
  float* out;
  char* ws;
};

__device__ __forceinline__ bf16_t f2bf(float f) {
  unsigned u = __float_as_uint(f);
  u += 0x7fffu + ((u >> 16) & 1u);
  return (bf16_t)(u >> 16);
}
__device__ __forceinline__ float bf2f(bf16_t h) { return __uint_as_float(((unsigned)h) << 16); }
__device__ __forceinline__ unsigned pk2(float a, float b) {
  unsigned r;
  asm("v_cvt_pk_bf16_f32 %0, %1, %2" : "=v"(r) : "v"(a), "v"(b));
  return r;
}
__device__ __forceinline__ float bflo(unsigned u) { return __uint_as_float(u << 16); }
__device__ __forceinline__ float bfhi(unsigned u) { return __uint_as_float(u & 0xffff0000u); }
__device__ __forceinline__ float sigm(float x) { return __builtin_amdgcn_rcpf(1.f + __expf(-x)); }
__device__ __forceinline__ float silu(float x) { return x * sigm(x); }
__device__ __forceinline__ float logsig(float x) { return fminf(x, 0.f) - log1pf(__expf(-fabsf(x))); }
__device__ __forceinline__ float shf(float v, int src) {
  return __int_as_float(__builtin_amdgcn_ds_bpermute(src << 2, __float_as_int(v)));
}
#define SHX(v, o) shf((v), lane ^ (o))
#define SHU(v, o) shf((v), (lane >= (o)) ? lane - (o) : lane)
__device__ __forceinline__ float wave_sum_l(float v, int lane) {
#pragma unroll
  for (int o = 1; o < 64; o <<= 1) v += shf(v, lane ^ o);
  return v;
}
#define wave_sum(v) wave_sum_l((v), lane)
__device__ __forceinline__ f32x4 mfma16(bf16x8 a, bf16x8 b, f32x4 c) {
  return __builtin_amdgcn_mfma_f32_16x16x32_bf16(a, b, c, 0, 0, 0);
}
__device__ __forceinline__ bf16x8 frag_t(const bf16_t* T, int stride, int r0, int k0, int lane) {
  const int fr = lane & 15, fq = lane >> 4;
  const bf16_t* q = T + (k0 + fq * 8 + (fr >> 2)) * stride + r0 + (fr & 3) * 4;
  s16x4 a = __builtin_amdgcn_ds_read_tr16_b64_v4i16((LDSP(s16x4))q);
  s16x4 b = __builtin_amdgcn_ds_read_tr16_b64_v4i16((LDSP(s16x4))(q + 4 * stride));
  bf16x8 r = {a[0], a[1], a[2], a[3], b[0], b[1], b[2], b[3]};
  return r;
}
__device__ __forceinline__ void unpack8(uint4 v, float* f) {
  f[0] = bflo(v.x); f[1] = bfhi(v.x); f[2] = bflo(v.y); f[3] = bfhi(v.y);
  f[4] = bflo(v.z); f[5] = bfhi(v.z); f[6] = bflo(v.w); f[7] = bfhi(v.w);
}
__device__ __forceinline__ uint4 pack8(const float* f) {
  uint4 o; o.x = pk2(f[0], f[1]); o.y = pk2(f[2], f[3]); o.z = pk2(f[4], f[5]); o.w = pk2(f[6], f[7]);
  return o;
}

__device__ __forceinline__ int otid() { int t = threadIdx.x; asm volatile("" : "+v"(t)); return t; }

__device__ __forceinline__ void tconv_item(const float* src, int lds_, bf16_t* dst, int ldd, int k0, int n0s, int n0d,
                                           float* scr, int lane) {
#pragma unroll 8
  for (int i = 0; i < 32; ++i) {
    const int kk = 2 * i + (lane >> 5);
    scr[kk * 33 + (lane & 31)] = src[(size_t)(k0 + kk) * lds_ + n0s + (lane & 31)];
  }
  const int c = lane & 7;
#pragma unroll
  for (int j = 0; j < 4; ++j) {
    const int n = (lane >> 3) + 8 * j;
    const float* t = scr + (8 * c) * 33 + n;
    uint4 o;
    o.x = pk2(t[0 * 33], t[1 * 33]); o.y = pk2(t[2 * 33], t[3 * 33]);
    o.z = pk2(t[4 * 33], t[5 * 33]); o.w = pk2(t[6 * 33], t[7 * 33]);
    *(uint4*)(dst + (size_t)(n0d + n) * ldd + k0 + 8 * c) = o;
  }
}

__device__ __forceinline__ void phase_convert(const Params& p, char* smem) {
  const int tid = otid(), lane = tid & 63, wid = tid >> 6;
  float* scr = (float*)smem + wid * (64 * 33);
  constexpr int N_IN = NL * 16 * 416, N_PJ = NL * 4 * 16 * 32, N_LR = NL * 2 * 8 * 8;
  for (int it = blockIdx.x * 8 + wid; it < N_IN + N_PJ + N_LR; it += gridDim.x * 8) {
    int r = it;
    if (r < N_IN) {
      int l = r / (16 * 416), q = r % (16 * 416), kt = q / 416, nt = q % 416;
      int n0d = nt * 32, n0s = n0d + (n0d >= 5120 ? 8 : 0);
      tconv_item(p.in[I_WIN] + (size_t)l * D * INW, INW, (bf16_t*)(p.ws + W_WTIN) + (size_t)l * NPJ * D, D, kt * 64, n0s,
                 n0d, scr, lane);
      continue;
    }
    r -= N_IN;
    if (r < N_PJ) {
      int lm = r >> 9, q = r & 511, kt = q >> 5, nt = q & 31, l = lm >> 2, mat = lm & 3;
      const float* src = p.in[I_WPA + mat] + (size_t)l * D * D;
      tconv_item(src, D, (bf16_t*)(p.ws + W_WTP) + (size_t)lm * D * D, D, kt * 64, nt * 32, nt * 32, scr, lane);
      continue;
    }
    r -= N_PJ;
    {
      int q = r & 7, lmn = r >> 3, n = lmn & 7, mat = (lmn >> 3) & 1, l = lmn >> 4;
      const float* src = p.in[mat ? I_WX : I_WA] + (size_t)(l * 8 + n) * 16384;
      tconv_item(src, 128, (bf16_t*)(p.ws + W_WTL) + (size_t)((l * 2 + mat) * 8 + n) * 16384, 128, (q >> 2) * 64,
                 (q & 3) * 32, (q & 3) * 32, scr, lane);
    }
  }
  __syncthreads();
  bf16_t* wm = (bf16_t*)(p.ws + W_WM);
  const float* gws = p.in[I_GWS];
  for (int idx = blockIdx.x * 512 + otid(); idx < NL * 4 * 128 * 128; idx += gridDim.x * 512) {
    int t = (idx >> 7) & 127, s = idx & 127;
    wm[idx] = f2bf(s <= t ? gws[idx] : 0.f);
  }
}

__device__ __forceinline__ void row_pass(const Params& p, int l, char* smem) {
  const int tid = otid(), lane = tid & 63, wid = tid >> 6;
  float* sWg = (float*)smem;
  if (l < NL) {
    const float* w = p.in[I_WIN] + (size_t)l * D * INW;
    for (int idx = tid; idx < 8192; idx += 512) {
      int j = idx >> 10, k = idx & 1023;
      sWg[idx] = w[(size_t)k * INW + 5120 + j];
    }
  }
  __syncthreads();
  bf16_t* XB = (bf16_t*)(p.ws + W_XB);
  float* XF = (float*)(p.ws + W_XF);
  const float* PRE = (const float*)(p.ws + W_PRE);
  float* GATE = (float*)(p.ws + W_GATE);
  for (int r = blockIdx.x * 8 + wid; r < MT; r += gridDim.x * 8) {
    float4 v[4];
    if (l == 0) {
      const float* src = r < NPR ? p.in[I_XP] + (size_t)r * D : p.in[I_XS] + (size_t)(r - NPR) * D;
#pragma unroll
      for (int i = 0; i < 4; ++i) v[i] = ((const float4*)src)[lane + 64 * i];
    } else {
      const float* src = PRE + (size_t)r * D;
      float s = 0.f;
#pragma unroll
      for (int i = 0; i < 4; ++i) { v[i] = ((const float4*)src)[lane + 64 * i]; s += (v[i].x + v[i].y) + (v[i].z + v[i].w); }
      const float mean = wave_sum(s) * (1.f / D);
      float s2 = 0.f;
#pragma unroll
      for (int i = 0; i < 4; ++i) {
        v[i].x -= mean; v[i].y -= mean; v[i].z -= mean; v[i].w -= mean;
        s2 += (v[i].x * v[i].x + v[i].y * v[i].y) + (v[i].z * v[i].z + v[i].w * v[i].w);
      }
      const float rstd = rsqrtf(wave_sum(s2) * (1.f / D) + EPS);
      const float4* g4 = (const float4*)(p.in[I_LNG] + (size_t)(l - 1) * D);
      const float4* b4 = (const float4*)(p.in[I_LNB] + (size_t)(l - 1) * D);
      float* dst = (l == NL) ? p.out + O_Y + (size_t)r * D : XF + (size_t)r * D;
#pragma unroll
      for (int i = 0; i < 4; ++i) {
        float4 g = g4[lane + 64 * i], b = b4[lane + 64 * i];
        v[i].x = v[i].x * rstd * g.x + b.x; v[i].y = v[i].y * rstd * g.y + b.y;
        v[i].z = v[i].z * rstd * g.z + b.z; v[i].w = v[i].w * rstd * g.w + b.w;
        ((float4*)dst)[lane + 64 * i] = v[i];
      }
    }
    if (l < NL) {
#pragma unroll
      for (int i = 0; i < 4; ++i) {
        uint2 o; o.x = pk2(v[i].x, v[i].y); o.y = pk2(v[i].z, v[i].w);
        ((uint2*)(XB + (size_t)r * D))[lane + 64 * i] = o;
      }
      float ga[8];
#pragma unroll
      for (int j = 0; j < 8; ++j) {
        float a = 0.f;
#pragma unroll
        for (int i = 0; i < 4; ++i) {
          float4 w = ((const float4*)(sWg + j * 1024))[lane + 64 * i];
          a += v[i].x * w.x + v[i].y * w.y + v[i].z * w.z + v[i].w * w.w;
        }
        ga[j] = wave_sum(a);
      }
      if (lane == 0) {
        const float* bi = p.in[I_BIN] + (size_t)l * INW + 5120;
        float4 o0 = {ga[0] + bi[0], ga[1] + bi[1], ga[2] + bi[2], ga[3] + bi[3]};
        float4 o1 = {ga[4] + bi[4], ga[5] + bi[5], ga[6] + bi[6], ga[7] + bi[7]};
        ((float4*)(GATE + (size_t)r * 8))[0] = o0;
        ((float4*)(GATE + (size_t)r * 8))[1] = o1;
      }
    }
  }
  __syncthreads();
}

constexpr int KD = 1024, BK = 64, HALF = 128, HTB = HALF * BK * 2;
__device__ __forceinline__ int lds_byte(int r, int c) {
  int st = (r >> 4) * 2 + (c >> 5), rr = r & 15, cc = c & 31, ob = rr * 64 + cc * 2;
  return st * 1024 + (ob ^ (((ob >> 9) & 1) << 5));
}
__device__ __forceinline__ void stage_rc(int b, int& R, int& C) {
  int st = b / 1024, sb = b % 1024, swz = sb ^ (((sb >> 9) & 1) << 5);
  R = (st >> 1) * 16 + swz / 64;
  C = (st & 1) * 32 + (swz % 64) / 2;
}
__device__ __forceinline__ void tile_map(int L, int nM, int nN, int& pm, int& pn, int WGM_ = 8) {
  int nwg = nM * nN, q = nwg / 8, r = nwg % 8, xcd = L % 8, off = L / 8;
  int wgid = (xcd < r ? xcd * (q + 1) : r * (q + 1) + (xcd - r) * q) + off;
  int nig = WGM_ * nN, gid = wgid / nig, fm = gid * WGM_, gsz = min(nM - fm, WGM_);
  pm = fm + ((wgid % nig) % gsz);
  pn = (wgid % nig) / gsz;
}

__device__ __forceinline__ void gemm_tile(const bf16_t* __restrict__ A, const bf16_t* __restrict__ Bt, int brow, int bcol,
                                          char* shm, f32x4 (&acc)[2][2][4][2], bool primed = false, bool prime_only = false) {
#define SAO(b, h) (((b) * 2 + (h)) * HTB)
#define SBO(b, h) ((4 + (b) * 2 + (h)) * HTB)
#define STAGE(BO, BASE, br, kt)                                                                              \
  do {                                                                                                       \
    const char* _gb = (const char*)(BASE) + ((size_t)(br) * KD + (size_t)(kt) * BK) * 2;                     \
    __builtin_amdgcn_global_load_lds((const unsigned*)(_gb + toff0), (unsigned*)(shm + (BO) + tb0), 16, 0, 0); \
    __builtin_amdgcn_global_load_lds((const unsigned*)(_gb + toff1), (unsigned*)(shm + (BO) + tb1), 16, 0, 0); \
  } while (0)
#define LDA(dst, b, h)                                                                                         \
  _Pragma("unroll") for (int m = 0; m < 4; ++m) _Pragma("unroll") for (int k = 0; k < 2; ++k) dst[m][k] =      \
      *reinterpret_cast<const bf16x8*>(shm + SAO(b, h) + lds_byte(wr * 64 + m * 16 + fr, k * 32 + fq * 8))
#define LDB(dst, b, h)                                                                                         \
  _Pragma("unroll") for (int n = 0; n < 2; ++n) _Pragma("unroll") for (int k = 0; k < 2; ++k) dst[n][k] =      \
      *reinterpret_cast<const bf16x8*>(shm + SBO(b, h) + lds_byte(wc * 32 + n * 16 + fr, k * 32 + fq * 8))
#define MMA(ai, bj, At_, Bt_)                                                                               \
  do {                                                                                                      \
    __builtin_amdgcn_s_setprio(1);                                                                          \
    _Pragma("unroll") for (int m = 0; m < 4; ++m) _Pragma("unroll") for (int n = 0; n < 2; ++n)             \
        _Pragma("unroll") for (int k = 0; k < 2; ++k) acc[ai][bj][m][n] =                                   \
            __builtin_amdgcn_mfma_f32_16x16x32_bf16(Bt_[n][k], At_[m][k], acc[ai][bj][m][n], 0, 0, 0);     \
    __builtin_amdgcn_s_setprio(0);                                                                          \
  } while (0)
#define WAIT_V(n) asm volatile("s_waitcnt vmcnt(" #n ")" ::: "memory")
#define WAIT_L(n) asm volatile("s_waitcnt lgkmcnt(" #n ")" ::: "memory")
#define BAR __builtin_amdgcn_s_barrier()
#define SCHED __builtin_amdgcn_sched_barrier(0)
  const int tidg = otid();
  const int wid = tidg >> 6, lane = tidg & 63, wr = wid >> 2, wc = wid & 3, fr = lane & 15, fq = lane >> 4;
  const int tb0 = tidg * 16, tb1 = tb0 + 8192;
  unsigned toff0, toff1;
  {
    int r_, c_;
    stage_rc(tb0, r_, c_); toff0 = (unsigned)(r_ * KD + c_) * 2u;
    stage_rc(tb1, r_, c_); toff1 = (unsigned)(r_ * KD + c_) * 2u;
  }
  if (prime_only) {
    STAGE(SBO(0, 0), Bt, bcol, 0); STAGE(SAO(0, 0), A, brow, 0);
    STAGE(SBO(0, 1), Bt, bcol + HALF, 0); STAGE(SAO(0, 1), A, brow + HALF, 0);
    STAGE(SBO(1, 0), Bt, bcol, 1); STAGE(SAO(1, 0), A, brow, 1); STAGE(SBO(1, 1), Bt, bcol + HALF, 1);
    return;
  }
#pragma unroll
  for (int a = 0; a < 2; ++a)
#pragma unroll
    for (int b = 0; b < 2; ++b)
#pragma unroll
      for (int m = 0; m < 4; ++m)
#pragma unroll
        for (int n = 0; n < 2; ++n) acc[a][b][m][n] = f32x4{0.f, 0.f, 0.f, 0.f};
  bf16x8 At[4][2], B0[2][2], B1[2][2];
  constexpr int nt = KD / BK;
  if (!primed) {
    __syncthreads();
    STAGE(SBO(0, 0), Bt, bcol, 0); STAGE(SAO(0, 0), A, brow, 0);
    STAGE(SBO(0, 1), Bt, bcol + HALF, 0); STAGE(SAO(0, 1), A, brow + HALF, 0);
    STAGE(SBO(1, 0), Bt, bcol, 1); STAGE(SAO(1, 0), A, brow, 1); STAGE(SBO(1, 1), Bt, bcol + HALF, 1);
  }
  if (wr == 1) BAR;
  WAIT_V(0); BAR;
  BAR;
#pragma unroll 1
  for (int t = 0; t < nt - 2; t += 2) {
    LDB(B0, 0, 0); SCHED; LDA(At, 0, 0); STAGE(SAO(1, 1), A, brow + HALF, t + 1);
    WAIT_L(8); BAR; WAIT_L(0); MMA(0, 0, At, B0); BAR; SCHED;
    LDB(B1, 0, 1); STAGE(SBO(0, 0), Bt, bcol, t + 2);
    BAR; WAIT_L(0); MMA(0, 1, At, B1); BAR;
    LDA(At, 0, 1); STAGE(SAO(0, 0), A, brow, t + 2);
    BAR; WAIT_L(0); MMA(1, 0, At, B0); BAR; SCHED;
    STAGE(SBO(0, 1), Bt, bcol + HALF, t + 2);
    WAIT_V(6); BAR; MMA(1, 1, At, B1); BAR;
    LDB(B0, 1, 0); SCHED; LDA(At, 1, 0); STAGE(SAO(0, 1), A, brow + HALF, t + 2);
    WAIT_L(8); BAR; WAIT_L(0); MMA(0, 0, At, B0); BAR; SCHED;
    LDB(B1, 1, 1); STAGE(SBO(1, 0), Bt, bcol, t + 3);
    BAR; WAIT_L(0); MMA(0, 1, At, B1); BAR;
    LDA(At, 1, 1); STAGE(SAO(1, 0), A, brow, t + 3);
    BAR; WAIT_L(0); MMA(1, 0, At, B0); BAR; SCHED;
    STAGE(SBO(1, 1), Bt, bcol + HALF, t + 3);
    WAIT_V(6); BAR; MMA(1, 1, At, B1); BAR;
  }
  {
    LDB(B0, 0, 0); LDA(At, 0, 0); STAGE(SAO(1, 1), A, brow + HALF, nt - 1);
    BAR; WAIT_L(0); MMA(0, 0, At, B0); BAR;
    LDB(B1, 0, 1); BAR; WAIT_L(0); MMA(0, 1, At, B1); BAR;
    LDA(At, 0, 1); WAIT_V(4); BAR; WAIT_L(0); MMA(1, 0, At, B0); MMA(1, 1, At, B1); BAR;
  }
  {
    LDB(B0, 1, 0); LDA(At, 1, 0); WAIT_V(2); BAR; WAIT_L(0); MMA(0, 0, At, B0); BAR;
    LDB(B1, 1, 1); WAIT_V(0); BAR; WAIT_L(0); MMA(0, 1, At, B1); BAR;
    LDA(At, 1, 1); BAR; WAIT_L(0); MMA(1, 0, At, B0); MMA(1, 1, At, B1); BAR;
  }
  if (wr == 0) BAR;
}
#define EPI_IDX const int tide = otid(), wid = tide >> 6, lane = tide & 63, wr = wid >> 2, wc = wid & 3, fr = lane & 15, fq = lane >> 4;
#define EPI_LOOP                                                                     \
  _Pragma("unroll") for (int ai = 0; ai < 2; ++ai) _Pragma("unroll") for (int bj = 0; bj < 2; ++bj) \
      _Pragma("unroll") for (int m = 0; m < 4; ++m) _Pragma("unroll") for (int n = 0; n < 2; ++n)

__device__ __forceinline__ void mlstm_scalars(const Params& p, int l, int bh, char* smem) {
  const int tid = otid(), lane = tid & 63, wid = tid >> 6;
  float* sred = (float*)smem;
  const float* GATE = (const float*)(p.ws + W_GATE);
  const int b = bh >> 2, h = bh & 3;
  float itv[4], c[4];
#pragma unroll
  for (int r = 0; r < 4; ++r) {
    size_t row = (size_t)b * SEQ + tid * 4 + r;
    itv[r] = GATE[row * 8 + h];
    c[r] = logsig(GATE[row * 8 + 4 + h]);
  }
  c[1] += c[0]; c[2] += c[1]; c[3] += c[2];
  float inc = c[3];
#pragma unroll
  for (int o = 1; o < 64; o <<= 1) { float t = SHU(inc, o); if (lane >= o) inc += t; }
  if (lane == 63) sred[wid] = inc;
  __syncthreads();
  float base = 0.f;
  for (int w = 0; w < wid; ++w) base += sred[w];
  __syncthreads();
  const float excl = base + inc - c[3];
  float g[4], mx[4];
#pragma unroll
  for (int r = 0; r < 4; ++r) { c[r] += excl; g[r] = itv[r] - c[r]; }
  mx[0] = g[0]; mx[1] = fmaxf(mx[0], g[1]); mx[2] = fmaxf(mx[1], g[2]); mx[3] = fmaxf(mx[2], g[3]);
  float minc = mx[3];
#pragma unroll
  for (int o = 1; o < 64; o <<= 1) { float t = SHU(minc, o); if (lane >= o) minc = fmaxf(minc, t); }
  if (lane == 63) sred[wid] = minc;
  __syncthreads();
  float mb = 0.f;
  for (int w = 0; w < wid; ++w) mb = fmaxf(mb, sred[w]);
  float prev = SHU(minc, 1);
  if (lane > 0) mb = fmaxf(mb, prev);
  __syncthreads();
  float* G = (float*)(p.ws + W_G) + (size_t)bh * SEQ;
  float* MX = (float*)(p.ws + W_MX) + (size_t)bh * SEQ;
  float* EM = (float*)(p.ws + W_EM) + (size_t)bh * SEQ;
  float4 og, om, oe;
  float mxv[4], mv[4];
#pragma unroll
  for (int r = 0; r < 4; ++r) { mxv[r] = fmaxf(mb, mx[r]); mv[r] = c[r] + mxv[r]; }
  og = float4{g[0], g[1], g[2], g[3]};
  om = float4{mxv[0], mxv[1], mxv[2], mxv[3]};
  oe = float4{__expf(-mv[0]), __expf(-mv[1]), __expf(-mv[2]), __expf(-mv[3])};
  ((float4*)G)[tid] = og; ((float4*)MX)[tid] = om; ((float4*)EM)[tid] = oe;
  if (tid == 511) p.out[O_MP + (size_t)l * 32 + bh] = mv[3];
}

__device__ __forceinline__ void mlstm_flash(const Params& p, int l, int bh, int qi, char* smem) {
  const int tid = otid(), lane = tid & 63, wid = tid >> 6, fr = lane & 15, fq = lane >> 4, wr = wid >> 1, wc = wid & 1;
  const int b = bh >> 2, h = bh & 3;
  char* sKb = smem;
  char* sVb = smem + 65536;
  bf16_t* sP = (bf16_t*)(smem + 131072);
  float* sRed = (float*)(smem + 131072);
  const bf16_t* P = (const bf16_t*)(p.ws + W_P);
  const float* G = (const float*)(p.ws + W_G) + (size_t)bh * SEQ;
  const float* MX = (const float*)(p.ws + W_MX) + (size_t)bh * SEQ;
  const float* EM = (const float*)(p.ws + W_EM) + (size_t)bh * SEQ;
  const size_t rowbase = (size_t)b * SEQ;
  const int nblk = 2 * qi + 2;
#define FL_ISSUE(jb)                                                                                              \
  do {                                                                                                            \
    const int buf_ = (jb) & 1;                                                                                    \
    const bf16_t* rp0_ = P + (rowbase + (size_t)(jb) * 64) * NPJ + h * 256;                                       \
    _Pragma("unroll") for (int i_ = 0; i_ < 4; ++i_) {                                                            \
      const int r_ = (wid * 4 + i_) * 2 + (lane >> 5), cs_ = lane & 31;                                           \
      const int ck_ = cs_ ^ (r_ & 31), cv_ = cs_ ^ (((r_ & 3) << 1) | (r_ & 8));                                  \
      __builtin_amdgcn_global_load_lds((const unsigned*)(rp0_ + (size_t)r_ * NPJ + C_K + ck_ * 8),                \
                                       (unsigned*)(sKb + buf_ * 32768 + (wid * 4 + i_) * 1024 + lane * 16), 16, 0, 0); \
      __builtin_amdgcn_global_load_lds((const unsigned*)(rp0_ + (size_t)r_ * NPJ + C_V + cv_ * 8),                \
                                       (unsigned*)(sVb + buf_ * 32768 + (wid * 4 + i_) * 1024 + lane * 16), 16, 0, 0); \
    }                                                                                                             \
  } while (0)
  FL_ISSUE(0);
  bf16x8 qf[2][8];
  float mxr[2];
#pragma unroll
  for (int m = 0; m < 2; ++m) {
    const int t = qi * 128 + wr * 32 + m * 16 + fr;
    const bf16_t* qp = P + (rowbase + t) * NPJ + C_Q + h * 256 + fq * 8;
#pragma unroll
    for (int kk = 0; kk < 8; ++kk) qf[m][kk] = *(const bf16x8*)(qp + kk * 32);
    mxr[m] = MX[t];
  }
  f32x4 oacc[2][8];
#pragma unroll
  for (int m = 0; m < 2; ++m)
#pragma unroll
    for (int n = 0; n < 8; ++n) oacc[m][n] = f32x4{0.f, 0.f, 0.f, 0.f};
  float den[2] = {0.f, 0.f};
#pragma unroll 1
  for (int j = 0; j < nblk; ++j) {
    asm volatile("s_waitcnt vmcnt(0)" ::: "memory");
    __syncthreads();
    if (j + 1 < nblk) FL_ISSUE(j + 1);
    const char* sK = sKb + (j & 1) * 32768;
    const char* sV = sVb + (j & 1) * 32768;
    f32x4 sacc[2][2];
#pragma unroll
    for (int m = 0; m < 2; ++m)
#pragma unroll
      for (int n = 0; n < 2; ++n) sacc[m][n] = f32x4{0.f, 0.f, 0.f, 0.f};
#pragma unroll
    for (int kk = 0; kk < 8; ++kk)
#pragma unroll
      for (int n = 0; n < 2; ++n) {
        const int row = wc * 32 + n * 16 + fr, c = kk * 4 + fq;
        bf16x8 kf = *(const bf16x8*)(sK + row * 512 + ((c ^ (row & 31)) << 4));
        sacc[0][n] = mfma16(kf, qf[0][kk], sacc[0][n]);
        sacc[1][n] = mfma16(kf, qf[1][kk], sacc[1][n]);
      }
#pragma unroll
    for (int n = 0; n < 2; ++n) {
      const int s0 = j * 64 + wc * 32 + n * 16 + fq * 4;
      const float4 g4 = *(const float4*)(G + s0);
      const float gs[4] = {g4.x, g4.y, g4.z, g4.w};
#pragma unroll
      for (int m = 0; m < 2; ++m) {
        const int t = qi * 128 + wr * 32 + m * 16 + fr;
        float v[4];
#pragma unroll
        for (int r = 0; r < 4; ++r) {
          float w = (s0 + r <= t) ? __expf(gs[r] - mxr[m]) : 0.f;
          v[r] = sacc[m][n][r] * 0.0625f * w;
          den[m] += v[r];
        }
        uint2 pk; pk.x = pk2(v[0], v[1]); pk.y = pk2(v[2], v[3]);
        *(uint2*)(sP + (wr * 32 + m * 16 + fr) * 72 + wc * 32 + n * 16 + fq * 4) = pk;
      }
    }
    __syncthreads();
#pragma unroll
    for (int kk = 0; kk < 2; ++kk) {
      bf16x8 pf0 = *(const bf16x8*)(sP + (wr * 32 + fr) * 72 + kk * 32 + fq * 8);
      bf16x8 pf1 = *(const bf16x8*)(sP + (wr * 32 + 16 + fr) * 72 + kk * 32 + fq * 8);
      const int srow = kk * 32 + fq * 8 + (fr >> 2);
      const int swz = ((srow & 3) << 1) | (srow & 8);
#pragma unroll
      for (int n2 = 0; n2 < 8; ++n2) {
        const int ch = ((wc * 128 + n2 * 16) >> 3) + ((fr & 3) >> 1);
        const char* va = sV + srow * 512 + ((ch ^ swz) << 4) + (fr & 1) * 8;
        s16x4 a = __builtin_amdgcn_ds_read_tr16_b64_v4i16((LDSP(s16x4))va);
        s16x4 bq = __builtin_amdgcn_ds_read_tr16_b64_v4i16((LDSP(s16x4))(va + 4 * 512));
        bf16x8 vf = {a[0], a[1], a[2], a[3], bq[0], bq[1], bq[2], bq[3]};
        oacc[0][n2] = mfma16(vf, pf0, oacc[0][n2]);
        oacc[1][n2] = mfma16(vf, pf1, oacc[1][n2]);
      }
    }
  }
  __syncthreads();
#undef FL_ISSUE
  float dn[2];
#pragma unroll
  for (int m = 0; m < 2; ++m) {
    float v = den[m];
    v += SHX(v, 16); v += SHX(v, 32);
    if (fq == 0) sRed[wc * 128 + wr * 32 + m * 16 + fr] = v;
  }
  __syncthreads();
#pragma unroll
  for (int m = 0; m < 2; ++m) {
    const int tl = wr * 32 + m * 16 + fr;
    float d = sRed[tl] + sRed[128 + tl];
    dn[m] = 1.f / fmaxf(fabsf(d), EM[qi * 128 + tl]);
  }
  float s1[2] = {0.f, 0.f}, s2[2] = {0.f, 0.f};
#pragma unroll
  for (int m = 0; m < 2; ++m) {
    const size_t row = rowbase + qi * 128 + wr * 32 + m * 16 + fr;
#pragma unroll
    for (int n2 = 0; n2 < 8; ++n2) {
      const int col = h * 256 + wc * 128 + n2 * 16 + fq * 4;
      const uint2 ov = *(const uint2*)(P + row * NPJ + C_O + col);
      const float o[4] = {bflo(ov.x), bfhi(ov.x), bflo(ov.y), bfhi(ov.y)};
#pragma unroll
      for (int r = 0; r < 4; ++r) {
        float hv = oacc[m][n2][r] * dn[m] * sigm(o[r]);
        oacc[m][n2][r] = hv;
        s1[m] += hv; s2[m] += hv * hv;
      }
    }
  }
#pragma unroll
  for (int m = 0; m < 2; ++m) {
    float a = s1[m], q = s2[m];
    a += SHX(a, 16); a += SHX(a, 32);
    q += SHX(q, 16); q += SHX(q, 32);
    if (fq == 0) { sRed[256 + wc * 128 + wr * 32 + m * 16 + fr] = a; sRed[512 + wc * 128 + wr * 32 + m * 16 + fr] = q; }
  }
  __syncthreads();
  bf16_t* Y0 = (bf16_t*)(p.ws + W_Y);
  const float* ng = p.in[I_NORMG] + (size_t)l * D;
#pragma unroll
  for (int m = 0; m < 2; ++m) {
    const int tl = wr * 32 + m * 16 + fr;
    const float mean = (sRed[256 + tl] + sRed[256 + 128 + tl]) * (1.f / 256.f);
    const float var = (sRed[512 + tl] + sRed[512 + 128 + tl]) * (1.f / 256.f) - mean * mean;
    const float rstd = rsqrtf(fmaxf(var, 0.f) + EPS);
    const size_t row = rowbase + qi * 128 + tl;
#pragma unroll
    for (int n2 = 0; n2 < 8; ++n2) {
      const int col = h * 256 + wc * 128 + n2 * 16 + fq * 4;
      const uint2 zv = *(const uint2*)(P + row * NPJ + C_ZA + col);
      const float4 g4 = *(const float4*)(ng + col);
      const float z[4] = {bflo(zv.x), bfhi(zv.x), bflo(zv.y), bfhi(zv.y)};
      const float gg[4] = {g4.x, g4.y, g4.z, g4.w};
      float y[4];
#pragma unroll
      for (int r = 0; r < 4; ++r) y[r] = (oacc[m][n2][r] - mean) * rstd * gg[r] * silu(z[r]);
      uint2 o; o.x = pk2(y[0], y[1]); o.y = pk2(y[2], y[3]);
      *(uint2*)(Y0 + row * D + col) = o;
    }
  }
  __syncthreads();
}

__device__ __forceinline__ void mlstm_final(const Params& p, int l, int bh, int dq, char* smem) {
  const int tid = otid(), lane = tid & 63, wid = tid >> 6, fr = lane & 15, fq = lane >> 4, wr = wid >> 2, wc = wid & 3;
  const int b = bh >> 2, h = bh & 3;
  bf16_t* sKw = (bf16_t*)smem;
  bf16_t* sV = (bf16_t*)(smem + 18432);
  float* sW = (float*)(smem + 18432 + 69632);
  const bf16_t* P = (const bf16_t*)(p.ws + W_P);
  const float* G = (const float*)(p.ws + W_G) + (size_t)bh * SEQ;
  const float mxl = ((const float*)(p.ws + W_MX))[(size_t)bh * SEQ + SEQ - 1];
  const size_t rowbase = (size_t)b * SEQ;
  f32x4 acc[2][4];
#pragma unroll
  for (int m = 0; m < 2; ++m)
#pragma unroll
    for (int n = 0; n < 4; ++n) acc[m][n] = f32x4{0.f, 0.f, 0.f, 0.f};
  float nacc = 0.f;
#pragma unroll 1
  for (int ch = 0; ch < 16; ++ch) {
    if (tid < 128) sW[tid] = __expf(G[ch * 128 + tid] - mxl) * 0.0625f;
    __syncthreads();
#pragma unroll
    for (int i = 0; i < 2; ++i) {
      int c = tid + 512 * i, r = c >> 3, c8 = c & 7;
      uint4 kv = *(const uint4*)(P + (rowbase + ch * 128 + r) * NPJ + C_K + h * 256 + dq * 64 + c8 * 8);
      float f[8]; unpack8(kv, f);
      const float w = sW[r];
#pragma unroll
      for (int e = 0; e < 8; ++e) f[e] *= w;
      *(uint4*)(sKw + r * 72 + c8 * 8) = pack8(f);
    }
#pragma unroll
    for (int i = 0; i < 8; ++i) {
      int c = tid + 512 * i, r = c >> 5, c8 = c & 31;
      *(uint4*)(sV + r * 272 + c8 * 8) = *(const uint4*)(P + (rowbase + ch * 128 + r) * NPJ + C_V + h * 256 + c8 * 8);
    }
    __syncthreads();
#pragma unroll
    for (int kk = 0; kk < 4; ++kk) {
      bf16x8 kf0 = frag_t(sKw, 72, wr * 32, kk * 32, lane);
      bf16x8 kf1 = frag_t(sKw, 72, wr * 32 + 16, kk * 32, lane);
#pragma unroll
      for (int n = 0; n < 4; ++n) {
        bf16x8 vf = frag_t(sV, 272, wc * 64 + n * 16, kk * 32, lane);
        acc[0][n] = mfma16(vf, kf0, acc[0][n]);
        acc[1][n] = mfma16(vf, kf1, acc[1][n]);
      }
    }
    {
      float a = 0.f;
#pragma unroll
      for (int s = 0; s < 16; ++s) a += bf2f(sKw[(wid * 16 + s) * 72 + lane]);
      nacc += a;
    }
    __syncthreads();
  }
  float* oc = p.out + O_CP + ((size_t)l * 32 + bh) * 65536;
#pragma unroll
  for (int m = 0; m < 2; ++m)
#pragma unroll
    for (int n = 0; n < 4; ++n) {
      const int d = dq * 64 + wr * 32 + m * 16 + fr, e = wc * 64 + n * 16 + fq * 4;
      *(float4*)(oc + (size_t)d * 256 + e) = float4{acc[m][n][0], acc[m][n][1], acc[m][n][2], acc[m][n][3]};
    }
  sW[tid] = nacc;
  __syncthreads();
  if (tid < 64) {
    float a = 0.f;
#pragma unroll
    for (int w8 = 0; w8 < 8; ++w8) a += sW[w8 * 64 + tid];
    p.out[O_NP + ((size_t)l * 32 + bh) * 256 + dq * 64 + tid] = a;
  }
  __syncthreads();
}

__device__ __forceinline__ void mlstm_sample(const Params& p, int l, int b, int h, char* smem) {
  const int tid = otid(), lane = tid & 63, wid = tid >> 6;
  float* sq = (float*)smem;
  float* sk = sq + 1024;
  float* sv = sk + 1024;
  float* sn0 = sv + 1024;
  float* sqk = sn0 + 256;
  float* ssc = sqk + 32;
  float* sst = ssc + 32;
  float* snum = sst + 32;
  const bf16_t* P = (const bf16_t*)(p.ws + W_P);
  const float* GATE = (const float*)(p.ws + W_GATE);
  const size_t R0 = (size_t)NPR + b * 4;
  const size_t sidx = ((size_t)l * 128 + b) * 4 + h;
#pragma unroll
  for (int i = 0; i < 6; ++i) {
    int idx = tid + 512 * i, which = idx >> 10, t = (idx >> 8) & 3, d = idx & 255;
    sq[idx] = bf2f(P[(R0 + t) * NPJ + which * 1024 + h * 256 + d]);
  }
  if (tid < 256) sn0[tid] = p.in[I_SN][sidx * 256 + tid];
  const float m0 = p.in[I_SM][sidx];
  float g[4], cm[4], mm[4];
  {
    float bc = 0.f, run = m0;
#pragma unroll
    for (int t = 0; t < 4; ++t) {
      float itv = GATE[(R0 + t) * 8 + h];
      bc += logsig(GATE[(R0 + t) * 8 + 4 + h]);
      g[t] = itv - bc;
      run = fmaxf(run, g[t]);
      cm[t] = run;
      mm[t] = bc + run;
    }
  }
  __syncthreads();
  {
    const int pp = tid >> 5, li = tid & 31, t = pp >> 2, s = pp & 3;
    float part = 0.f;
#pragma unroll
    for (int d8 = 0; d8 < 8; ++d8) part += sq[t * 256 + li * 8 + d8] * sk[s * 256 + li * 8 + d8];
#pragma unroll
    for (int o = 16; o >= 1; o >>= 1) part += SHX(part, o);
    if (li == 0) sqk[pp] = part * 0.0625f;
    float part2 = 0.f;
    const int t2 = pp & 3;
#pragma unroll
    for (int d8 = 0; d8 < 8; ++d8) part2 += sq[t2 * 256 + li * 8 + d8] * sn0[li * 8 + d8];
#pragma unroll
    for (int o = 16; o >= 1; o >>= 1) part2 += SHX(part2, o);
    if (li == 0 && pp < 4) sqk[16 + pp] = part2;
  }
  __syncthreads();
  float w[4];
#pragma unroll
  for (int s = 0; s < 4; ++s) w[s] = __expf(g[s] - cm[3]) * 0.0625f;
  const float decay = __expf(m0 - cm[3]);
  if (tid == 0) {
#pragma unroll
    for (int t = 0; t < 4; ++t) {
      const float inter = __expf(m0 - cm[t]);
      float dsum = inter * sqk[16 + t];
#pragma unroll
      for (int s = 0; s < 4; ++s) {
        float st = (s <= t) ? sqk[t * 4 + s] * __expf(g[s] - cm[t]) : 0.f;
        ssc[t * 4 + s] = st;
        dsum += st;
      }
      ssc[16 + t] = inter;
      ssc[20 + t] = 1.f / fmaxf(fabsf(dsum), __expf(-mm[t]));
    }
  }
#pragma unroll
  for (int i = 0; i < 2; ++i) {
    int idx = tid + 512 * i;
    sk[idx] *= w[idx >> 8];
  }
  __syncthreads();
  {
    const int e4 = lane * 4, d0 = wid * 32;
    float4 vv[4], np[4];
#pragma unroll
    for (int s = 0; s < 4; ++s) { vv[s] = *(const float4*)(sv + s * 256 + e4); np[s] = float4{0.f, 0.f, 0.f, 0.f}; }
    const float* c0p = p.in[I_SC] + sidx * 65536;
    float* cop = p.out + O_CS + sidx * 65536;
#pragma unroll 1
    for (int dd = 0; dd < 32; dd += 8) {
      float4 c[8];
#pragma unroll
      for (int u = 0; u < 8; ++u) c[u] = *(const float4*)(c0p + (size_t)(d0 + dd + u) * 256 + e4);
#pragma unroll
      for (int u = 0; u < 8; ++u) {
        const int d = d0 + dd + u;
        float4 cn = {decay * c[u].x, decay * c[u].y, decay * c[u].z, decay * c[u].w};
#pragma unroll
        for (int t = 0; t < 4; ++t) {
          const float qv = sq[t * 256 + d], kv = sk[t * 256 + d];
          np[t].x += qv * c[u].x; np[t].y += qv * c[u].y; np[t].z += qv * c[u].z; np[t].w += qv * c[u].w;
          cn.x += kv * vv[t].x; cn.y += kv * vv[t].y; cn.z += kv * vv[t].z; cn.w += kv * vv[t].w;
        }
        *(float4*)(cop + (size_t)d * 256 + e4) = cn;
      }
    }
#pragma unroll
    for (int t = 0; t < 4; ++t) *(float4*)(snum + (wid * 4 + t) * 256 + e4) = np[t];
  }
  __syncthreads();
  {
    const int t = tid >> 7, e2 = (tid & 127) * 2;
    float hv[2];
    const unsigned ov = *(const unsigned*)(P + (R0 + t) * NPJ + C_O + h * 256 + e2);
    const float o2[2] = {bflo(ov), bfhi(ov)};
    const float inter = ssc[16 + t], dnm = ssc[20 + t];
#pragma unroll
    for (int k = 0; k < 2; ++k) {
      const int e = e2 + k;
      float a = 0.f;
#pragma unroll
      for (int w8 = 0; w8 < 8; ++w8) a += snum[(w8 * 4 + t) * 256 + e];
      float x = inter * a;
#pragma unroll
      for (int s = 0; s < 4; ++s) x += ssc[t * 4 + s] * sv[s * 256 + e];
      hv[k] = x * dnm * sigm(o2[k]);
    }
    float a1 = wave_sum(hv[0] + hv[1]), a2 = wave_sum(hv[0] * hv[0] + hv[1] * hv[1]);
    if (lane == 0) { sst[wid * 2] = a1; sst[wid * 2 + 1] = a2; }
    __syncthreads();
    const float mean = (sst[(2 * t) * 2] + sst[(2 * t + 1) * 2]) * (1.f / 256.f);
    const float var = (sst[(2 * t) * 2 + 1] + sst[(2 * t + 1) * 2 + 1]) * (1.f / 256.f) - mean * mean;
    const float rstd = rsqrtf(fmaxf(var, 0.f) + EPS);
    const unsigned zv = *(const unsigned*)(P + (R0 + t) * NPJ + C_ZA + h * 256 + e2);
    const float* ng = p.in[I_NORMG] + (size_t)l * D + h * 256 + e2;
    float y0 = (hv[0] - mean) * rstd * ng[0] * silu(bflo(zv));
    float y1 = (hv[1] - mean) * rstd * ng[1] * silu(bfhi(zv));
    *(unsigned*)((bf16_t*)(p.ws + W_Y) + (R0 + t) * D + h * 256 + e2) = pk2(y0, y1);
  }
  if (tid < 256) {
    float nn = decay * sn0[tid];
#pragma unroll
    for (int s = 0; s < 4; ++s) nn += sk[s * 256 + tid];
    p.out[O_NS + sidx * 256 + tid] = nn;
  }
  if (tid == 0) p.out[O_MS + sidx] = mm[3];
  __syncthreads();
}

__device__ __forceinline__ void gmlp_prompt(const Params& p, int l, int b, int chunk, int g, char* smem) {
  const int tid = otid(), lane = tid & 63, wid = tid >> 6, fr = lane & 15, fq = lane >> 4, wr = wid >> 2, wc = wid & 3;
  bf16_t* sVn = (bf16_t*)smem;
  bf16_t* sW = (bf16_t*)(smem + 69632);
  float* sMu = (float*)(smem + 69632 + 34816);
  float* sRs = sMu + 128;
  const bf16_t* P = (const bf16_t*)(p.ws + W_P);
  const size_t R0 = (size_t)b * SEQ + chunk * 128;
  for (int rr = 0; rr < 16; ++rr) {
    const int s = wid * 16 + rr;
    const bf16_t* rp = P + (R0 + s) * NPJ + C_VB;
    float f[16];
    unpack8(*(const uint4*)(rp + lane * 8), f);
    unpack8(*(const uint4*)(rp + 512 + lane * 8), f + 8);
    float a = 0.f, q = 0.f;
#pragma unroll
    for (int e = 0; e < 16; ++e) { a += f[e]; q += f[e] * f[e]; }
    a = wave_sum(a); q = wave_sum(q);
    if (lane == 0) {
      const float mean = a * (1.f / D);
      sMu[s] = mean;
      sRs[s] = rsqrtf(fmaxf(q * (1.f / D) - mean * mean, 0.f) + EPS);
    }
  }
  __syncthreads();
  const float* lg = p.in[I_GLNG] + (size_t)l * D + g * 256;
  const float* lb = p.in[I_GLNB] + (size_t)l * D + g * 256;
#pragma unroll
  for (int i = 0; i < 8; ++i) {
    int c = tid + 512 * i, r = c >> 5, c8 = c & 31;
    float f[8];
    unpack8(*(const uint4*)(P + (R0 + r) * NPJ + C_VB + g * 256 + c8 * 8), f);
    const float mu = sMu[r], rs = sRs[r];
    const float4 g0 = *(const float4*)(lg + c8 * 8), g1 = *(const float4*)(lg + c8 * 8 + 4);
    const float4 b0 = *(const float4*)(lb + c8 * 8), b1 = *(const float4*)(lb + c8 * 8 + 4);
    f[0] = (f[0] - mu) * rs * g0.x + b0.x; f[1] = (f[1] - mu) * rs * g0.y + b0.y;
    f[2] = (f[2] - mu) * rs * g0.z + b0.z; f[3] = (f[3] - mu) * rs * g0.w + b0.w;
    f[4] = (f[4] - mu) * rs * g1.x + b1.x; f[5] = (f[5] - mu) * rs * g1.y + b1.y;
    f[6] = (f[6] - mu) * rs * g1.z + b1.z; f[7] = (f[7] - mu) * rs * g1.w + b1.w;
    *(uint4*)(sVn + r * 272 + c8 * 8) = pack8(f);
  }
  const bf16_t* wm = (const bf16_t*)(p.ws + W_WM) + (size_t)(l * 4 + g) * 16384;
#pragma unroll
  for (int i = 0; i < 4; ++i) {
    int c = tid + 512 * i, r = c >> 4, c8 = c & 15;
    *(uint4*)(sW + r * 136 + c8 * 8) = *(const uint4*)(wm + r * 128 + c8 * 8);
  }
  __syncthreads();
  f32x4 acc[4][4];
#pragma unroll
  for (int m = 0; m < 4; ++m)
#pragma unroll
    for (int n = 0; n < 4; ++n) acc[m][n] = f32x4{0.f, 0.f, 0.f, 0.f};
#pragma unroll
  for (int kk = 0; kk < 4; ++kk) {
    bf16x8 tf[4];
#pragma unroll
    for (int m = 0; m < 4; ++m) tf[m] = *(const bf16x8*)(sW + (wr * 64 + m * 16 + fr) * 136 + kk * 32 + fq * 8);
#pragma unroll
    for (int n = 0; n < 4; ++n) {
      bf16x8 cf = frag_t(sVn, 272, wc * 64 + n * 16, kk * 32, lane);
#pragma unroll
      for (int m = 0; m < 4; ++m) acc[m][n] = mfma16(cf, tf[m], acc[m][n]);
    }
  }
  bf16_t* Y1 = (bf16_t*)(p.ws + W_Y) + (size_t)MT * D;
  const float* bs = p.in[I_GBS] + (size_t)(l * 4 + g) * 128;
#pragma unroll
  for (int m = 0; m < 4; ++m) {
    const int t = wr * 64 + m * 16 + fr;
    const float bsv = bs[t];
    const size_t row = R0 + t;
#pragma unroll
    for (int n = 0; n < 4; ++n) {
      const int col = g * 256 + wc * 64 + n * 16 + fq * 4;
      const uint2 uv = *(const uint2*)(P + row * NPJ + C_UB + col);
      const uint2 zv = *(const uint2*)(P + row * NPJ + C_ZB + col);
      const float u[4] = {bflo(uv.x), bfhi(uv.x), bflo(uv.y), bfhi(uv.y)};
      const float z[4] = {bflo(zv.x), bfhi(zv.x), bflo(zv.y), bfhi(zv.y)};
      float y[4];
#pragma unroll
      for (int r = 0; r < 4; ++r) y[r] = u[r] * (acc[m][n][r] + bsv) * silu(z[r]);
      uint2 o; o.x = pk2(y[0], y[1]); o.y = pk2(y[2], y[3]);
      *(uint2*)(Y1 + row * D + col) = o;
    }
  }
  __syncthreads();
}

__device__ __forceinline__ void gmlp_sample(const Params& p, int l, int b, char* smem) {
  const int tid = otid(), lane = tid & 63, wid = tid >> 6;
  float* svn = (float*)smem;
  const bf16_t* P = (const bf16_t*)(p.ws + W_P);
  const size_t R0 = (size_t)NPR + b * 4;
  if (wid < 4) {
    const int t = wid;
    const bf16_t* rp = P + (R0 + t) * NPJ + C_VB;
    float f[16];
    unpack8(*(const uint4*)(rp + lane * 8), f);
    unpack8(*(const uint4*)(rp + 512 + lane * 8), f + 8);
    float a = 0.f;
#pragma unroll
    for (int e = 0; e < 16; ++e) a += f[e];
    const float mean = wave_sum(a) * (1.f / D);
    float q = 0.f;
#pragma unroll
    for (int e = 0; e < 16; ++e) { f[e] -= mean; q += f[e] * f[e]; }
    const float rs = rsqrtf(wave_sum(q) * (1.f / D) + EPS);
    const float* lg = p.in[I_GLNG] + (size_t)l * D;
    const float* lb = p.in[I_GLNB] + (size_t)l * D;
    float* ov = p.out + O_VS + (((size_t)l * 128 + b) * 4 + t) * D;
#pragma unroll
    for (int hh = 0; hh < 2; ++hh) {
      const int c0 = hh * 512 + lane * 8;
#pragma unroll
      for (int e = 0; e < 8; ++e) f[hh * 8 + e] = f[hh * 8 + e] * rs * lg[c0 + e] + lb[c0 + e];
      *(float4*)(svn + t * 1024 + c0) = float4{f[hh * 8], f[hh * 8 + 1], f[hh * 8 + 2], f[hh * 8 + 3]};
      *(float4*)(svn + t * 1024 + c0 + 4) = float4{f[hh * 8 + 4], f[hh * 8 + 5], f[hh * 8 + 6], f[hh * 8 + 7]};
      *(float4*)(ov + c0) = float4{f[hh * 8], f[hh * 8 + 1], f[hh * 8 + 2], f[hh * 8 + 3]};
      *(float4*)(ov + c0 + 4) = float4{f[hh * 8 + 4], f[hh * 8 + 5], f[hh * 8 + 6], f[hh * 8 + 7]};
    }
  }
  __syncthreads();
  bf16_t* Y1 = (bf16_t*)(p.ws + W_Y) + (size_t)MT * D;
#pragma unroll
  for (int i = 0; i < 8; ++i) {
    const int idx = tid + 512 * i, t = idx >> 10, c = idx & 1023, g = c >> 8;
    const float* wrow = p.in[I_GWS] + ((size_t)(l * 4 + g) * 128 + t) * 128;
    float mixed = p.in[I_GBS][(size_t)(l * 4 + g) * 128 + t];
#pragma unroll
    for (int s = 0; s < 4; ++s)
      if (s <= t) mixed += wrow[s] * svn[s * 1024 + c];
    const float u = bf2f(P[(R0 + t) * NPJ + C_UB + c]), z = bf2f(P[(R0 + t) * NPJ + C_ZB + c]);
    Y1[(R0 + t) * D + c] = f2bf(u * mixed * silu(z));
  }
  __syncthreads();
}

__device__ __forceinline__ void lru_gemm_pass(const Params& p, int l, int mat, int cp, const bf16_t* sX, bf16_t* sWt,
                                              f32x4 (&acc)[8][2]) {
  const int tid = otid(), lane = tid & 63, wid = tid >> 6, fr = lane & 15, fq = lane >> 4;
  const bf16_t* src = (const bf16_t*)(p.ws + W_WTL) + (size_t)((l * 2 + mat) * 8 + cp * 2) * 16384;
  __syncthreads();
#pragma unroll
  for (int i = 0; i < 8; ++i) {
    int c = tid + 512 * i, r = c >> 4, c8 = c & 15;
    *(uint4*)(sWt + r * 136 + c8 * 8) = *(const uint4*)(src + r * 128 + c8 * 8);
  }
  __syncthreads();
  const int kb = (wid >> 2) * 128;
#pragma unroll
  for (int m = 0; m < 8; ++m) { acc[m][0] = f32x4{0.f, 0.f, 0.f, 0.f}; acc[m][1] = f32x4{0.f, 0.f, 0.f, 0.f}; }
#pragma unroll
  for (int kk = 0; kk < 4; ++kk) {
    bf16x8 wf0 = *(const bf16x8*)(sWt + (wid * 32 + fr) * 136 + kk * 32 + fq * 8);
    bf16x8 wf1 = *(const bf16x8*)(sWt + (wid * 32 + 16 + fr) * 136 + kk * 32 + fq * 8);
#pragma unroll
    for (int m = 0; m < 8; ++m) {
      bf16x8 xf = *(const bf16x8*)(sX + (m * 16 + fr) * 264 + kb + kk * 32 + fq * 8);
      acc[m][0] = mfma16(xf, wf0, acc[m][0]);
      acc[m][1] = mfma16(xf, wf1, acc[m][1]);
    }
  }
}

__device__ __forceinline__ void lru_tile(const Params& p, int l, int tile, int cp, bool sample, char* smem) {
  const int tid = otid(), lane = tid & 63, wid = tid >> 6, fr = lane & 15, fq = lane >> 4;
  bf16_t* sX = (bf16_t*)smem;
  bf16_t* sWt = (bf16_t*)(smem + 67584);
  const bf16_t* P = (const bf16_t*)(p.ws + W_P);
  {
    const int cg8 = tid & 31, tg = tid >> 5, c = cp * 256 + cg8 * 8;
    float w0[8], w1[8], w2[8], w3[8], bb[8];
    const float* cw = p.in[I_CONVW] + (size_t)l * 4 * D + c;
#pragma unroll
    for (int e = 0; e < 8; ++e) { w0[e] = cw[e]; w1[e] = cw[D + e]; w2[e] = cw[2 * D + e]; w3[e] = cw[3 * D + e]; bb[e] = p.in[I_CONVB][(size_t)l * D + c + e]; }
    if (!sample) {
      const int b = tile >> 4, tt0 = (tile & 15) * 128 + tg * 8;
      const size_t rb = (size_t)b * SEQ;
      float x3[8], x2[8], x1[8], cur[8];
#pragma unroll
      for (int e = 0; e < 8; ++e) { x3[e] = 0.f; x2[e] = 0.f; x1[e] = 0.f; }
      if (tt0 > 0) {
        unpack8(*(const uint4*)(P + (rb + tt0 - 3) * NPJ + C_XC + c), x3);
        unpack8(*(const uint4*)(P + (rb + tt0 - 2) * NPJ + C_XC + c), x2);
        unpack8(*(const uint4*)(P + (rb + tt0 - 1) * NPJ + C_XC + c), x1);
      }
#pragma unroll
      for (int i = 0; i < 8; ++i) {
        unpack8(*(const uint4*)(P + (rb + tt0 + i) * NPJ + C_XC + c), cur);
        float xc[8];
#pragma unroll
        for (int e = 0; e < 8; ++e) xc[e] = bb[e] + w0[e] * x3[e] + w1[e] * x2[e] + w2[e] * x1[e] + w3[e] * cur[e];
        *(uint4*)(sX + (tg * 8 + i) * 264 + cg8 * 8) = pack8(xc);
        if ((tile & 15) == 15 && tg == 15 && i >= 5) {
          float* o = p.out + O_CONVP + (((size_t)l * 8 + b) * 3 + (i - 5)) * D + c;
          *(float4*)o = float4{cur[0], cur[1], cur[2], cur[3]};
          *(float4*)(o + 4) = float4{cur[4], cur[5], cur[6], cur[7]};
        }
#pragma unroll
        for (int e = 0; e < 8; ++e) { x3[e] = x2[e]; x2[e] = x1[e]; x1[e] = cur[e]; }
      }
    } else {
#pragma unroll
      for (int q = 0; q < 2; ++q) {
        const int bbi = tile * 32 + tg * 2 + q;
        const float* cb = p.in[I_SCONV] + ((size_t)l * 128 + bbi) * 3 * D + c;
        float x3[8], x2[8], x1[8], cur[8];
#pragma unroll
        for (int e = 0; e < 8; ++e) { x3[e] = cb[e]; x2[e] = cb[D + e]; x1[e] = cb[2 * D + e]; }
#pragma unroll
        for (int i = 0; i < 4; ++i) {
          unpack8(*(const uint4*)(P + ((size_t)NPR + bbi * 4 + i) * NPJ + C_XC + c), cur);
          float xc[8];
#pragma unroll
          for (int e = 0; e < 8; ++e) xc[e] = bb[e] + w0[e] * x3[e] + w1[e] * x2[e] + w2[e] * x1[e] + w3[e] * cur[e];
          *(uint4*)(sX + (tg * 8 + q * 4 + i) * 264 + cg8 * 8) = pack8(xc);
          if (i >= 1) {
            float* o = p.out + O_CONVS + (((size_t)l * 128 + bbi) * 3 + (i - 1)) * D + c;
            *(float4*)o = float4{cur[0], cur[1], cur[2], cur[3]};
            *(float4*)(o + 4) = float4{cur[4], cur[5], cur[6], cur[7]};
          }
#pragma unroll
          for (int e = 0; e < 8; ++e) { x3[e] = x2[e]; x2[e] = x1[e]; x1[e] = cur[e]; }
        }
      }
    }
  }
  f32x4 racc[8][2], iacc[8][2];
  lru_gemm_pass(p, l, 0, cp, sX, sWt, racc);
  lru_gemm_pass(p, l, 1, cp, sX, sWt, iacc);
  const bool first = (!sample) && ((tile & 15) == 0);
#pragma unroll
  for (int n = 0; n < 2; ++n) {
    const int jl = wid * 32 + n * 16 + fr, c = cp * 256 + jl;
    const float bav = p.in[I_BA][(size_t)l * D + c], bxv = p.in[I_BX][(size_t)l * D + c];
    const float ls8 = 8.f * logsig(p.in[I_LAM][(size_t)l * D + c]);
#pragma unroll
    for (int m = 0; m < 8; ++m) {
      int mo = m * 16 + fq * 4;
      asm volatile("" : "+v"(mo));
#pragma unroll
      for (int r = 0; r < 4; ++r) {
        const int t = mo + r;
        const float rg = sigm(racc[m][n][r] + bav), ig = sigm(iacc[m][n][r] + bxv);
        const float av = __expf(ls8 * rg);
        float mult = __builtin_amdgcn_sqrtf(fmaxf(1.f - av * av, 0.f));
        if (first && t == 0) mult = 1.f;
        racc[m][n][r] = av;
        iacc[m][n][r] = mult * ig * bf2f(sX[t * 264 + jl]);
      }
    }
  }
  if (sample) {
    bf16_t* Y2 = (bf16_t*)(p.ws + W_Y) + (size_t)2 * MT * D;
#pragma unroll
    for (int n = 0; n < 2; ++n) {
      const int c = cp * 256 + wid * 32 + n * 16 + fr;
#pragma unroll
      for (int m = 0; m < 8; ++m) {
        int bbi = tile * 32 + m * 4 + fq;
        asm volatile("" : "+v"(bbi));
        float hh = p.in[I_SH][((size_t)l * 128 + bbi) * D + c];
#pragma unroll
        for (int r = 0; r < 4; ++r) {
          hh = racc[m][n][r] * hh + iacc[m][n][r];
          const size_t row = (size_t)NPR + bbi * 4 + r;
          const float z = bf2f(P[row * NPJ + C_ZC + c]);
          Y2[row * D + c] = f2bf(hh * silu(z));
        }
        p.out[O_HS + ((size_t)l * 128 + bbi) * D + c] = hh;
      }
    }
  } else {
    bf16_t* LH = (bf16_t*)(p.ws + W_LH);
    bf16_t* LA = (bf16_t*)(p.ws + W_LA);
    const size_t rb = (size_t)(tile >> 4) * SEQ + (tile & 15) * 128;
#pragma unroll
    for (int n = 0; n < 2; ++n) {
      const int c = cp * 256 + wid * 32 + n * 16 + fr;
      float cA = 1.f, cH = 0.f;
#pragma unroll
      for (int m = 0; m < 8; ++m) {
        int mo = m * 16 + fq * 4;
        asm volatile("" : "+v"(mo));
        float la_[4], lh_[4];
        la_[0] = racc[m][n][0]; lh_[0] = iacc[m][n][0];
#pragma unroll
        for (int r = 1; r < 4; ++r) { la_[r] = la_[r - 1] * racc[m][n][r]; lh_[r] = racc[m][n][r] * lh_[r - 1] + iacc[m][n][r]; }
        float A = la_[3], H = lh_[3];
        float pA = SHU(A, 16), pH = SHU(H, 16);
        if (fq >= 1) { H = A * pH + H; A = A * pA; }
        pA = SHU(A, 32); pH = SHU(H, 32);
        if (fq >= 2) { H = A * pH + H; A = A * pA; }
        float eA = SHU(A, 16), eH = SHU(H, 16);
        if (fq == 0) { eA = 1.f; eH = 0.f; }
        const float tA = shf(A, 48 + fr), tH = shf(H, 48 + fr);
        const float PA = cA * eA, PH = eA * cH + eH;
#pragma unroll
        for (int r = 0; r < 4; ++r) {
          const size_t row = rb + mo + r;
          LA[row * D + c] = f2bf(PA * la_[r]);
          LH[row * D + c] = f2bf(la_[r] * PH + lh_[r]);
        }
        cH = tA * cH + tH;
        cA = cA * tA;
      }
      if (fq == 0) {
        float* LE = (float*)(p.ws + W_LE) + ((size_t)tile * D + c) * 2;
        LE[0] = cA; LE[1] = cH;
      }
    }
  }
  __syncthreads();
}

__device__ __forceinline__ void lru_fix(const Params& p, int l, int tile, int half) {
  const int tid = otid(), c = tid * 2;
  const int b = tile >> 4, seg = tile & 15;
  const float* LE = (const float*)(p.ws + W_LE);
  float H0 = 0.f, H1 = 0.f;
  for (int k = 0; k < seg; ++k) {
    const float4 e = *(const float4*)(LE + ((size_t)(b * 16 + k) * D + c) * 2);
    H0 = e.x * H0 + e.y;
    H1 = e.z * H1 + e.w;
  }
  const bf16_t* P = (const bf16_t*)(p.ws + W_P);
  const bf16_t* LH = (const bf16_t*)(p.ws + W_LH);
  const bf16_t* LA = (const bf16_t*)(p.ws + W_LA);
  bf16_t* Y2 = (bf16_t*)(p.ws + W_Y) + (size_t)2 * MT * D;
  const size_t R0 = (size_t)b * SEQ + seg * 128 + half * 64;
#pragma unroll 8
  for (int rr = 0; rr < 64; ++rr) {
    const size_t row = R0 + rr;
    const unsigned hl = *(const unsigned*)(LH + row * D + c);
    const unsigned al = *(const unsigned*)(LA + row * D + c);
    const unsigned zv = *(const unsigned*)(P + row * NPJ + C_ZC + c);
    const float h0 = bflo(hl) + bflo(al) * H0, h1 = bfhi(hl) + bfhi(al) * H1;
    *(unsigned*)(Y2 + row * D + c) = pk2(h0 * silu(bflo(zv)), h1 * silu(bfhi(zv)));
  }
  if (seg == 15 && half == 1) {
    const float4 e = *(const float4*)(LE + ((size_t)(b * 16 + 15) * D + c) * 2);
    float2 o = {e.x * H0 + e.y, e.z * H1 + e.w};
    *(float2*)(p.out + O_HP + ((size_t)l * 8 + b) * D + c) = o;
  }
}

__device__ __forceinline__ void x4_unit(const Params& p, int l, int pm, int pn, char* smem) {
  float* MF = (float*)(p.ws + W_MF);
  bf16_t* MB = (bf16_t*)(p.ws + W_MB);
  const bf16_t* const P = (const bf16_t*)(p.ws + W_P);
#pragma unroll 1
  for (int br = 0; br < 3; ++br) {
    const bf16_t* A = (const bf16_t*)(p.ws + W_Y) + (size_t)br * MT * D;
    const bf16_t* Bt = (const bf16_t*)(p.ws + W_WTP) + (size_t)(l * 4 + br) * D * D;
    f32x4 acc[2][2][4][2];
    gemm_tile(A, Bt, pm * 256, pn * 256, smem, acc);
    EPI_IDX
    EPI_LOOP {
      const int row = pm * 256 + ai * 128 + wr * 64 + m * 16 + fr, col = pn * 256 + bj * 128 + wc * 32 + n * 16 + fq * 4;
      const uint2 gv = *(const uint2*)(P + (size_t)row * NPJ + C_GA + br * 1024 + col);
      float4 v = {acc[ai][bj][m][n][0] * sigm(bflo(gv.x)), acc[ai][bj][m][n][1] * sigm(bfhi(gv.x)),
                  acc[ai][bj][m][n][2] * sigm(bflo(gv.y)), acc[ai][bj][m][n][3] * sigm(bfhi(gv.y))};
      uint2* mf = (uint2*)((bf16_t*)MF + (size_t)row * D + col);
      if (br == 0) {
        uint2 ob; ob.x = pk2(v.x, v.y); ob.y = pk2(v.z, v.w); *mf = ob;
      } else {
        const uint2 o = *mf;
        v.x += bflo(o.x); v.y += bfhi(o.x); v.z += bflo(o.y); v.w += bfhi(o.y);
        uint2 ob; ob.x = pk2(v.x, v.y); ob.y = pk2(v.z, v.w);
        if (br == 1) *mf = ob;
        else *(uint2*)(MB + (size_t)row * D + col) = ob;
      }
    }
  }
}
__device__ __forceinline__ void x5_unit(const Params& p, int l, int pm, int pn, char* smem) {
  const bf16_t* A = (const bf16_t*)(p.ws + W_MB);
  const bf16_t* Bt = (const bf16_t*)(p.ws + W_WTP) + (size_t)(l * 4 + 3) * D * D;
  float* PRE = (float*)(p.ws + W_PRE);
  const float* XF = (const float*)(p.ws + W_XF);
  f32x4 acc[2][2][4][2];
  gemm_tile(A, Bt, pm * 256, pn * 256, smem, acc);
  EPI_IDX
  EPI_LOOP {
    const int row = pm * 256 + ai * 128 + wr * 64 + m * 16 + fr, col = pn * 256 + bj * 128 + wc * 32 + n * 16 + fq * 4;
    const float* xr = (l == 0) ? (row < NPR ? p.in[I_XP] + (size_t)row * D : p.in[I_XS] + (size_t)(row - NPR) * D)
                               : XF + (size_t)row * D;
    const float4 xv = *(const float4*)(xr + col);
    float4 v = {ALPHA * xv.x + acc[ai][bj][m][n][0], ALPHA * xv.y + acc[ai][bj][m][n][1],
                ALPHA * xv.z + acc[ai][bj][m][n][2], ALPHA * xv.w + acc[ai][bj][m][n][3]};
    *(float4*)(PRE + (size_t)row * D + col) = v;
  }
}
__device__ __forceinline__ void dep_signal(unsigned* ctr) {
  asm volatile("s_waitcnt vmcnt(0)" ::: "memory");
  __syncthreads();
  if (threadIdx.x == 0) {
    __builtin_amdgcn_fence(__ATOMIC_RELEASE, "agent");
    asm volatile("s_waitcnt vmcnt(0)" ::: "memory");
    (void)__hip_atomic_fetch_add(ctr, 1u, __ATOMIC_RELAXED, __HIP_MEMORY_SCOPE_AGENT);
  }
}
__device__ __forceinline__ void dep_wait(unsigned* ctr, unsigned target) {
  if (threadIdx.x == 0) {
    unsigned sp = 0;
    while (__hip_atomic_load(ctr, __ATOMIC_RELAXED, __HIP_MEMORY_SCOPE_AGENT) < target) {
      __builtin_amdgcn_s_sleep(2);
      if (++sp > (1u << 24)) break;
    }
    __builtin_amdgcn_fence(__ATOMIC_ACQUIRE, "agent");
    asm volatile("s_waitcnt vmcnt(0)" ::: "memory");
  }
  __syncthreads();
}

#define XB_TMO 128
#define XB_XCNT(j) (256 + 64 * (j))
#define XB_XSUB(j) (1280 + 64 * (j))
#define XB_XGEN(j) (2304 + 64 * (j))
#define XB_TOP 3328
#define XB_TOPGEN 3392
#define XCD_BAR_WORDS 3456
#define XB_SPIN_CAP (1u << 22)
__device__ __forceinline__ unsigned xb_ld(unsigned* p) { return __hip_atomic_load(p, __ATOMIC_RELAXED, __HIP_MEMORY_SCOPE_AGENT); }
__device__ __forceinline__ unsigned xb_add(unsigned* p, unsigned v) { return __hip_atomic_fetch_add(p, v, __ATOMIC_RELAXED, __HIP_MEMORY_SCOPE_AGENT); }
__device__ __forceinline__ unsigned xb_xcc_id() { return (unsigned)__builtin_amdgcn_s_getreg((3 << 11) | 20) & 0xFu; }
#define XB_SPIN(cond, bar) do { unsigned _sp = 0; while (cond) { __builtin_amdgcn_s_sleep(1); \
    if ((++_sp & 255u) == 0u) { if (xb_ld(&(bar)[XB_TMO])) break; if (_sp > XB_SPIN_CAP) { atomicAdd(&(bar)[XB_TMO], 1u); break; } } } } while (0)
struct XcdBarrier { unsigned* bar; unsigned x; volatile LDSP(unsigned) st; };
__device__ __forceinline__ XcdBarrier xcd_barrier_post(unsigned* bar, volatile LDSP(unsigned) st) {
  XcdBarrier b; b.bar = bar; b.x = xb_xcc_id(); b.st = st;
  if (threadIdx.x == 0) (void)xb_add(&bar[XB_XCNT(b.x)], 1u);
  return b;
}
__device__ __forceinline__ void xcd_barrier_complete(unsigned* bar, unsigned x, unsigned& nloc, unsigned& nx) {
  const unsigned G = gridDim.x * gridDim.y * gridDim.z;
  unsigned sum, cnt, mine, sp = 0u;
  for (;;) {
    sum = 0u; cnt = 0u; mine = 0u;
#pragma unroll
    for (unsigned j = 0; j < 16; ++j) { const unsigned c = xb_ld(&bar[XB_XCNT(j)]); sum += c; cnt += (c > 0u) ? 1u : 0u; mine = (j == x) ? c : mine; }
    if (sum == G) break;
    __builtin_amdgcn_s_sleep(1);
    if ((++sp & 255u) == 0u) { if (xb_ld(&bar[XB_TMO])) break; if (sp > XB_SPIN_CAP) { atomicAdd(&bar[XB_TMO], 1u); break; } }
  }
  nloc = mine > 0u ? mine : 1u; nx = cnt > 0u ? cnt : 1u;
}
__device__ __forceinline__ void xcd_barrier(const XcdBarrier& b) {
  asm volatile("s_waitcnt vmcnt(0)" ::: "memory");
  __syncthreads();
  if (threadIdx.x == 0) {
    unsigned* bar = b.bar;
    __builtin_amdgcn_s_waitcnt(0);
    unsigned nloc = b.st[0], nx = b.st[1];
    if (nloc == 0u) { xcd_barrier_complete(bar, b.x, nloc, nx); b.st[0] = nloc; b.st[1] = nx; }
    const unsigned old = xb_add(&bar[XB_XSUB(b.x)], 1u);
    const unsigned gen = old / nloc;
    if (old + 1u == (gen + 1u) * nloc) {
      __builtin_amdgcn_fence(__ATOMIC_RELEASE, "agent");
      asm volatile("s_waitcnt vmcnt(0)" ::: "memory");
      const unsigned og = xb_add(&bar[XB_TOP], 1u);
      const unsigned tg = og / nx;
      if (og + 1u == (tg + 1u) * nx) xb_add(&bar[XB_TOPGEN], 1u);
      else XB_SPIN(xb_ld(&bar[XB_TOPGEN]) == tg, bar);
      __builtin_amdgcn_fence(__ATOMIC_ACQUIRE, "agent");
      xb_add(&bar[XB_XGEN(b.x)], 1u);
      asm volatile("s_waitcnt vmcnt(0)" ::: "memory");
    } else {
      XB_SPIN(xb_ld(&bar[XB_XGEN(b.x)]) == gen, bar);
      __builtin_amdgcn_fence(__ATOMIC_ACQUIRE, "agent");
      asm volatile("s_waitcnt vmcnt(0)" ::: "memory");
    }
  }
  __syncthreads();
}

__global__ void __launch_bounds__(512) mega(Params p) {
  extern __shared__ __attribute__((aligned(16))) char smem[];
  cg::grid_group grid = cg::this_grid();
  const int G = gridDim.x, bid = blockIdx.x;
  volatile LDSP(unsigned) xst = (volatile LDSP(unsigned))(smem + LDS_TOTAL - 16);
  if (threadIdx.x == 0) { xst[0] = 0u; xst[1] = 0u; xst[2] = 0u; xst[3] = 0u; }
  __syncthreads();
  XcdBarrier xb = xcd_barrier_post((unsigned*)(p.ws + W_BAR), xst);
  phase_convert(p, smem);
  row_pass(p, 0, smem);
  grid.sync();
#pragma unroll 1
  for (int l = 0; l < NL; ++l) {
    for (int it = bid; it < 32; it += G) mlstm_scalars(p, l, it, smem);
    REP(0) {
      const bf16_t* A = (const bf16_t*)(p.ws + W_XB);
      const bf16_t* Bt = (const bf16_t*)(p.ws + W_WTIN) + (size_t)l * NPJ * D;
      const float* bias = p.in[I_BIN] + (size_t)l * INW;
      bf16_t* const P = (bf16_t*)(p.ws + W_P);
      bool primed = false;
#pragma unroll 1
      for (int L = bid; L < 66 * 52; L += G) {
        int pm, pn; tile_map(L, 66, 52, pm, pn, 4);
        f32x4 acc[2][2][4][2];
        gemm_tile(A, Bt, pm * 256, pn * 256, smem, acc, primed);
        EPI_IDX
        float4 bvv[2][2];
#pragma unroll
        for (int bj = 0; bj < 2; ++bj)
#pragma unroll
          for (int n = 0; n < 2; ++n) {
            const int col = pn * 256 + bj * 128 + wc * 32 + n * 16 + fq * 4;
            bvv[bj][n] = *(const float4*)(bias + col + (col >= 5120 ? 8 : 0));
          }
        asm volatile("s_waitcnt vmcnt(0)" ::: "memory");
        primed = (L + G < 66 * 52);
        if (primed) { int pm2, pn2; tile_map(L + G, 66, 52, pm2, pn2, 4); gemm_tile(A, Bt, pm2 * 256, pn2 * 256, smem, acc, false, true); }
        EPI_LOOP {
          const int row = pm * 256 + ai * 128 + wr * 64 + m * 16 + fr, col = pn * 256 + bj * 128 + wc * 32 + n * 16 + fq * 4;
          const float4 bv = bvv[bj][n];
          uint2 o;
          o.x = pk2(acc[ai][bj][m][n][0] + bv.x, acc[ai][bj][m][n][1] + bv.y);
          o.y = pk2(acc[ai][bj][m][n][2] + bv.z, acc[ai][bj][m][n][3] + bv.w);
          *(uint2*)(P + (size_t)row * NPJ + col) = o;
        }
      }
    }
    GSYNC;
    {
      unsigned* qbase = (unsigned*)(p.ws + W_QCT) + l * 64;
      volatile LDSP(int) qslot = (volatile LDSP(int))(smem + LDS_TOTAL - 32);
      const int xq = (int)(xb.x & 7u);
      int it;
      if (threadIdx.x == 0) qslot[0] = (int)xb_add(qbase, 1u);
      __syncthreads();
      it = qslot[0];
#pragma unroll 1
      while (it < 664) {
        __syncthreads();
        int nxt = 0;
        if (threadIdx.x == 0) nxt = (int)xb_add(qbase, 1u);
        int r = it;
        if (r < 656) {
          if (r < 512) mlstm_sample(p, l, r >> 2, r & 3, smem);
          else if (r < 640) gmlp_sample(p, l, r - 512, smem);
          else lru_tile(p, l, (r - 640) >> 2, r & 3, true, smem);
          dep_signal(qbase + 16);
        } else {
          r -= 656;
          dep_wait(qbase + 16, 656u);
          x4_unit(p, l, 64 + (r >> 2), r & 3, smem);
          dep_signal(qbase + 32 + 16 * (r >> 2));
        }
        if (threadIdx.x == 0) qslot[0] = nxt;
        __syncthreads();
        it = qslot[0];
      }
      __syncthreads();
      if (threadIdx.x == 0) qslot[0] = (int)xb_add(qbase + 4 + xq, 1u);
      __syncthreads();
      it = qslot[0];
#pragma unroll 1
      while (it < 64) {
        __syncthreads();
        mlstm_flash(p, l, 4 * xq + (it & 3), 15 - (it >> 2), smem);
        if (threadIdx.x == 0) qslot[0] = (int)xb_add(qbase + 4 + xq, 1u);
        __syncthreads();
        it = qslot[0];
      }
      __syncthreads();
      if (threadIdx.x == 0) qslot[0] = (int)xb_add(qbase + 2, 1u);
      __syncthreads();
      it = qslot[0];
#pragma unroll 1
      while (it < 1160) {
        __syncthreads();
        int nxt = 0;
        if (threadIdx.x == 0) nxt = (int)xb_add(qbase + 2, 1u);
        int r = it;
        if (r < 8) { dep_wait(qbase + 32 + 16 * (r >> 2), 4u); x5_unit(p, l, 64 + (r >> 2), r & 3, smem); }
        else if (r < 136) { r -= 8; mlstm_final(p, l, r >> 2, r & 3, smem); }
        else if (r < 648) { r -= 136; lru_tile(p, l, r >> 2, r & 3, false, smem); }
        else { r -= 648; gmlp_prompt(p, l, r >> 6, (r >> 2) & 15, r & 3, smem); }
        if (threadIdx.x == 0) qslot[0] = nxt;
        __syncthreads();
        it = qslot[0];
      }
    }
    GSYNC;
    for (int it = bid; it < 256; it += G) lru_fix(p, l, it >> 1, it & 1);
    GSYNC;
#pragma unroll 1
    for (int L = bid; L < 64 * 4; L += G) { int pm, pn; tile_map(L, 64, 4, pm, pn); x4_unit(p, l, pm, pn, smem); }
    GSYNC;
#pragma unroll 1
    for (int L = bid; L < 64 * 4; L += G) { int pm, pn; tile_map(L, 64, 4, pm, pn); x5_unit(p, l, pm, pn, smem); }
    GSYNC;
    row_pass(p, l + 1, smem);
    GSYNC;
  }
}

extern "C" void kernel_launch(void* const* d_in, const int* in_sizes, int n_in, void* d_out, int out_size, void* d_ws,
                              size_t ws_size, hipStream_t stream) {
  constexpr size_t kLds = LDS_TOTAL;
  static int grid_blocks = 0;
  if (!grid_blocks) {
    int dev = 0, cus = 0, per_cu = 0;
    (void)hipGetDevice(&dev);
    (void)hipDeviceGetAttribute(&cus, hipDeviceAttributeMultiprocessorCount, dev);
    (void)hipFuncSetAttribute((const void*)mega, hipFuncAttributeMaxDynamicSharedMemorySize, (int)kLds);
    (void)hipOccupancyMaxActiveBlocksPerMultiprocessor(&per_cu, (const void*)mega, 512, kLds);
    if (per_cu < 1) per_cu = 1;
    grid_blocks = cus * per_cu;
    if (grid_blocks % 8) grid_blocks -= grid_blocks % 8;
    if (ws_size < W_END || n_in != 27 || (size_t)out_size != O_END)
      fprintf(stderr, "kernel_launch: unexpected sizes ws %zu (need %zu) n_in %d out %d (expect %zu)\n", ws_size,
              (size_t)W_END, n_in, out_size, (size_t)O_END);
  }
  (void)hipMemsetAsync((char*)d_ws + W_BAR, 0, W_CTL_END - W_BAR, stream);
  Params p{};
  for (int i = 0; i < 27; ++i) p.in[i] = (const float*)d_in[i];
  p.out = (float*)d_out;
  p.ws = (char*)d_ws;
  void* args[] = {&p};
  hipError_t e = hipLaunchCooperativeKernel((const void*)mega, dim3(grid_blocks), dim3(512), args, kLds, stream);
  if (e != hipSuccess) fprintf(stderr, "cooperative launch failed: %s (grid %d)\n", hipGetErrorString(e), grid_blocks);
}
```

```cpp
#include <hip/hip_runtime.h>
#include <hip/hip_cooperative_groups.h>
#include <cstdio>
#include <cstdint>
namespace cg = cooperative_groups;

typedef unsigned short bf16_t;
typedef short bf16x8 __attribute__((ext_vector_type(8)));
typedef short s16x4 __attribute__((ext_vector_type(4)));
typedef float f32x4 __attribute__((ext_vector_type(4)));
#define LDSP(T) __attribute__((address_space(3))) T*

constexpr int D = 1024, NPR = 16384, NSM = 512, MT = 16896, NL = 4, SEQ = 2048;
constexpr int INW = 13320, NPJ = 13312;
constexpr int C_Q = 0, C_K = 1024, C_V = 2048, C_O = 3072, C_ZA = 4096, C_UB = 5120, C_VB = 6144, C_ZB = 7168,
              C_XC = 8192, C_ZC = 9216, C_GA = 10240;
constexpr float ALPHA = 1.6817928305074292f;
constexpr float EPS = 1e-5f;
constexpr int LDS_TOTAL = 150 * 1024;
#ifndef DUP_PHASE
#define DUP_PHASE -1
#endif
#define GSYNC xcd_barrier(xb)
#define REP(k) for (int rep_ = 0; rep_ < ((DUP_PHASE == (k)) ? 2 : 1); ++rep_)

constexpr size_t W_WTIN = 0;
constexpr size_t W_WTP = W_WTIN + (size_t)NL * NPJ * D * 2;
constexpr size_t W_WTL = W_WTP + (size_t)NL * 4 * D * D * 2;
constexpr size_t W_WM = W_WTL + (size_t)NL * 2 * 8 * 128 * 128 * 2;
constexpr size_t W_XB = W_WM + (size_t)NL * 4 * 128 * 128 * 2;
constexpr size_t W_XF = W_XB + (size_t)MT * D * 2;
constexpr size_t W_GATE = W_XF + (size_t)MT * D * 4;
constexpr size_t W_P = W_GATE + (size_t)MT * 8 * 4;
constexpr size_t W_PRE = W_P + (size_t)MT * NPJ * 2;
constexpr size_t W_MF = W_PRE + (size_t)MT * D * 4;
constexpr size_t W_MB = W_MF + (size_t)MT * D * 4;
constexpr size_t W_Y = W_MB + (size_t)MT * D * 2;
constexpr size_t W_G = W_Y + (size_t)3 * MT * D * 2;
constexpr size_t W_MX = W_G + (size_t)32 * 2048 * 4;
constexpr size_t W_EM = W_MX + (size_t)32 * 2048 * 4;
constexpr size_t W_LH = W_EM + (size_t)32 * 2048 * 4;
constexpr size_t W_LA = W_LH + (size_t)NPR * D * 2;
constexpr size_t W_LE = W_LA + (size_t)NPR * D * 2;
constexpr size_t W_BAR = W_LE + (size_t)8 * 16 * 1024 * 2 * 4;
constexpr size_t W_QCT = W_BAR + 3456 * 4;
constexpr size_t W_CTL_END = W_QCT + 4 * 256;
constexpr size_t W_END = W_CTL_END;

constexpr size_t O_Y = 0;
constexpr size_t O_CP = (size_t)MT * D;
constexpr size_t O_NP = O_CP + (size_t)NL * 8 * 4 * 256 * 256;
constexpr size_t O_MP = O_NP + (size_t)NL * 8 * 4 * 256;
constexpr size_t O_CONVP = O_MP + (size_t)NL * 8 * 4;
constexpr size_t O_HP = O_CONVP + (size_t)NL * 8 * 3 * 1024;
constexpr size_t O_CS = O_HP + (size_t)NL * 8 * 1024;
constexpr size_t O_NS = O_CS + (size_t)NL * 128 * 4 * 256 * 256;
constexpr size_t O_MS = O_NS + (size_t)NL * 128 * 4 * 256;
constexpr size_t O_CONVS = O_MS + (size_t)NL * 128 * 4;
constexpr size_t O_HS = O_CONVS + (size_t)NL * 128 * 3 * 1024;
constexpr size_t O_VS = O_HS + (size_t)NL * 128 * 1024;
constexpr size_t O_END = O_VS + (size_t)NL * 128 * 4 * 1024;

enum { I_XP = 0, I_XS, I_SC, I_SN, I_SM, I_SCONV, I_SH, I_WIN, I_BIN, I_NORMG, I_GLNG, I_GLNB, I_GWS, I_GBS, I_CONVW,
       I_CONVB, I_WA, I_BA, I_WX, I_BX, I_LAM, I_WPA, I_WPB, I_WPC, I_WOUT, I_LNG, I_LNB };

struct Params {
  const float* in[27];
  float* out;
  char* ws;
};

__device__ __forceinline__ bf16_t f2bf(float f) {
  unsigned u = __float_as_uint(f);
  u += 0x7fffu + ((u >> 16) & 1u);
  return (bf16_t)(u >> 16);
}
__device__ __forceinline__ float bf2f(bf16_t h) { return __uint_as_float(((unsigned)h) << 16); }
__device__ __forceinline__ unsigned pk2(float a, float b) {
  unsigned r;
  asm("v_cvt_pk_bf16_f32 %0, %1, %2" : "=v"(r) : "v"(a), "v"(b));
  return r;
}
__device__ __forceinline__ float bflo(unsigned u) { return __uint_as_float(u << 16); }
__device__ __forceinline__ float bfhi(unsigned u) { return __uint_as_float(u & 0xffff0000u); }
__device__ __forceinline__ float sigm(float x) { return __builtin_amdgcn_rcpf(1.f + __expf(-x)); }
__device__ __forceinline__ float silu(float x) { return x * sigm(x); }
__device__ __forceinline__ float logsig(float x) { return fminf(x, 0.f) - log1pf(__expf(-fabsf(x))); }
__device__ __forceinline__ float shf(float v, int src) {
  return __int_as_float(__builtin_amdgcn_ds_bpermute(src << 2, __float_as_int(v)));
}
#define SHX(v, o) shf((v), lane ^ (o))
#define SHU(v, o) shf((v), (lane >= (o)) ? lane - (o) : lane)
__device__ __forceinline__ float wave_sum_l(float v, int lane) {
#pragma unroll
  for (int o = 1; o < 64; o <<= 1) v += shf(v, lane ^ o);
  return v;
}
#define wave_sum(v) wave_sum_l((v), lane)
__device__ __forceinline__ f32x4 mfma16(bf16x8 a, bf16x8 b, f32x4 c) {
  return __builtin_amdgcn_mfma_f32_16x16x32_bf16(a, b, c, 0, 0, 0);
}
__device__ __forceinline__ bf16x8 frag_t(const bf16_t* T, int stride, int r0, int k0, int lane) {
  const int fr = lane & 15, fq = lane >> 4;
  const bf16_t* q = T + (k0 + fq * 8 + (fr >> 2)) * stride + r0 + (fr & 3) * 4;
  s16x4 a = __builtin_amdgcn_ds_read_tr16_b64_v4i16((LDSP(s16x4))q);
  s16x4 b = __builtin_amdgcn_ds_read_tr16_b64_v4i16((LDSP(s16x4))(q + 4 * stride));
  bf16x8 r = {a[0], a[1], a[2], a[3], b[0], b[1], b[2], b[3]};
  return r;
}
__device__ __forceinline__ void unpack8(uint4 v, float* f) {
  f[0] = bflo(v.x); f[1] = bfhi(v.x); f[2] = bflo(v.y); f[3] = bfhi(v.y);
  f[4] = bflo(v.z); f[5] = bfhi(v.z); f[6] = bflo(v.w); f[7] = bfhi(v.w);
}
__device__ __forceinline__ uint4 pack8(const float* f) {
  uint4 o; o.x = pk2(f[0], f[1]); o.y = pk2(f[2], f[3]); o.z = pk2(f[4], f[5]); o.w = pk2(f[6], f[7]);
  return o;
}

__device__ __forceinline__ int otid() { int t = threadIdx.x; asm volatile("" : "+v"(t)); return t; }

__device__ __forceinline__ void tconv_item(const float* src, int lds_, bf16_t* dst, int ldd, int k0, int n0s, int n0d,
                                           float* scr, int lane) {
#pragma unroll 8
  for (int i = 0; i < 32; ++i) {
    const int kk = 2 * i + (lane >> 5);
    scr[kk * 33 + (lane & 31)] = src[(size_t)(k0 + kk) * lds_ + n0s + (lane & 31)];
  }
  const int c = lane & 7;
#pragma unroll
  for (int j = 0; j < 4; ++j) {
    const int n = (lane >> 3) + 8 * j;
    const float* t = scr + (8 * c) * 33 + n;
    uint4 o;
    o.x = pk2(t[0 * 33], t[1 * 33]); o.y = pk2(t[2 * 33], t[3 * 33]);
    o.z = pk2(t[4 * 33], t[5 * 33]); o.w = pk2(t[6 * 33], t[7 * 33]);
    *(uint4*)(dst + (size_t)(n0d + n) * ldd + k0 + 8 * c) = o;
  }
}

__device__ __forceinline__ void phase_convert(const Params& p, char* smem) {
  const int tid = otid(), lane = tid & 63, wid = tid >> 6;
  float* scr = (float*)smem + wid * (64 * 33);
  constexpr int N_IN = NL * 16 * 416, N_PJ = NL * 4 * 16 * 32, N_LR = NL * 2 * 8 * 8;
  for (int it = blockIdx.x * 8 + wid; it < N_IN + N_PJ + N_LR; it += gridDim.x * 8) {
    int r = it;
    if (r < N_IN) {
      int l = r / (16 * 416), q = r % (16 * 416), kt = q / 416, nt = q % 416;
      int n0d = nt * 32, n0s = n0d + (n0d >= 5120 ? 8 : 0);
      tconv_item(p.in[I_WIN] + (size_t)l * D * INW, INW, (bf16_t*)(p.ws + W_WTIN) + (size_t)l * NPJ * D, D, kt * 64, n0s,
                 n0d, scr, lane);
      continue;
    }
    r -= N_IN;
    if (r < N_PJ) {
      int lm = r >> 9, q = r & 511, kt = q >> 5, nt = q & 31, l = lm >> 2, mat = lm & 3;
      const float* src = p.in[I_WPA + mat] + (size_t)l * D * D;
      tconv_item(src, D, (bf16_t*)(p.ws + W_WTP) + (size_t)lm * D * D, D, kt * 64, nt * 32, nt * 32, scr, lane);
      continue;
    }
    r -= N_PJ;
    {
      int q = r & 7, lmn = r >> 3, n = lmn & 7, mat = (lmn >> 3) & 1, l = lmn >> 4;
      const float* src = p.in[mat ? I_WX : I_WA] + (size_t)(l * 8 + n) * 16384;
      tconv_item(src, 128, (bf16_t*)(p.ws + W_WTL) + (size_t)((l * 2 + mat) * 8 + n) * 16384, 128, (q >> 2) * 64,
                 (q & 3) * 32, (q & 3) * 32, scr, lane);
    }
  }
  __syncthreads();
  bf16_t* wm = (bf16_t*)(p.ws + W_WM);
  const float* gws = p.in[I_GWS];
  for (int idx = blockIdx.x * 512 + otid(); idx < NL * 4 * 128 * 128; idx += gridDim.x * 512) {
    int t = (idx >> 7) & 127, s = idx & 127;
    wm[idx] = f2bf(s <= t ? gws[idx] : 0.f);
  }
}

__device__ __forceinline__ void row_pass(const Params& p, int l, char* smem) {
  const int tid = otid(), lane = tid & 63, wid = tid >> 6;
  float* sWg = (float*)smem;
  if (l < NL) {
    const float* w = p.in[I_WIN] + (size_t)l * D * INW;
    for (int idx = tid; idx < 8192; idx += 512) {
      int j = idx >> 10, k = idx & 1023;
      sWg[idx] = w[(size_t)k * INW + 5120 + j];
    }
  }
  __syncthreads();
  bf16_t* XB = (bf16_t*)(p.ws + W_XB);
  float* XF = (float*)(p.ws + W_XF);
  const float* PRE = (const float*)(p.ws + W_PRE);
  float* GATE = (float*)(p.ws + W_GATE);
  for (int r = blockIdx.x * 8 + wid; r < MT; r += gridDim.x * 8) {
    float4 v[4];
    if (l == 0) {
      const float* src = r < NPR ? p.in[I_XP] + (size_t)r * D : p.in[I_XS] + (size_t)(r - NPR) * D;
#pragma unroll
      for (int i = 0; i < 4; ++i) v[i] = ((const float4*)src)[lane + 64 * i];
    } else {
      const float* src = PRE + (size_t)r * D;
      float s = 0.f;
#pragma unroll
      for (int i = 0; i < 4; ++i) { v[i] = ((const float4*)src)[lane + 64 * i]; s += (v[i].x + v[i].y) + (v[i].z + v[i].w); }
      const float mean = wave_sum(s) * (1.f / D);
      float s2 = 0.f;
#pragma unroll
      for (int i = 0; i < 4; ++i) {
        v[i].x -= mean; v[i].y -= mean; v[i].z -= mean; v[i].w -= mean;
        s2 += (v[i].x * v[i].x + v[i].y * v[i].y) + (v[i].z * v[i].z + v[i].w * v[i].w);
      }
      const float rstd = rsqrtf(wave_sum(s2) * (1.f / D) + EPS);
      const float4* g4 = (const float4*)(p.in[I_LNG] + (size_t)(l - 1) * D);
      const float4* b4 = (const float4*)(p.in[I_LNB] + (size_t)(l - 1) * D);
      float* dst = (l == NL) ? p.out + O_Y + (size_t)r * D : XF + (size_t)r * D;
#pragma unroll
      for (int i = 0; i < 4; ++i) {
        float4 g = g4[lane + 64 * i], b = b4[lane + 64 * i];
        v[i].x = v[i].x * rstd * g.x + b.x; v[i].y = v[i].y * rstd * g.y + b.y;
        v[i].z = v[i].z * rstd * g.z + b.z; v[i].w = v[i].w * rstd * g.w + b.w;
        ((float4*)dst)[lane + 64 * i] = v[i];
      }
    }
    if (l < NL) {
#pragma unroll
      for (int i = 0; i < 4; ++i) {
        uint2 o; o.x = pk2(v[i].x, v[i].y); o.y = pk2(v[i].z, v[i].w);
        ((uint2*)(XB + (size_t)r * D))[lane + 64 * i] = o;
      }
      float ga[8];
#pragma unroll
      for (int j = 0; j < 8; ++j) {
        float a = 0.f;
#pragma unroll
        for (int i = 0; i < 4; ++i) {
          float4 w = ((const float4*)(sWg + j * 1024))[lane + 64 * i];
          a += v[i].x * w.x + v[i].y * w.y + v[i].z * w.z + v[i].w * w.w;
        }
        ga[j] = wave_sum(a);
      }
      if (lane == 0) {
        const float* bi = p.in[I_BIN] + (size_t)l * INW + 5120;
        float4 o0 = {ga[0] + bi[0], ga[1] + bi[1], ga[2] + bi[2], ga[3] + bi[3]};
        float4 o1 = {ga[4] + bi[4], ga[5] + bi[5], ga[6] + bi[6], ga[7] + bi[7]};
        ((float4*)(GATE + (size_t)r * 8))[0] = o0;
        ((float4*)(GATE + (size_t)r * 8))[1] = o1;
      }
    }
  }
  __syncthreads();
}

constexpr int KD = 1024, BK = 64, HALF = 128, HTB = HALF * BK * 2;
__device__ __forceinline__ int lds_byte(int r, int c) {
  int st = (r >> 4) * 2 + (c >> 5), rr = r & 15, cc = c & 31, ob = rr * 64 + cc * 2;
  return st * 1024 + (ob ^ (((ob >> 9) & 1) << 5));
}
__device__ __forceinline__ void stage_rc(int b, int& R, int& C) {
  int st = b / 1024, sb = b % 1024, swz = sb ^ (((sb >> 9) & 1) << 5);
  R = (st >> 1) * 16 + swz / 64;
  C = (st & 1) * 32 + (swz % 64) / 2;
}
__device__ __forceinline__ void tile_map(int L, int nM, int nN, int& pm, int& pn, int WGM_ = 8) {
  int nwg = nM * nN, q = nwg / 8, r = nwg % 8, xcd = L % 8, off = L / 8;
  int wgid = (xcd < r ? xcd * (q + 1) : r * (q + 1) + (xcd - r) * q) + off;
  int nig = WGM_ * nN, gid = wgid / nig, fm = gid * WGM_, gsz = min(nM - fm, WGM_);
  pm = fm + ((wgid % nig) % gsz);
  pn = (wgid % nig) / gsz;
}

__device__ __forceinline__ void gemm_tile(const bf16_t* __restrict__ A, const bf16_t* __restrict__ Bt, int brow, int bcol,
                                          char* shm, f32x4 (&acc)[2][2][4][2], bool primed = false, bool prime_only = false) {
#define SAO(b, h) (((b) * 2 + (h)) * HTB)
#define SBO(b, h) ((4 + (b) * 2 + (h)) * HTB)
#define STAGE(BO, BASE, br, kt)                                                                              \
  do {                                                                                                       \
    const char* _gb = (const char*)(BASE) + ((size_t)(br) * KD + (size_t)(kt) * BK) * 2;                     \
    __builtin_amdgcn_global_load_lds((const unsigned*)(_gb + toff0), (unsigned*)(shm + (BO) + tb0), 16, 0, 0); \
    __builtin_amdgcn_global_load_lds((const unsigned*)(_gb + toff1), (unsigned*)(shm + (BO) + tb1), 16, 0, 0); \
  } while (0)
#define LDA(dst, b, h)                                                                                         \
  _Pragma("unroll") for (int m = 0; m < 4; ++m) _Pragma("unroll") for (int k = 0; k < 2; ++k) dst[m][k] =      \
      *reinterpret_cast<const bf16x8*>(shm + SAO(b, h) + lds_byte(wr * 64 + m * 16 + fr, k * 32 + fq * 8))
#define LDB(dst, b, h)                                                                                         \
  _Pragma("unroll") for (int n = 0; n < 2; ++n) _Pragma("unroll") for (int k = 0; k < 2; ++k) dst[n][k] =      \
      *reinterpret_cast<const bf16x8*>(shm + SBO(b, h) + lds_byte(wc * 32 + n * 16 + fr, k * 32 + fq * 8))
#define MMA(ai, bj, At_, Bt_)                                                                               \
  do {                                                                                                      \
    __builtin_amdgcn_s_setprio(1);                                                                          \
    _Pragma("unroll") for (int m = 0; m < 4; ++m) _Pragma("unroll") for (int n = 0; n < 2; ++n)             \
        _Pragma("unroll") for (int k = 0; k < 2; ++k) acc[ai][bj][m][n] =                                   \
            __builtin_amdgcn_mfma_f32_16x16x32_bf16(Bt_[n][k], At_[m][k], acc[ai][bj][m][n], 0, 0, 0);     \
    __builtin_amdgcn_s_setprio(0);                                                                          \
  } while (0)
#define WAIT_V(n) asm volatile("s_waitcnt vmcnt(" #n ")" ::: "memory")
#define WAIT_L(n) asm volatile("s_waitcnt lgkmcnt(" #n ")" ::: "memory")
#define BAR __builtin_amdgcn_s_barrier()
#define SCHED __builtin_amdgcn_sched_barrier(0)
  const int tidg = otid();
  const int wid = tidg >> 6, lane = tidg & 63, wr = wid >> 2, wc = wid & 3, fr = lane & 15, fq = lane >> 4;
  const int tb0 = tidg * 16, tb1 = tb0 + 8192;
  unsigned toff0, toff1;
  {
    int r_, c_;
    stage_rc(tb0, r_, c_); toff0 = (unsigned)(r_ * KD + c_) * 2u;
    stage_rc(tb1, r_, c_); toff1 = (unsigned)(r_ * KD + c_) * 2u;
  }
  if (prime_only) {
    STAGE(SBO(0, 0), Bt, bcol, 0); STAGE(SAO(0, 0), A, brow, 0);
    STAGE(SBO(0, 1), Bt, bcol + HALF, 0); STAGE(SAO(0, 1), A, brow + HALF, 0);
    STAGE(SBO(1, 0), Bt, bcol, 1); STAGE(SAO(1, 0), A, brow, 1); STAGE(SBO(1, 1), Bt, bcol + HALF, 1);
    return;
  }
#pragma unroll
  for (int a = 0; a < 2; ++a)
#pragma unroll
    for (int b = 0; b < 2; ++b)
#pragma unroll
      for (int m = 0; m < 4; ++m)
#pragma unroll
        for (int n = 0; n < 2; ++n) acc[a][b][m][n] = f32x4{0.f, 0.f, 0.f, 0.f};
  bf16x8 At[4][2], B0[2][2], B1[2][2];
  constexpr int nt = KD / BK;
  if (!primed) {
    __syncthreads();
    STAGE(SBO(0, 0), Bt, bcol, 0); STAGE(SAO(0, 0), A, brow, 0);
    STAGE(SBO(0, 1), Bt, bcol + HALF, 0); STAGE(SAO(0, 1), A, brow + HALF, 0);
    STAGE(SBO(1, 0), Bt, bcol, 1); STAGE(SAO(1, 0), A, brow, 1); STAGE(SBO(1, 1), Bt, bcol + HALF, 1);
  }
  if (wr == 1) BAR;
  WAIT_V(0); BAR;
  BAR;
#pragma unroll 1
  for (int t = 0; t < nt - 2; t += 2) {
    LDB(B0, 0, 0); SCHED; LDA(At, 0, 0); STAGE(SAO(1, 1), A, brow + HALF, t + 1);
    WAIT_L(8); BAR; WAIT_L(0); MMA(0, 0, At, B0); BAR; SCHED;
    LDB(B1, 0, 1); STAGE(SBO(0, 0), Bt, bcol, t + 2);
    BAR; WAIT_L(0); MMA(0, 1, At, B1); BAR;
    LDA(At, 0, 1); STAGE(SAO(0, 0), A, brow, t + 2);
    BAR; WAIT_L(0); MMA(1, 0, At, B0); BAR; SCHED;
    STAGE(SBO(0, 1), Bt, bcol + HALF, t + 2);
    WAIT_V(6); BAR; MMA(1, 1, At, B1); BAR;
    LDB(B0, 1, 0); SCHED; LDA(At, 1, 0); STAGE(SAO(0, 1), A, brow + HALF, t + 2);
    WAIT_L(8); BAR; WAIT_L(0); MMA(0, 0, At, B0); BAR; SCHED;
    LDB(B1, 1, 1); STAGE(SBO(1, 0), Bt, bcol, t + 3);
    BAR; WAIT_L(0); MMA(0, 1, At, B1); BAR;
    LDA(At, 1, 1); STAGE(SAO(1, 0), A, brow, t + 3);
    BAR; WAIT_L(0); MMA(1, 0, At, B0); BAR; SCHED;
    STAGE(SBO(1, 1), Bt, bcol + HALF, t + 3);
    WAIT_V(6); BAR; MMA(1, 1, At, B1); BAR;
  }
  {
    LDB(B0, 0, 0); LDA(At, 0, 0); STAGE(SAO(1, 1), A, brow + HALF, nt - 1);
    BAR; WAIT_L(0); MMA(0, 0, At, B0); BAR;
    LDB(B1, 0, 1); BAR; WAIT_L(0); MMA(0, 1, At, B1); BAR;
    LDA(At, 0, 1); WAIT_V(4); BAR; WAIT_L(0); MMA(1, 0, At, B0); MMA(1, 1, At, B1); BAR;
  }
  {
    LDB(B0, 1, 0); LDA(At, 1, 0); WAIT_V(2); BAR; WAIT_L(0); MMA(0, 0, At, B0); BAR;
    LDB(B1, 1, 1); WAIT_V(0); BAR; WAIT_L(0); MMA(0, 1, At, B1); BAR;
    LDA(At, 1, 1); BAR; WAIT_L(0); MMA(1, 0, At, B0); MMA(1, 1, At, B1); BAR;
  }
  if (wr == 0) BAR;
}
#define EPI_IDX const int tide = otid(), wid = tide >> 6, lane = tide & 63, wr = wid >> 2, wc = wid & 3, fr = lane & 15, fq = lane >> 4;
#define EPI_LOOP                                                                     \
  _Pragma("unroll") for (int ai = 0; ai < 2; ++ai) _Pragma("unroll") for (int bj = 0; bj < 2; ++bj) \
      _Pragma("unroll") for (int m = 0; m < 4; ++m) _Pragma("unroll") for (int n = 0; n < 2; ++n)

__device__ __forceinline__ void mlstm_scalars(const Params& p, int l, int bh, char* smem) {
  const int tid = otid(), lane = tid & 63, wid = tid >> 6;
  float* sred = (float*)smem;
  const float* GATE = (const float*)(p.ws + W_GATE);
  const int b = bh >> 2, h = bh & 3;
  float itv[4], c[4];
#pragma unroll
  for (int r = 0; r < 4; ++r) {
    size_t row = (size_t)b * SEQ + tid * 4 + r;
    itv[r] = GATE[row * 8 + h];
    c[r] = logsig(GATE[row * 8 + 4 + h]);
  }
  c[1] += c[0]; c[2] += c[1]; c[3] += c[2];
  float inc = c[3];
#pragma unroll
  for (int o = 1; o < 64; o <<= 1) { float t = SHU(inc, o); if (lane >= o) inc += t; }
  if (lane == 63) sred[wid] = inc;
  __syncthreads();
  float base = 0.f;
  for (int w = 0; w < wid; ++w) base += sred[w];
  __syncthreads();
  const float excl = base + inc - c[3];
  float g[4], mx[4];
#pragma unroll
  for (int r = 0; r < 4; ++r) { c[r] += excl; g[r] = itv[r] - c[r]; }
  mx[0] = g[0]; mx[1] = fmaxf(mx[0], g[1]); mx[2] = fmaxf(mx[1], g[2]); mx[3] = fmaxf(mx[2], g[3]);
  float minc = mx[3];
#pragma unroll
  for (int o = 1; o < 64; o <<= 1) { float t = SHU(minc, o); if (lane >= o) minc = fmaxf(minc, t); }
  if (lane == 63) sred[wid] = minc;
  __syncthreads();
  float mb = 0.f;
  for (int w = 0; w < wid; ++w) mb = fmaxf(mb, sred[w]);
  float prev = SHU(minc, 1);
  if (lane > 0) mb = fmaxf(mb, prev);
  __syncthreads();
  float* G = (float*)(p.ws + W_G) + (size_t)bh * SEQ;
  float* MX = (float*)(p.ws + W_MX) + (size_t)bh * SEQ;
  float* EM = (float*)(p.ws + W_EM) + (size_t)bh * SEQ;
  float4 og, om, oe;
  float mxv[4], mv[4];
#pragma unroll
  for (int r = 0; r < 4; ++r) { mxv[r] = fmaxf(mb, mx[r]); mv[r] = c[r] + mxv[r]; }
  og = float4{g[0], g[1], g[2], g[3]};
  om = float4{mxv[0], mxv[1], mxv[2], mxv[3]};
  oe = float4{__expf(-mv[0]), __expf(-mv[1]), __expf(-mv[2]), __expf(-mv[3])};
  ((float4*)G)[tid] = og; ((float4*)MX)[tid] = om; ((float4*)EM)[tid] = oe;
  if (tid == 511) p.out[O_MP + (size_t)l * 32 + bh] = mv[3];
}

__device__ __forceinline__ void mlstm_flash(const Params& p, int l, int bh, int qi, char* smem) {
  const int tid = otid(), lane = tid & 63, wid = tid >> 6, fr = lane & 15, fq = lane >> 4, wr = wid >> 1, wc = wid & 1;
  const int b = bh >> 2, h = bh & 3;
  char* sKb = smem;
  char* sVb = smem + 65536;
  bf16_t* sP = (bf16_t*)(smem + 131072);
  float* sRed = (float*)(smem + 131072);
  const bf16_t* P = (const bf16_t*)(p.ws + W_P);
  const float* G = (const float*)(p.ws + W_G) + (size_t)bh * SEQ;
  const float* MX = (const float*)(p.ws + W_MX) + (size_t)bh * SEQ;
  const float* EM = (const float*)(p.ws + W_EM) + (size_t)bh * SEQ;
  const size_t rowbase = (size_t)b * SEQ;
  const int nblk = 2 * qi + 2;
#define FL_ISSUE(jb)                                                                                              \
  do {                                                                                                            \
    const int buf_ = (jb) & 1;                                                                                    \
    const bf16_t* rp0_ = P + (rowbase + (size_t)(jb) * 64) * NPJ + h * 256;                                       \
    _Pragma("unroll") for (int i_ = 0; i_ < 4; ++i_) {                                                            \
      const int r_ = (wid * 4 + i_) * 2 + (lane >> 5), cs_ = lane & 31;                                           \
      const int ck_ = cs_ ^ (r_ & 31), cv_ = cs_ ^ (((r_ & 3) << 1) | (r_ & 8));                                  \
      __builtin_amdgcn_global_load_lds((const unsigned*)(rp0_ + (size_t)r_ * NPJ + C_K + ck_ * 8),                \
                                       (unsigned*)(sKb + buf_ * 32768 + (wid * 4 + i_) * 1024 + lane * 16), 16, 0, 0); \
      __builtin_amdgcn_global_load_lds((const unsigned*)(rp0_ + (size_t)r_ * NPJ + C_V + cv_ * 8),                \
                                       (unsigned*)(sVb + buf_ * 32768 + (wid * 4 + i_) * 1024 + lane * 16), 16, 0, 0); \
    }                                                                                                             \
  } while (0)
  FL_ISSUE(0);
  bf16x8 qf[2][8];
  float mxr[2];
#pragma unroll
  for (int m = 0; m < 2; ++m) {
    const int t = qi * 128 + wr * 32 + m * 16 + fr;
    const bf16_t* qp = P + (rowbase + t) * NPJ + C_Q + h * 256 + fq * 8;
#pragma unroll
    for (int kk = 0; kk < 8; ++kk) qf[m][kk] = *(const bf16x8*)(qp + kk * 32);
    mxr[m] = MX[t];
  }
  f32x4 oacc[2][8];
#pragma unroll
  for (int m = 0; m < 2; ++m)
#pragma unroll
    for (int n = 0; n < 8; ++n) oacc[m][n] = f32x4{0.f, 0.f, 0.f, 0.f};
  float den[2] = {0.f, 0.f};
#pragma unroll 1
  for (int j = 0; j < nblk; ++j) {
    asm volatile("s_waitcnt vmcnt(0)" ::: "memory");
    __syncthreads();
    if (j + 1 < nblk) FL_ISSUE(j + 1);
    const char* sK = sKb + (j & 1) * 32768;
    const char* sV = sVb + (j & 1) * 32768;
    f32x4 sacc[2][2];
#pragma unroll
    for (int m = 0; m < 2; ++m)
#pragma unroll
      for (int n = 0; n < 2; ++n) sacc[m][n] = f32x4{0.f, 0.f, 0.f, 0.f};
#pragma unroll
    for (int kk = 0; kk < 8; ++kk)
#pragma unroll
      for (int n = 0; n < 2; ++n) {
        const int row = wc * 32 + n * 16 + fr, c = kk * 4 + fq;
        bf16x8 kf = *(const bf16x8*)(sK + row * 512 + ((c ^ (row & 31)) << 4));
        sacc[0][n] = mfma16(kf, qf[0][kk], sacc[0][n]);
        sacc[1][n] = mfma16(kf, qf[1][kk], sacc[1][n]);
      }
#pragma unroll
    for (int n = 0; n < 2; ++n) {
      const int s0 = j * 64 + wc * 32 + n * 16 + fq * 4;
      const float4 g4 = *(const float4*)(G + s0);
      const float gs[4] = {g4.x, g4.y, g4.z, g4.w};
#pragma unroll
      for (int m = 0; m < 2; ++m) {
        const int t = qi * 128 + wr * 32 + m * 16 + fr;
        float v[4];
#pragma unroll
        for (int r = 0; r < 4; ++r) {
          float w = (s0 + r <= t) ? __expf(gs[r] - mxr[m]) : 0.f;
          v[r] = sacc[m][n][r] * 0.0625f * w;
          den[m] += v[r];
        }
        uint2 pk; pk.x = pk2(v[0], v[1]); pk.y = pk2(v[2], v[3]);
        *(uint2*)(sP + (wr * 32 + m * 16 + fr) * 72 + wc * 32 + n * 16 + fq * 4) = pk;
      }
    }
    __syncthreads();
#pragma unroll
    for (int kk = 0; kk < 2; ++kk) {
      bf16x8 pf0 = *(const bf16x8*)(sP + (wr * 32 + fr) * 72 + kk * 32 + fq * 8);
      bf16x8 pf1 = *(const bf16x8*)(sP + (wr * 32 + 16 + fr) * 72 + kk * 32 + fq * 8);
      const int srow = kk * 32 + fq * 8 + (fr >> 2);
      const int swz = ((srow & 3) << 1) | (srow & 8);
#pragma unroll
      for (int n2 = 0; n2 < 8; ++n2) {
        const int ch = ((wc * 128 + n2 * 16) >> 3) + ((fr & 3) >> 1);
        const char* va = sV + srow * 512 + ((ch ^ swz) << 4) + (fr & 1) * 8;
        s16x4 a = __builtin_amdgcn_ds_read_tr16_b64_v4i16((LDSP(s16x4))va);
        s16x4 bq = __builtin_amdgcn_ds_read_tr16_b64_v4i16((LDSP(s16x4))(va + 4 * 512));
        bf16x8 vf = {a[0], a[1], a[2], a[3], bq[0], bq[1], bq[2], bq[3]};
        oacc[0][n2] = mfma16(vf, pf0, oacc[0][n2]);
        oacc[1][n2] = mfma16(vf, pf1, oacc[1][n2]);
      }
    }
  }
  __syncthreads();
#undef FL_ISSUE
  float dn[2];
#pragma unroll
  for (int m = 0; m < 2; ++m) {
    float v = den[m];
    v += SHX(v, 16); v += SHX(v, 32);
    if (fq == 0) sRed[wc * 128 + wr * 32 + m * 16 + fr] = v;
  }
  __syncthreads();
#pragma unroll
  for (int m = 0; m < 2; ++m) {
    const int tl = wr * 32 + m * 16 + fr;
    float d = sRed[tl] + sRed[128 + tl];
    dn[m] = 1.f / fmaxf(fabsf(d), EM[qi * 128 + tl]);
  }
  float s1[2] = {0.f, 0.f}, s2[2] = {0.f, 0.f};
#pragma unroll
  for (int m = 0; m < 2; ++m) {
    const size_t row = rowbase + qi * 128 + wr * 32 + m * 16 + fr;
#pragma unroll
    for (int n2 = 0; n2 < 8; ++n2) {
      const int col = h * 256 + wc * 128 + n2 * 16 + fq * 4;
      const uint2 ov = *(const uint2*)(P + row * NPJ + C_O + col);
      const float o[4] = {bflo(ov.x), bfhi(ov.x), bflo(ov.y), bfhi(ov.y)};
#pragma unroll
      for (int r = 0; r < 4; ++r) {
        float hv = oacc[m][n2][r] * dn[m] * sigm(o[r]);
        oacc[m][n2][r] = hv;
        s1[m] += hv; s2[m] += hv * hv;
      }
    }
  }
#pragma unroll
  for (int m = 0; m < 2; ++m) {
    float a = s1[m], q = s2[m];
    a += SHX(a, 16); a += SHX(a, 32);
    q += SHX(q, 16); q += SHX(q, 32);
    if (fq == 0) { sRed[256 + wc * 128 + wr * 32 + m * 16 + fr] = a; sRed[512 + wc * 128 + wr * 32 + m * 16 + fr] = q; }
  }
  __syncthreads();
  bf16_t* Y0 = (bf16_t*)(p.ws + W_Y);
  const float* ng = p.in[I_NORMG] + (size_t)l * D;
#pragma unroll
  for (int m = 0; m < 2; ++m) {
    const int tl = wr * 32 + m * 16 + fr;
    const float mean = (sRed[256 + tl] + sRed[256 + 128 + tl]) * (1.f / 256.f);
    const float var = (sRed[512 + tl] + sRed[512 + 128 + tl]) * (1.f / 256.f) - mean * mean;
    const float rstd = rsqrtf(fmaxf(var, 0.f) + EPS);
    const size_t row = rowbase + qi * 128 + tl;
#pragma unroll
    for (int n2 = 0; n2 < 8; ++n2) {
      const int col = h * 256 + wc * 128 + n2 * 16 + fq * 4;
      const uint2 zv = *(const uint2*)(P + row * NPJ + C_ZA + col);
      const float4 g4 = *(const float4*)(ng + col);
      const float z[4] = {bflo(zv.x), bfhi(zv.x), bflo(zv.y), bfhi(zv.y)};
      const float gg[4] = {g4.x, g4.y, g4.z, g4.w};
      float y[4];
#pragma unroll
      for (int r = 0; r < 4; ++r) y[r] = (oacc[m][n2][r] - mean) * rstd * gg[r] * silu(z[r]);
      uint2 o; o.x = pk2(y[0], y[1]); o.y = pk2(y[2], y[3]);
      *(uint2*)(Y0 + row * D + col) = o;
    }
  }
  __syncthreads();
}

__device__ __forceinline__ void mlstm_final(const Params& p, int l, int bh, int dq, char* smem) {
  const int tid = otid(), lane = tid & 63, wid = tid >> 6, fr = lane & 15, fq = lane >> 4, wr = wid >> 2, wc = wid & 3;
  const int b = bh >> 2, h = bh & 3;
  char* sVb = smem;
  char* sKb = smem + 98304;
  float* sWall = (float*)(smem + 122880);
  float* sW = (float*)(smem + 131072);
  const bf16_t* P = (const bf16_t*)(p.ws + W_P);
  const float* G = (const float*)(p.ws + W_G) + (size_t)bh * SEQ;
  const float mxl = ((const float*)(p.ws + W_MX))[(size_t)bh * SEQ + SEQ - 1];
  const size_t rowbase = (size_t)b * SEQ;
  {
    const float4 g4 = ((const float4*)G)[tid];
    float4 w4 = {__expf(g4.x - mxl) * 0.0625f, __expf(g4.y - mxl) * 0.0625f, __expf(g4.z - mxl) * 0.0625f, __expf(g4.w - mxl) * 0.0625f};
    ((float4*)sWall)[tid] = w4;
  }
#define FN_ISSUE(jb)                                                                                                  \
  do {                                                                                                                \
    const int buf_ = (jb) % 3;                                                                                        \
    const bf16_t* rp0_ = P + (rowbase + (size_t)(jb) * 64) * NPJ + h * 256;                                           \
    _Pragma("unroll") for (int i_ = 0; i_ < 4; ++i_) {                                                                \
      const int r_ = (wid * 4 + i_) * 2 + (lane >> 5), cs_ = lane & 31;                                               \
      const int cv_ = cs_ ^ (((r_ & 3) << 1) | (r_ & 8));                                                             \
      __builtin_amdgcn_global_load_lds((const unsigned*)(rp0_ + (size_t)r_ * NPJ + C_V + cv_ * 8),                    \
                                       (unsigned*)(sVb + buf_ * 32768 + (wid * 4 + i_) * 1024 + lane * 16), 16, 0, 0); \
    }                                                                                                                 \
    {                                                                                                                 \
      const int r_ = wid * 8 + (lane >> 3), cs_ = lane & 7;                                                           \
      const int ck_ = cs_ ^ ((r_ & 3) << 1);                                                                          \
      __builtin_amdgcn_global_load_lds((const unsigned*)(rp0_ + (size_t)r_ * NPJ + C_K + dq * 64 + ck_ * 8),          \
                                       (unsigned*)(sKb + buf_ * 8192 + wid * 1024 + lane * 16), 16, 0, 0);            \
    }                                                                                                                 \
  } while (0)
  asm volatile("s_waitcnt vmcnt(0)" ::: "memory");
  FN_ISSUE(0);
  FN_ISSUE(1);
  f32x4 acc[2][4];
#pragma unroll
  for (int m = 0; m < 2; ++m)
#pragma unroll
    for (int n = 0; n < 4; ++n) acc[m][n] = f32x4{0.f, 0.f, 0.f, 0.f};
  float nacc = 0.f;
#pragma unroll 1
  for (int j = 0; j < 32; ++j) {
    if (j + 1 < 32) asm volatile("s_waitcnt vmcnt(5)" ::: "memory");
    else asm volatile("s_waitcnt vmcnt(0)" ::: "memory");
    __syncthreads();
    if (j + 2 < 32) FN_ISSUE(j + 2);
    const char* sV = sVb + (j % 3) * 32768;
    const char* sK = sKb + (j % 3) * 8192;
#pragma unroll
    for (int kk = 0; kk < 2; ++kk) {
      const int srow = kk * 32 + fq * 8 + (fr >> 2);
      const float4 wa = *(const float4*)(sWall + j * 64 + kk * 32 + fq * 8);
      const float4 wb = *(const float4*)(sWall + j * 64 + kk * 32 + fq * 8 + 4);
      bf16x8 kf[2];
#pragma unroll
      for (int m = 0; m < 2; ++m) {
        const int d0 = wr * 32 + m * 16 + (fr & 3) * 4;
        const char* ka = sK + srow * 128 + ((((d0 >> 3) ^ ((srow & 3) << 1)) & 7) << 4) + ((d0 >> 2) & 1) * 8;
        s16x4 a = __builtin_amdgcn_ds_read_tr16_b64_v4i16((LDSP(s16x4))ka);
        s16x4 bq = __builtin_amdgcn_ds_read_tr16_b64_v4i16((LDSP(s16x4))(ka + 4 * 128));
        const unsigned u0 = pk2(bf2f((bf16_t)a[0]) * wa.x, bf2f((bf16_t)a[1]) * wa.y);
        const unsigned u1 = pk2(bf2f((bf16_t)a[2]) * wa.z, bf2f((bf16_t)a[3]) * wa.w);
        const unsigned u2 = pk2(bf2f((bf16_t)bq[0]) * wb.x, bf2f((bf16_t)bq[1]) * wb.y);
        const unsigned u3 = pk2(bf2f((bf16_t)bq[2]) * wb.z, bf2f((bf16_t)bq[3]) * wb.w);
        kf[m] = bf16x8{(short)(u0 & 0xffff), (short)(u0 >> 16), (short)(u1 & 0xffff), (short)(u1 >> 16),
                       (short)(u2 & 0xffff), (short)(u2 >> 16), (short)(u3 & 0xffff), (short)(u3 >> 16)};
      }
      const int swz = ((srow & 3) << 1) | (srow & 8);
#pragma unroll
      for (int n = 0; n < 4; ++n) {
        const int ch = ((wc * 64 + n * 16) >> 3) + ((fr & 3) >> 1);
        const char* va = sV + srow * 512 + ((ch ^ swz) << 4) + (fr & 1) * 8;
        s16x4 a = __builtin_amdgcn_ds_read_tr16_b64_v4i16((LDSP(s16x4))va);
        s16x4 bq = __builtin_amdgcn_ds_read_tr16_b64_v4i16((LDSP(s16x4))(va + 4 * 512));
        bf16x8 vf = {a[0], a[1], a[2], a[3], bq[0], bq[1], bq[2], bq[3]};
        acc[0][n] = mfma16(vf, kf[0], acc[0][n]);
        acc[1][n] = mfma16(vf, kf[1], acc[1][n]);
      }
    }
    {
      float a = 0.f;
#pragma unroll
      for (int s8 = 0; s8 < 8; ++s8) {
        const int srow = wid * 8 + s8;
        const bf16_t kv = *(const bf16_t*)(sK + srow * 128 + ((((lane >> 3) ^ ((srow & 3) << 1)) & 7) << 4) + (lane & 7) * 2);
        a += bf2f(kv) * sWall[j * 64 + srow];
      }
      nacc += a;
    }
  }
  __syncthreads();
#undef FN_ISSUE
  float* oc = p.out + O_CP + ((size_t)l * 32 + bh) * 65536;
#pragma unroll
  for (int m = 0; m < 2; ++m)
#pragma unroll
    for (int n = 0; n < 4; ++n) {
      const int d = dq * 64 + wr * 32 + m * 16 + fr, e = wc * 64 + n * 16 + fq * 4;
      *(float4*)(oc + (size_t)d * 256 + e) = float4{acc[m][n][0], acc[m][n][1], acc[m][n][2], acc[m][n][3]};
    }
  sW[tid] = nacc;
  __syncthreads();
  if (tid < 64) {
    float a = 0.f;
#pragma unroll
    for (int w8 = 0; w8 < 8; ++w8) a += sW[w8 * 64 + tid];
    p.out[O_NP + ((size_t)l * 32 + bh) * 256 + dq * 64 + tid] = a;
  }
  __syncthreads();
}

__device__ __forceinline__ void mlstm_sample(const Params& p, int l, int b, int h, char* smem) {
  const int tid = otid(), lane = tid & 63, wid = tid >> 6;
  float* sq = (float*)smem;
  float* sk = sq + 1024;
  float* sv = sk + 1024;
  float* sn0 = sv + 1024;
  float* sqk = sn0 + 256;
  float* ssc = sqk + 32;
  float* sst = ssc + 32;
  float* snum = sst + 32;
  const bf16_t* P = (const bf16_t*)(p.ws + W_P);
  const float* GATE = (const float*)(p.ws + W_GATE);
  const size_t R0 = (size_t)NPR + b * 4;
  const size_t sidx = ((size_t)l * 128 + b) * 4 + h;
#pragma unroll
  for (int i = 0; i < 6; ++i) {
    int idx = tid + 512 * i, which = idx >> 10, t = (idx >> 8) & 3, d = idx & 255;
    sq[idx] = bf2f(P[(R0 + t) * NPJ + which * 1024 + h * 256 + d]);
  }
  if (tid < 256) sn0[tid] = p.in[I_SN][sidx * 256 + tid];
  const float m0 = p.in[I_SM][sidx];
  float g[4], cm[4], mm[4];
  {
    float bc = 0.f, run = m0;
#pragma unroll
    for (int t = 0; t < 4; ++t) {
      float itv = GATE[(R0 + t) * 8 + h];
      bc += logsig(GATE[(R0 + t) * 8 + 4 + h]);
      g[t] = itv - bc;
      run = fmaxf(run, g[t]);
      cm[t] = run;
      mm[t] = bc + run;
    }
  }
  __syncthreads();
  {
    const int pp = tid >> 5, li = tid & 31, t = pp >> 2, s = pp & 3;
    float part = 0.f;
#pragma unroll
    for (int d8 = 0; d8 < 8; ++d8) part += sq[t * 256 + li * 8 + d8] * sk[s * 256 + li * 8 + d8];
#pragma unroll
    for (int o = 16; o >= 1; o >>= 1) part += SHX(part, o);
    if (li == 0) sqk[pp] = part * 0.0625f;
    float part2 = 0.f;
    const int t2 = pp & 3;
#pragma unroll
    for (int d8 = 0; d8 < 8; ++d8) part2 += sq[t2 * 256 + li * 8 + d8] * sn0[li * 8 + d8];
#pragma unroll
    for (int o = 16; o >= 1; o >>= 1) part2 += SHX(part2, o);
    if (li == 0 && pp < 4) sqk[16 + pp] = part2;
  }
  __syncthreads();
  float w[4];
#pragma unroll
  for (int s = 0; s < 4; ++s) w[s] = __expf(g[s] - cm[3]) * 0.0625f;
  const float decay = __expf(m0 - cm[3]);
  if (tid == 0) {
#pragma unroll
    for (int t = 0; t < 4; ++t) {
      const float inter = __expf(m0 - cm[t]);
      float dsum = inter * sqk[16 + t];
#pragma unroll
      for (int s = 0; s < 4; ++s) {
        float st = (s <= t) ? sqk[t * 4 + s] * __expf(g[s] - cm[t]) : 0.f;
        ssc[t * 4 + s] = st;
        dsum += st;
      }
      ssc[16 + t] = inter;
      ssc[20 + t] = 1.f / fmaxf(fabsf(dsum), __expf(-mm[t]));
    }
  }
#pragma unroll
  for (int i = 0; i < 2; ++i) {
    int idx = tid + 512 * i;
    sk[idx] *= w[idx >> 8];
  }
  __syncthreads();
  {
    const int e4 = lane * 4, d0 = wid * 32;
    float4 vv[4], np[4];
#pragma unroll
    for (int s = 0; s < 4; ++s) { vv[s] = *(const float4*)(sv + s * 256 + e4); np[s] = float4{0.f, 0.f, 0.f, 0.f}; }
    const float* c0p = p.in[I_SC] + sidx * 65536;
    float* cop = p.out + O_CS + sidx * 65536;
#pragma unroll 1
    for (int dd = 0; dd < 32; dd += 8) {
      float4 c[8];
#pragma unroll
      for (int u = 0; u < 8; ++u) c[u] = *(const float4*)(c0p + (size_t)(d0 + dd + u) * 256 + e4);
#pragma unroll
      for (int u = 0; u < 8; ++u) {
        const int d = d0 + dd + u;
        float4 cn = {decay * c[u].x, decay * c[u].y, decay * c[u].z, decay * c[u].w};
#pragma unroll
        for (int t = 0; t < 4; ++t) {
          const float qv = sq[t * 256 + d], kv = sk[t * 256 + d];
          np[t].x += qv * c[u].x; np[t].y += qv * c[u].y; np[t].z += qv * c[u].z; np[t].w += qv * c[u].w;
          cn.x += kv * vv[t].x; cn.y += kv * vv[t].y; cn.z += kv * vv[t].z; cn.w += kv * vv[t].w;
        }
        *(float4*)(cop + (size_t)d * 256 + e4) = cn;
      }
    }
#pragma unroll
    for (int t = 0; t < 4; ++t) *(float4*)(snum + (wid * 4 + t) * 256 + e4) = np[t];
  }
  __syncthreads();
  {
    const int t = tid >> 7, e2 = (tid & 127) * 2;
    float hv[2];
    const unsigned ov = *(const unsigned*)(P + (R0 + t) * NPJ + C_O + h * 256 + e2);
    const float o2[2] = {bflo(ov), bfhi(ov)};
    const float inter = ssc[16 + t], dnm = ssc[20 + t];
#pragma unroll
    for (int k = 0; k < 2; ++k) {
      const int e = e2 + k;
      float a = 0.f;
#pragma unroll
      for (int w8 = 0; w8 < 8; ++w8) a += snum[(w8 * 4 + t) * 256 + e];
      float x = inter * a;
#pragma unroll
      for (int s = 0; s < 4; ++s) x += ssc[t * 4 + s] * sv[s * 256 + e];
      hv[k] = x * dnm * sigm(o2[k]);
    }
    float a1 = wave_sum(hv[0] + hv[1]), a2 = wave_sum(hv[0] * hv[0] + hv[1] * hv[1]);
    if (lane == 0) { sst[wid * 2] = a1; sst[wid * 2 + 1] = a2; }
    __syncthreads();
    const float mean = (sst[(2 * t) * 2] + sst[(2 * t + 1) * 2]) * (1.f / 256.f);
    const float var = (sst[(2 * t) * 2 + 1] + sst[(2 * t + 1) * 2 + 1]) * (1.f / 256.f) - mean * mean;
    const float rstd = rsqrtf(fmaxf(var, 0.f) + EPS);
    const unsigned zv = *(const unsigned*)(P + (R0 + t) * NPJ + C_ZA + h * 256 + e2);
    const float* ng = p.in[I_NORMG] + (size_t)l * D + h * 256 + e2;
    float y0 = (hv[0] - mean) * rstd * ng[0] * silu(bflo(zv));
    float y1 = (hv[1] - mean) * rstd * ng[1] * silu(bfhi(zv));
    *(unsigned*)((bf16_t*)(p.ws + W_Y) + (R0 + t) * D + h * 256 + e2) = pk2(y0, y1);
  }
  if (tid < 256) {
    float nn = decay * sn0[tid];
#pragma unroll
    for (int s = 0; s < 4; ++s) nn += sk[s * 256 + tid];
    p.out[O_NS + sidx * 256 + tid] = nn;
  }
  if (tid == 0) p.out[O_MS + sidx] = mm[3];
  __syncthreads();
}

__device__ __forceinline__ void gmlp_prompt(const Params& p, int l, int b, int chunk, int g, char* smem) {
  const int tid = otid(), lane = tid & 63, wid = tid >> 6, fr = lane & 15, fq = lane >> 4, wr = wid >> 2, wc = wid & 3;
  bf16_t* sVn = (bf16_t*)smem;
  bf16_t* sW = (bf16_t*)(smem + 69632);
  float* sMu = (float*)(smem + 69632 + 34816);
  float* sRs = sMu + 128;
  const bf16_t* P = (const bf16_t*)(p.ws + W_P);
  const size_t R0 = (size_t)b * SEQ + chunk * 128;
  for (int rr = 0; rr < 16; ++rr) {
    const int s = wid * 16 + rr;
    const bf16_t* rp = P + (R0 + s) * NPJ + C_VB;
    float f[16];
    unpack8(*(const uint4*)(rp + lane * 8), f);
    unpack8(*(const uint4*)(rp + 512 + lane * 8), f + 8);
    float a = 0.f, q = 0.f;
#pragma unroll
    for (int e = 0; e < 16; ++e) { a += f[e]; q += f[e] * f[e]; }
    a = wave_sum(a); q = wave_sum(q);
    if (lane == 0) {
      const float mean = a * (1.f / D);
      sMu[s] = mean;
      sRs[s] = rsqrtf(fmaxf(q * (1.f / D) - mean * mean, 0.f) + EPS);
    }
  }
  __syncthreads();
  const float* lg = p.in[I_GLNG] + (size_t)l * D + g * 256;
  const float* lb = p.in[I_GLNB] + (size_t)l * D + g * 256;
#pragma unroll
  for (int i = 0; i < 8; ++i) {
    int c = tid + 512 * i, r = c >> 5, c8 = c & 31;
    float f[8];
    unpack8(*(const uint4*)(P + (R0 + r) * NPJ + C_VB + g * 256 + c8 * 8), f);
    const float mu = sMu[r], rs = sRs[r];
    const float4 g0 = *(const float4*)(lg + c8 * 8), g1 = *(const float4*)(lg + c8 * 8 + 4);
    const float4 b0 = *(const float4*)(lb + c8 * 8), b1 = *(const float4*)(lb + c8 * 8 + 4);
    f[0] = (f[0] - mu) * rs * g0.x + b0.x; f[1] = (f[1] - mu) * rs * g0.y + b0.y;
    f[2] = (f[2] - mu) * rs * g0.z + b0.z; f[3] = (f[3] - mu) * rs * g0.w + b0.w;
    f[4] = (f[4] - mu) * rs * g1.x + b1.x; f[5] = (f[5] - mu) * rs * g1.y + b1.y;
    f[6] = (f[6] - mu) * rs * g1.z + b1.z; f[7] = (f[7] - mu) * rs * g1.w + b1.w;
    *(uint4*)(sVn + r * 272 + c8 * 8) = pack8(f);
  }
  const bf16_t* wm = (const bf16_t*)(p.ws + W_WM) + (size_t)(l * 4 + g) * 16384;
#pragma unroll
  for (int i = 0; i < 4; ++i) {
    int c = tid + 512 * i, r = c >> 4, c8 = c & 15;
    *(uint4*)(sW + r * 136 + c8 * 8) = *(const uint4*)(wm + r * 128 + c8 * 8);
  }
  __syncthreads();
  f32x4 acc[4][4];
#pragma unroll
  for (int m = 0; m < 4; ++m)
#pragma unroll
    for (int n = 0; n < 4; ++n) acc[m][n] = f32x4{0.f, 0.f, 0.f, 0.f};
#pragma unroll
  for (int kk = 0; kk < 4; ++kk) {
    bf16x8 tf[4];
#pragma unroll
    for (int m = 0; m < 4; ++m) tf[m] = *(const bf16x8*)(sW + (wr * 64 + m * 16 + fr) * 136 + kk * 32 + fq * 8);
#pragma unroll
    for (int n = 0; n < 4; ++n) {
      bf16x8 cf = frag_t(sVn, 272, wc * 64 + n * 16, kk * 32, lane);
#pragma unroll
      for (int m = 0; m < 4; ++m) acc[m][n] = mfma16(cf, tf[m], acc[m][n]);
    }
  }
  bf16_t* Y1 = (bf16_t*)(p.ws + W_Y) + (size_t)MT * D;
  const float* bs = p.in[I_GBS] + (size_t)(l * 4 + g) * 128;
#pragma unroll
  for (int m = 0; m < 4; ++m) {
    const int t = wr * 64 + m * 16 + fr;
    const float bsv = bs[t];
    const size_t row = R0 + t;
#pragma unroll
    for (int n = 0; n < 4; ++n) {
      const int col = g * 256 + wc * 64 + n * 16 + fq * 4;
      const uint2 uv = *(const uint2*)(P + row * NPJ + C_UB + col);
      const uint2 zv = *(const uint2*)(P + row * NPJ + C_ZB + col);
      const float u[4] = {bflo(uv.x), bfhi(uv.x), bflo(uv.y), bfhi(uv.y)};
      const float z[4] = {bflo(zv.x), bfhi(zv.x), bflo(zv.y), bfhi(zv.y)};
      float y[4];
#pragma unroll
      for (int r = 0; r < 4; ++r) y[r] = u[r] * (acc[m][n][r] + bsv) * silu(z[r]);
      uint2 o; o.x = pk2(y[0], y[1]); o.y = pk2(y[2], y[3]);
      *(uint2*)(Y1 + row * D + col) = o;
    }
  }
  __syncthreads();
}

__device__ __forceinline__ void gmlp_sample(const Params& p, int l, int b, char* smem) {
  const int tid = otid(), lane = tid & 63, wid = tid >> 6;
  float* svn = (float*)smem;
  const bf16_t* P = (const bf16_t*)(p.ws + W_P);
  const size_t R0 = (size_t)NPR + b * 4;
  if (wid < 4) {
    const int t = wid;
    const bf16_t* rp = P + (R0 + t) * NPJ + C_VB;
    float f[16];
    unpack8(*(const uint4*)(rp + lane * 8), f);
    unpack8(*(const uint4*)(rp + 512 + lane * 8), f + 8);
    float a = 0.f;
#pragma unroll
    for (int e = 0; e < 16; ++e) a += f[e];
    const float mean = wave_sum(a) * (1.f / D);
    float q = 0.f;
#pragma unroll
    for (int e = 0; e < 16; ++e) { f[e] -= mean; q += f[e] * f[e]; }
    const float rs = rsqrtf(wave_sum(q) * (1.f / D) + EPS);
    const float* lg = p.in[I_GLNG] + (size_t)l * D;
    const float* lb = p.in[I_GLNB] + (size_t)l * D;
    float* ov = p.out + O_VS + (((size_t)l * 128 + b) * 4 + t) * D;
#pragma unroll
    for (int hh = 0; hh < 2; ++hh) {
      const int c0 = hh * 512 + lane * 8;
#pragma unroll
      for (int e = 0; e < 8; ++e) f[hh * 8 + e] = f[hh * 8 + e] * rs * lg[c0 + e] + lb[c0 + e];
      *(float4*)(svn + t * 1024 + c0) = float4{f[hh * 8], f[hh * 8 + 1], f[hh * 8 + 2], f[hh * 8 + 3]};
      *(float4*)(svn + t * 1024 + c0 + 4) = float4{f[hh * 8 + 4], f[hh * 8 + 5], f[hh * 8 + 6], f[hh * 8 + 7]};
      *(float4*)(ov + c0) = float4{f[hh * 8], f[hh * 8 + 1], f[hh * 8 + 2], f[hh * 8 + 3]};
      *(float4*)(ov + c0 + 4) = float4{f[hh * 8 + 4], f[hh * 8 + 5], f[hh * 8 + 6], f[hh * 8 + 7]};
    }
  }
  __syncthreads();
  bf16_t* Y1 = (bf16_t*)(p.ws + W_Y) + (size_t)MT * D;
#pragma unroll
  for (int i = 0; i < 8; ++i) {
    const int idx = tid + 512 * i, t = idx >> 10, c = idx & 1023, g = c >> 8;
    const float* wrow = p.in[I_GWS] + ((size_t)(l * 4 + g) * 128 + t) * 128;
    float mixed = p.in[I_GBS][(size_t)(l * 4 + g) * 128 + t];
#pragma unroll
    for (int s = 0; s < 4; ++s)
      if (s <= t) mixed += wrow[s] * svn[s * 1024 + c];
    const float u = bf2f(P[(R0 + t) * NPJ + C_UB + c]), z = bf2f(P[(R0 + t) * NPJ + C_ZB + c]);
    Y1[(R0 + t) * D + c] = f2bf(u * mixed * silu(z));
  }
  __syncthreads();
}

__device__ __forceinline__ void lru_gemm_pass(const Params& p, int l, int mat, int cp, const bf16_t* sX, bf16_t* sWt,
                                              f32x4 (&acc)[8][2]) {
  const int tid = otid(), lane = tid & 63, wid = tid >> 6, fr = lane & 15, fq = lane >> 4;
  const bf16_t* src = (const bf16_t*)(p.ws + W_WTL) + (size_t)((l * 2 + mat) * 8 + cp * 2) * 16384;
  __syncthreads();
#pragma unroll
  for (int i = 0; i < 8; ++i) {
    int c = tid + 512 * i, r = c >> 4, c8 = c & 15;
    *(uint4*)(sWt + r * 136 + c8 * 8) = *(const uint4*)(src + r * 128 + c8 * 8);
  }
  __syncthreads();
  const int kb = (wid >> 2) * 128;
#pragma unroll
  for (int m = 0; m < 8; ++m) { acc[m][0] = f32x4{0.f, 0.f, 0.f, 0.f}; acc[m][1] = f32x4{0.f, 0.f, 0.f, 0.f}; }
#pragma unroll
  for (int kk = 0; kk < 4; ++kk) {
    bf16x8 wf0 = *(const bf16x8*)(sWt + (wid * 32 + fr) * 136 + kk * 32 + fq * 8);
    bf16x8 wf1 = *(const bf16x8*)(sWt + (wid * 32 + 16 + fr) * 136 + kk * 32 + fq * 8);
#pragma unroll
    for (int m = 0; m < 8; ++m) {
      bf16x8 xf = *(const bf16x8*)(sX + (m * 16 + fr) * 264 + kb + kk * 32 + fq * 8);
      acc[m][0] = mfma16(xf, wf0, acc[m][0]);
      acc[m][1] = mfma16(xf, wf1, acc[m][1]);
    }
  }
}

__device__ __forceinline__ void lru_tile(const Params& p, int l, int tile, int cp, bool sample, char* smem) {
  const int tid = otid(), lane = tid & 63, wid = tid >> 6, fr = lane & 15, fq = lane >> 4;
  bf16_t* sX = (bf16_t*)smem;
  bf16_t* sWt = (bf16_t*)(smem + 67584);
  const bf16_t* P = (const bf16_t*)(p.ws + W_P);
  {
    const int cg8 = tid & 31, tg = tid >> 5, c = cp * 256 + cg8 * 8;
    float w0[8], w1[8], w2[8], w3[8], bb[8];
    const float* cw = p.in[I_CONVW] + (size_t)l * 4 * D + c;
#pragma unroll
    for (int e = 0; e < 8; ++e) { w0[e] = cw[e]; w1[e] = cw[D + e]; w2[e] = cw[2 * D + e]; w3[e] = cw[3 * D + e]; bb[e] = p.in[I_CONVB][(size_t)l * D + c + e]; }
    if (!sample) {
      const int b = tile >> 4, tt0 = (tile & 15) * 128 + tg * 8;
      const size_t rb = (size_t)b * SEQ;
      float x3[8], x2[8], x1[8], cur[8];
#pragma unroll
      for (int e = 0; e < 8; ++e) { x3[e] = 0.f; x2[e] = 0.f; x1[e] = 0.f; }
      if (tt0 > 0) {
        unpack8(*(const uint4*)(P + (rb + tt0 - 3) * NPJ + C_XC + c), x3);
        unpack8(*(const uint4*)(P + (rb + tt0 - 2) * NPJ + C_XC + c), x2);
        unpack8(*(const uint4*)(P + (rb + tt0 - 1) * NPJ + C_XC + c), x1);
      }
#pragma unroll
      for (int i = 0; i < 8; ++i) {
        unpack8(*(const uint4*)(P + (rb + tt0 + i) * NPJ + C_XC + c), cur);
        float xc[8];
#pragma unroll
        for (int e = 0; e < 8; ++e) xc[e] = bb[e] + w0[e] * x3[e] + w1[e] * x2[e] + w2[e] * x1[e] + w3[e] * cur[e];
        *(uint4*)(sX + (tg * 8 + i) * 264 + cg8 * 8) = pack8(xc);
        if ((tile & 15) == 15 && tg == 15 && i >= 5) {
          float* o = p.out + O_CONVP + (((size_t)l * 8 + b) * 3 + (i - 5)) * D + c;
          *(float4*)o = float4{cur[0], cur[1], cur[2], cur[3]};
          *(float4*)(o + 4) = float4{cur[4], cur[5], cur[6], cur[7]};
        }
#pragma unroll
        for (int e = 0; e < 8; ++e) { x3[e] = x2[e]; x2[e] = x1[e]; x1[e] = cur[e]; }
      }
    } else {
#pragma unroll
      for (int q = 0; q < 2; ++q) {
        const int bbi = tile * 32 + tg * 2 + q;
        const float* cb = p.in[I_SCONV] + ((size_t)l * 128 + bbi) * 3 * D + c;
        float x3[8], x2[8], x1[8], cur[8];
#pragma unroll
        for (int e = 0; e < 8; ++e) { x3[e] = cb[e]; x2[e] = cb[D + e]; x1[e] = cb[2 * D + e]; }
#pragma unroll
        for (int i = 0; i < 4; ++i) {
          unpack8(*(const uint4*)(P + ((size_t)NPR + bbi * 4 + i) * NPJ + C_XC + c), cur);
          float xc[8];
#pragma unroll
          for (int e = 0; e < 8; ++e) xc[e] = bb[e] + w0[e] * x3[e] + w1[e] * x2[e] + w2[e] * x1[e] + w3[e] * cur[e];
          *(uint4*)(sX + (tg * 8 + q * 4 + i) * 264 + cg8 * 8) = pack8(xc);
          if (i >= 1) {
            float* o = p.out + O_CONVS + (((size_t)l * 128 + bbi) * 3 + (i - 1)) * D + c;
            *(float4*)o = float4{cur[0], cur[1], cur[2], cur[3]};
            *(float4*)(o + 4) = float4{cur[4], cur[5], cur[6], cur[7]};
          }
#pragma unroll
          for (int e = 0; e < 8; ++e) { x3[e] = x2[e]; x2[e] = x1[e]; x1[e] = cur[e]; }
        }
      }
    }
  }
  f32x4 racc[8][2], iacc[8][2];
  lru_gemm_pass(p, l, 0, cp, sX, sWt, racc);
  lru_gemm_pass(p, l, 1, cp, sX, sWt, iacc);
  const bool first = (!sample) && ((tile & 15) == 0);
#pragma unroll
  for (int n = 0; n < 2; ++n) {
    const int jl = wid * 32 + n * 16 + fr, c = cp * 256 + jl;
    const float bav = p.in[I_BA][(size_t)l * D + c], bxv = p.in[I_BX][(size_t)l * D + c];
    const float ls8 = 8.f * logsig(p.in[I_LAM][(size_t)l * D + c]);
#pragma unroll
    for (int m = 0; m < 8; ++m) {
      int mo = m * 16 + fq * 4;
      asm volatile("" : "+v"(mo));
#pragma unroll
      for (int r = 0; r < 4; ++r) {
        const int t = mo + r;
        const float rg = sigm(racc[m][n][r] + bav), ig = sigm(iacc[m][n][r] + bxv);
        const float av = __expf(ls8 * rg);
        float mult = __builtin_amdgcn_sqrtf(fmaxf(1.f - av * av, 0.f));
        if (first && t == 0) mult = 1.f;
        racc[m][n][r] = av;
        iacc[m][n][r] = mult * ig * bf2f(sX[t * 264 + jl]);
      }
    }
  }
  if (sample) {
    bf16_t* Y2 = (bf16_t*)(p.ws + W_Y) + (size_t)2 * MT * D;
#pragma unroll
    for (int n = 0; n < 2; ++n) {
      const int c = cp * 256 + wid * 32 + n * 16 + fr;
#pragma unroll
      for (int m = 0; m < 8; ++m) {
        int bbi = tile * 32 + m * 4 + fq;
        asm volatile("" : "+v"(bbi));
        float hh = p.in[I_SH][((size_t)l * 128 + bbi) * D + c];
#pragma unroll
        for (int r = 0; r < 4; ++r) {
          hh = racc[m][n][r] * hh + iacc[m][n][r];
          const size_t row = (size_t)NPR + bbi * 4 + r;
          const float z = bf2f(P[row * NPJ + C_ZC + c]);
          Y2[row * D + c] = f2bf(hh * silu(z));
        }
        p.out[O_HS + ((size_t)l * 128 + bbi) * D + c] = hh;
      }
    }
  } else {
    bf16_t* LH = (bf16_t*)(p.ws + W_LH);
    bf16_t* LA = (bf16_t*)(p.ws + W_LA);
    const size_t rb = (size_t)(tile >> 4) * SEQ + (tile & 15) * 128;
#pragma unroll
    for (int n = 0; n < 2; ++n) {
      const int c = cp * 256 + wid * 32 + n * 16 + fr;
      float cA = 1.f, cH = 0.f;
#pragma unroll
      for (int m = 0; m < 8; ++m) {
        int mo = m * 16 + fq * 4;
        asm volatile("" : "+v"(mo));
        float la_[4], lh_[4];
        la_[0] = racc[m][n][0]; lh_[0] = iacc[m][n][0];
#pragma unroll
        for (int r = 1; r < 4; ++r) { la_[r] = la_[r - 1] * racc[m][n][r]; lh_[r] = racc[m][n][r] * lh_[r - 1] + iacc[m][n][r]; }
        float A = la_[3], H = lh_[3];
        float pA = SHU(A, 16), pH = SHU(H, 16);
        if (fq >= 1) { H = A * pH + H; A = A * pA; }
        pA = SHU(A, 32); pH = SHU(H, 32);
        if (fq >= 2) { H = A * pH + H; A = A * pA; }
        float eA = SHU(A, 16), eH = SHU(H, 16);
        if (fq == 0) { eA = 1.f; eH = 0.f; }
        const float tA = shf(A, 48 + fr), tH = shf(H, 48 + fr);
        const float PA = cA * eA, PH = eA * cH + eH;
#pragma unroll
        for (int r = 0; r < 4; ++r) {
          const size_t row = rb + mo + r;
          LA[row * D + c] = f2bf(PA * la_[r]);
          LH[row * D + c] = f2bf(la_[r] * PH + lh_[r]);
        }
        cH = tA * cH + tH;
        cA = cA * tA;
      }
      if (fq == 0) {
        float* LE = (float*)(p.ws + W_LE) + ((size_t)tile * D + c) * 2;
        LE[0] = cA; LE[1] = cH;
      }
    }
  }
  __syncthreads();
}

__device__ __forceinline__ void lru_fix(const Params& p, int l, int tile, int half) {
  const int tid = otid(), c = tid * 2;
  const int b = tile >> 4, seg = tile & 15;
  const float* LE = (const float*)(p.ws + W_LE);
  float H0 = 0.f, H1 = 0.f;
  for (int k = 0; k < seg; ++k) {
    const float4 e = *(const float4*)(LE + ((size_t)(b * 16 + k) * D + c) * 2);
    H0 = e.x * H0 + e.y;
    H1 = e.z * H1 + e.w;
  }
  const bf16_t* P = (const bf16_t*)(p.ws + W_P);
  const bf16_t* LH = (const bf16_t*)(p.ws + W_LH);
  const bf16_t* LA = (const bf16_t*)(p.ws + W_LA);
  bf16_t* Y2 = (bf16_t*)(p.ws + W_Y) + (size_t)2 * MT * D;
  const size_t R0 = (size_t)b * SEQ + seg * 128 + half * 64;
#pragma unroll 8
  for (int rr = 0; rr < 64; ++rr) {
    const size_t row = R0 + rr;
    const unsigned hl = *(const unsigned*)(LH + row * D + c);
    const unsigned al = *(const unsigned*)(LA + row * D + c);
    const unsigned zv = *(const unsigned*)(P + row * NPJ + C_ZC + c);
    const float h0 = bflo(hl) + bflo(al) * H0, h1 = bfhi(hl) + bfhi(al) * H1;
    *(unsigned*)(Y2 + row * D + c) = pk2(h0 * silu(bflo(zv)), h1 * silu(bfhi(zv)));
  }
  if (seg == 15 && half == 1) {
    const float4 e = *(const float4*)(LE + ((size_t)(b * 16 + 15) * D + c) * 2);
    float2 o = {e.x * H0 + e.y, e.z * H1 + e.w};
    *(float2*)(p.out + O_HP + ((size_t)l * 8 + b) * D + c) = o;
  }
}

__device__ __forceinline__ void x4_unit(const Params& p, int l, int pm, int pn, char* smem) {
  float* MF = (float*)(p.ws + W_MF);
  bf16_t* MB = (bf16_t*)(p.ws + W_MB);
  const bf16_t* const P = (const bf16_t*)(p.ws + W_P);
#pragma unroll 1
  for (int br = 0; br < 3; ++br) {
    const bf16_t* A = (const bf16_t*)(p.ws + W_Y) + (size_t)br * MT * D;
    const bf16_t* Bt = (const bf16_t*)(p.ws + W_WTP) + (size_t)(l * 4 + br) * D * D;
    f32x4 acc[2][2][4][2];
    gemm_tile(A, Bt, pm * 256, pn * 256, smem, acc);
    EPI_IDX
    EPI_LOOP {
      const int row = pm * 256 + ai * 128 + wr * 64 + m * 16 + fr, col = pn * 256 + bj * 128 + wc * 32 + n * 16 + fq * 4;
      const uint2 gv = *(const uint2*)(P + (size_t)row * NPJ + C_GA + br * 1024 + col);
      float4 v = {acc[ai][bj][m][n][0] * sigm(bflo(gv.x)), acc[ai][bj][m][n][1] * sigm(bfhi(gv.x)),
                  acc[ai][bj][m][n][2] * sigm(bflo(gv.y)), acc[ai][bj][m][n][3] * sigm(bfhi(gv.y))};
      uint2* mf = (uint2*)((bf16_t*)MF + (size_t)row * D + col);
      if (br == 0) {
        uint2 ob; ob.x = pk2(v.x, v.y); ob.y = pk2(v.z, v.w); *mf = ob;
      } else {
        const uint2 o = *mf;
        v.x += bflo(o.x); v.y += bfhi(o.x); v.z += bflo(o.y); v.w += bfhi(o.y);
        uint2 ob; ob.x = pk2(v.x, v.y); ob.y = pk2(v.z, v.w);
        if (br == 1) *mf = ob;
        else *(uint2*)(MB + (size_t)row * D + col) = ob;
      }
    }
  }
}
__device__ __forceinline__ void x5_unit(const Params& p, int l, int pm, int pn, char* smem) {
  const bf16_t* A = (const bf16_t*)(p.ws + W_MB);
  const bf16_t* Bt = (const bf16_t*)(p.ws + W_WTP) + (size_t)(l * 4 + 3) * D * D;
  float* PRE = (float*)(p.ws + W_PRE);
  const float* XF = (const float*)(p.ws + W_XF);
  f32x4 acc[2][2][4][2];
  gemm_tile(A, Bt, pm * 256, pn * 256, smem, acc);
  EPI_IDX
  EPI_LOOP {
    const int row = pm * 256 + ai * 128 + wr * 64 + m * 16 + fr, col = pn * 256 + bj * 128 + wc * 32 + n * 16 + fq * 4;
    const float* xr = (l == 0) ? (row < NPR ? p.in[I_XP] + (size_t)row * D : p.in[I_XS] + (size_t)(row - NPR) * D)
                               : XF + (size_t)row * D;
    const float4 xv = *(const float4*)(xr + col);
    float4 v = {ALPHA * xv.x + acc[ai][bj][m][n][0], ALPHA * xv.y + acc[ai][bj][m][n][1],
                ALPHA * xv.z + acc[ai][bj][m][n][2], ALPHA * xv.w + acc[ai][bj][m][n][3]};
    *(float4*)(PRE + (size_t)row * D + col) = v;
  }
}
__device__ __forceinline__ void dep_signal(unsigned* ctr) {
  asm volatile("s_waitcnt vmcnt(0)" ::: "memory");
  __syncthreads();
  if (threadIdx.x == 0) {
    __builtin_amdgcn_fence(__ATOMIC_RELEASE, "agent");
    asm volatile("s_waitcnt vmcnt(0)" ::: "memory");
    (void)__hip_atomic_fetch_add(ctr, 1u, __ATOMIC_RELAXED, __HIP_MEMORY_SCOPE_AGENT);
  }
}
__device__ __forceinline__ void dep_wait(unsigned* ctr, unsigned target) {
  if (threadIdx.x == 0) {
    unsigned sp = 0;
    while (__hip_atomic_load(ctr, __ATOMIC_RELAXED, __HIP_MEMORY_SCOPE_AGENT) < target) {
      __builtin_amdgcn_s_sleep(2);
      if (++sp > (1u << 24)) break;
    }
    __builtin_amdgcn_fence(__ATOMIC_ACQUIRE, "agent");
    asm volatile("s_waitcnt vmcnt(0)" ::: "memory");
  }
  __syncthreads();
}

#define XB_TMO 128
#define XB_XCNT(j) (256 + 64 * (j))
#define XB_XSUB(j) (1280 + 64 * (j))
#define XB_XGEN(j) (2304 + 64 * (j))
#define XB_TOP 3328
#define XB_TOPGEN 3392
#define XCD_BAR_WORDS 3456
#define XB_SPIN_CAP (1u << 22)
__device__ __forceinline__ unsigned xb_ld(unsigned* p) { return __hip_atomic_load(p, __ATOMIC_RELAXED, __HIP_MEMORY_SCOPE_AGENT); }
__device__ __forceinline__ unsigned xb_add(unsigned* p, unsigned v) { return __hip_atomic_fetch_add(p, v, __ATOMIC_RELAXED, __HIP_MEMORY_SCOPE_AGENT); }
__device__ __forceinline__ unsigned xb_xcc_id() { return (unsigned)__builtin_amdgcn_s_getreg((3 << 11) | 20) & 0xFu; }
#define XB_SPIN(cond, bar) do { unsigned _sp = 0; while (cond) { __builtin_amdgcn_s_sleep(1); \
    if ((++_sp & 255u) == 0u) { if (xb_ld(&(bar)[XB_TMO])) break; if (_sp > XB_SPIN_CAP) { atomicAdd(&(bar)[XB_TMO], 1u); break; } } } } while (0)
struct XcdBarrier { unsigned* bar; unsigned x; volatile LDSP(unsigned) st; };
__device__ __forceinline__ XcdBarrier xcd_barrier_post(unsigned* bar, volatile LDSP(unsigned) st) {
  XcdBarrier b; b.bar = bar; b.x = xb_xcc_id(); b.st = st;
  if (threadIdx.x == 0) (void)xb_add(&bar[XB_XCNT(b.x)], 1u);
  return b;
}
__device__ __forceinline__ void xcd_barrier_complete(unsigned* bar, unsigned x, unsigned& nloc, unsigned& nx) {
  const unsigned G = gridDim.x * gridDim.y * gridDim.z;
  unsigned sum, cnt, mine, sp = 0u;
  for (;;) {
    sum = 0u; cnt = 0u; mine = 0u;
#pragma unroll
    for (unsigned j = 0; j < 16; ++j) { const unsigned c = xb_ld(&bar[XB_XCNT(j)]); sum += c; cnt += (c > 0u) ? 1u : 0u; mine = (j == x) ? c : mine; }
    if (sum == G) break;
    __builtin_amdgcn_s_sleep(1);
    if ((++sp & 255u) == 0u) { if (xb_ld(&bar[XB_TMO])) break; if (sp > XB_SPIN_CAP) { atomicAdd(&bar[XB_TMO], 1u); break; } }
  }
  nloc = mine > 0u ? mine : 1u; nx = cnt > 0u ? cnt : 1u;
}
__device__ __forceinline__ void xcd_barrier(const XcdBarrier& b) {
  asm volatile("s_waitcnt vmcnt(0)" ::: "memory");
  __syncthreads();
  if (threadIdx.x == 0) {
    unsigned* bar = b.bar;
    __builtin_amdgcn_s_waitcnt(0);
    unsigned nloc = b.st[0], nx = b.st[1];
    if (nloc == 0u) { xcd_barrier_complete(bar, b.x, nloc, nx); b.st[0] = nloc; b.st[1] = nx; }
    const unsigned old = xb_add(&bar[XB_XSUB(b.x)], 1u);
    const unsigned gen = old / nloc;
    if (old + 1u == (gen + 1u) * nloc) {
      __builtin_amdgcn_fence(__ATOMIC_RELEASE, "agent");
      asm volatile("s_waitcnt vmcnt(0)" ::: "memory");
      const unsigned og = xb_add(&bar[XB_TOP], 1u);
      const unsigned tg = og / nx;
      if (og + 1u == (tg + 1u) * nx) xb_add(&bar[XB_TOPGEN], 1u);
      else XB_SPIN(xb_ld(&bar[XB_TOPGEN]) == tg, bar);
      __builtin_amdgcn_fence(__ATOMIC_ACQUIRE, "agent");
      xb_add(&bar[XB_XGEN(b.x)], 1u);
      asm volatile("s_waitcnt vmcnt(0)" ::: "memory");
    } else {
      XB_SPIN(xb_ld(&bar[XB_XGEN(b.x)]) == gen, bar);
      __builtin_amdgcn_fence(__ATOMIC_ACQUIRE, "agent");
      asm volatile("s_waitcnt vmcnt(0)" ::: "memory");
    }
  }
  __syncthreads();
}

__global__ void __launch_bounds__(512) mega(Params p) {
  extern __shared__ __attribute__((aligned(16))) char smem[];
  cg::grid_group grid = cg::this_grid();
  const int G = gridDim.x, bid = blockIdx.x;
  volatile LDSP(unsigned) xst = (volatile LDSP(unsigned))(smem + LDS_TOTAL - 16);
  if (threadIdx.x == 0) { xst[0] = 0u; xst[1] = 0u; xst[2] = 0u; xst[3] = 0u; }
  __syncthreads();
  XcdBarrier xb = xcd_barrier_post((unsigned*)(p.ws + W_BAR), xst);
  phase_convert(p, smem);
  row_pass(p, 0, smem);
  grid.sync();
#pragma unroll 1
  for (int l = 0; l < NL; ++l) {
    for (int it = bid; it < 32; it += G) mlstm_scalars(p, l, it, smem);
    REP(0) {
      const bf16_t* A = (const bf16_t*)(p.ws + W_XB);
      const bf16_t* Bt = (const bf16_t*)(p.ws + W_WTIN) + (size_t)l * NPJ * D;
      const float* bias = p.in[I_BIN] + (size_t)l * INW;
      bf16_t* const P = (bf16_t*)(p.ws + W_P);
      bool primed = false;
#pragma unroll 1
      for (int L = bid; L < 66 * 52; L += G) {
        int pm, pn; tile_map(L, 66, 52, pm, pn, 4);
        f32x4 acc[2][2][4][2];
        gemm_tile(A, Bt, pm * 256, pn * 256, smem, acc, primed);
        EPI_IDX
        float4 bvv[2][2];
#pragma unroll
        for (int bj = 0; bj < 2; ++bj)
#pragma unroll
          for (int n = 0; n < 2; ++n) {
            const int col = pn * 256 + bj * 128 + wc * 32 + n * 16 + fq * 4;
            bvv[bj][n] = *(const float4*)(bias + col + (col >= 5120 ? 8 : 0));
          }
        asm volatile("s_waitcnt vmcnt(0)" ::: "memory");
        primed = (L + G < 66 * 52);
        if (primed) { int pm2, pn2; tile_map(L + G, 66, 52, pm2, pn2, 4); gemm_tile(A, Bt, pm2 * 256, pn2 * 256, smem, acc, false, true); }
        EPI_LOOP {
          const int row = pm * 256 + ai * 128 + wr * 64 + m * 16 + fr, col = pn * 256 + bj * 128 + wc * 32 + n * 16 + fq * 4;
          const float4 bv = bvv[bj][n];
          uint2 o;
          o.x = pk2(acc[ai][bj][m][n][0] + bv.x, acc[ai][bj][m][n][1] + bv.y);
          o.y = pk2(acc[ai][bj][m][n][2] + bv.z, acc[ai][bj][m][n][3] + bv.w);
          *(uint2*)(P + (size_t)row * NPJ + col) = o;
        }
      }
    }
    GSYNC;
    {
      constexpr int Q_S = 656, Q_X4 = Q_S + 8, Q_F1 = Q_X4 + 256, Q_X5 = Q_F1 + 8, Q_FN = Q_X5 + 128, Q_F2 = Q_FN + 128, Q_LR = Q_F2 + 512,
                    Q_F3 = Q_LR + 128, Q_G2 = Q_F3 + 512;
      unsigned* qbase = (unsigned*)(p.ws + W_QCT) + l * 64;
      volatile LDSP(int) qslot = (volatile LDSP(int))(smem + LDS_TOTAL - 32);
      if (threadIdx.x == 0) qslot[0] = (int)xb_add(qbase, 1u);
      __syncthreads();
      int it = qslot[0];
#pragma unroll 1
      while (it < Q_G2) {
        __syncthreads();
        int nxt = 0;
        int r = it, fq_ = -1, fbh = 0;
        if (r >= Q_X4 && r < Q_F1) { fq_ = 15 - ((r - Q_X4) >> 5); fbh = (r - Q_X4) & 31; }
        else if (r >= Q_FN && r < Q_F2) { fq_ = 7 - ((r - Q_FN) >> 5); fbh = (r - Q_FN) & 31; }
        else if (r >= Q_LR && r < Q_F3) { fq_ = 3 - ((r - Q_LR) >> 5); fbh = (r - Q_LR) & 31; }
        if (fq_ < 0 && threadIdx.x == 0) nxt = (int)xb_add(qbase, 1u);
        if (fq_ >= 0) { mlstm_flash(p, l, fbh, fq_, smem); if (threadIdx.x == 0) nxt = (int)xb_add(qbase, 1u); }
        else if (r < Q_S) {
          if (r < 512) mlstm_sample(p, l, r >> 2, r & 3, smem);
          else if (r < 640) gmlp_sample(p, l, r - 512, smem);
          else lru_tile(p, l, (r - 640) >> 2, r & 3, true, smem);
          dep_signal(qbase + 16);
        }
        else if (r < Q_X4) { r -= Q_S; dep_wait(qbase + 16, 656u); x4_unit(p, l, 64 + (r >> 2), r & 3, smem); dep_signal(qbase + 32 + 16 * (r >> 2)); }
        else if (r < Q_X5) { r -= Q_F1; dep_wait(qbase + 32 + 16 * (r >> 2), 4u); x5_unit(p, l, 64 + (r >> 2), r & 3, smem); }
        else if (r < Q_FN) { r -= Q_X5; mlstm_final(p, l, r >> 2, r & 3, smem); }
        else if (r < Q_LR) { r -= Q_F2; lru_tile(p, l, r >> 2, r & 3, false, smem); }
        else { r -= Q_F3; gmlp_prompt(p, l, r >> 6, (r >> 2) & 15, r & 3, smem); }
        if (threadIdx.x == 0) qslot[0] = nxt;
        __syncthreads();
        it = qslot[0];
      }
    }
    GSYNC;
    for (int it = bid; it < 256; it += G) lru_fix(p, l, it >> 1, it & 1);
    GSYNC;
#pragma unroll 1
    for (int L = bid; L < 64 * 4; L += G) { int pm, pn; tile_map(L, 64, 4, pm, pn); x4_unit(p, l, pm, pn, smem); }
    GSYNC;
#pragma unroll 1
    for (int L = bid; L < 64 * 4; L += G) { int pm, pn; tile_map(L, 64, 4, pm, pn); x5_unit(p, l, pm, pn, smem); }
    GSYNC;
    row_pass(p, l + 1, smem);
    GSYNC;
  }
}

extern "C" void kernel_launch(void* const* d_in, const int* in_sizes, int n_in, void* d_out, int out_size, void* d_ws,
                              size_t ws_size, hipStream_t stream) {
  constexpr size_t kLds = LDS_TOTAL;
  static int grid_blocks = 0;
  if (!grid_blocks) {
    int dev = 0, cus = 0, per_cu = 0;
    (void)hipGetDevice(&dev);
    (void)hipDeviceGetAttribute(&cus, hipDeviceAttributeMultiprocessorCount, dev);
    (void)hipFuncSetAttribute((const void*)mega, hipFuncAttributeMaxDynamicSharedMemorySize, (int)kLds);
    (void)hipOccupancyMaxActiveBlocksPerMultiprocessor(&per_cu, (const void*)mega, 512, kLds);
    if (per_cu < 1) per_cu = 1;
    grid_blocks = cus * per_cu;
    if (grid_blocks % 8) grid_blocks -= grid_blocks % 8;
    if (ws_size < W_END || n_in != 27 || (size_t)out_size != O_END)
      fprintf(stderr, "kernel_launch: unexpected sizes ws %zu (need %zu) n_in %d out %d (expect %zu)\n", ws_size,
              (size_t)W_END, n_in, out_size, (size_t)O_END);
  }
  (void)hipMemsetAsync((char*)d_ws + W_BAR, 0, W_CTL_END - W_BAR, stream);
  Params p{};
  for (int i = 0; i < 27; ++i) p.in[i] = (const float*)d_in[i];
  p.out = (float*)d_out;
  p.ws = (char*)d_ws;
  void* args[] = {&p};
  hipError_t e = hipLaunchCooperativeKernel((const void*)mega, dim3(grid_blocks), dim3(512), args, kLds, stream);
  if (e != hipSuccess) fprintf(stderr, "cooperative launch failed: %s (grid %d)\n", hipGetErrorString(e), grid_blocks);
}
```

```cpp
#include <hip/hip_runtime.h>
#include <hip/hip_cooperative_groups.h>
#include <cstdio>
#include <cstdint>
namespace cg = cooperative_groups;

typedef unsigned short bf16_t;
typedef short bf16x8 __attribute__((ext_vector_type(8)));
typedef short s16x4 __attribute__((ext_vector_type(4)));
typedef float f32x4 __attribute__((ext_vector_type(4)));
#define LDSP(T) __attribute__((address_space(3))) T*

constexpr int D = 1024, NPR = 16384, NSM = 512, MT = 16896, NL = 4, SEQ = 2048;
constexpr int INW = 13320, NPJ = 13312;
constexpr int C_Q = 0, C_K = 1024, C_V = 2048, C_O = 3072, C_ZA = 4096, C_UB = 5120, C_VB = 6144, C_ZB = 7168,
              C_XC = 8192, C_ZC = 9216, C_GA = 10240;
constexpr float ALPHA = 1.6817928305074292f;
constexpr float EPS = 1e-5f;
constexpr int LDS_TOTAL = 150 * 1024;
#ifndef DUP_PHASE
#define DUP_PHASE -1
#endif
#define GSYNC xcd_barrier(xb)
#define REP(k) for (int rep_ = 0; rep_ < ((DUP_PHASE == (k)) ? 2 : 1); ++rep_)

constexpr size_t W_WTIN = 0;
constexpr size_t W_WTP = W_WTIN + (size_t)NL * NPJ * D * 2;
constexpr size_t W_WTL = W_WTP + (size_t)NL * 4 * D * D * 2;
constexpr size_t W_WM = W_WTL + (size_t)NL * 2 * 8 * 128 * 128 * 2;
constexpr size_t W_XB = W_WM + (size_t)NL * 4 * 128 * 128 * 2;
constexpr size_t W_XF = W_XB + (size_t)MT * D * 2;
constexpr size_t W_GATE = W_XF + (size_t)MT * D * 4;
constexpr size_t W_P = W_GATE + (size_t)MT * 8 * 4;
constexpr size_t W_PRE = W_P + (size_t)MT * NPJ * 2;
constexpr size_t W_MF = W_PRE + (size_t)MT * D * 4;
constexpr size_t W_MB = W_MF + (size_t)MT * D * 4;
constexpr size_t W_Y = W_MB + (size_t)MT * D * 2;
constexpr size_t W_G = W_Y + (size_t)3 * MT * D * 2;
constexpr size_t W_MX = W_G + (size_t)32 * 2048 * 4;
constexpr size_t W_EM = W_MX + (size_t)32 * 2048 * 4;
constexpr size_t W_LH = W_EM + (size_t)32 * 2048 * 4;
constexpr size_t W_LA = W_LH + (size_t)NPR * D * 2;
constexpr size_t W_LE = W_LA + (size_t)NPR * D * 2;
constexpr size_t W_BAR = W_LE + (size_t)8 * 16 * 1024 * 2 * 4;
constexpr size_t W_QCT = W_BAR + 3456 * 4;
constexpr size_t W_CTL_END = W_QCT + 4 * 256;
constexpr size_t W_END = W_CTL_END;

constexpr size_t O_Y = 0;
constexpr size_t O_CP = (size_t)MT * D;
constexpr size_t O_NP = O_CP + (size_t)NL * 8 * 4 * 256 * 256;
constexpr size_t O_MP = O_NP + (size_t)NL * 8 * 4 * 256;
constexpr size_t O_CONVP = O_MP + (size_t)NL * 8 * 4;
constexpr size_t O_HP = O_CONVP + (size_t)NL * 8 * 3 * 1024;
constexpr size_t O_CS = O_HP + (size_t)NL * 8 * 1024;
constexpr size_t O_NS = O_CS + (size_t)NL * 128 * 4 * 256 * 256;
constexpr size_t O_MS = O_NS + (size_t)NL * 128 * 4 * 256;
constexpr size_t O_CONVS = O_MS + (size_t)NL * 128 * 4;
constexpr size_t O_HS = O_CONVS + (size_t)NL * 128 * 3 * 1024;
constexpr size_t O_VS = O_HS + (size_t)NL * 128 * 1024;
constexpr size_t O_END = O_VS + (size_t)NL * 128 * 4 * 1024;

enum { I_XP = 0, I_XS, I_SC, I_SN, I_SM, I_SCONV, I_SH, I_WIN, I_BIN, I_NORMG, I_GLNG, I_GLNB, I_GWS, I_GBS, I_CONVW,
       I_CONVB, I_WA, I_BA, I_WX, I_BX, I_LAM, I_WPA, I_WPB, I_WPC, I_WOUT, I_LNG, I_LNB };

struct Params {
  const float* in[27];
  float* out;
  char* ws;
};

__device__ __forceinline__ bf16_t f2bf(float f) {
  unsigned u = __float_as_uint(f);
  u += 0x7fffu + ((u >> 16) & 1u);
  return (bf16_t)(u >> 16);
}
__device__ __forceinline__ float bf2f(bf16_t h) { return __uint_as_float(((unsigned)h) << 16); }
__device__ __forceinline__ unsigned pk2(float a, float b) {
  unsigned r;
  asm("v_cvt_pk_bf16_f32 %0, %1, %2" : "=v"(r) : "v"(a), "v"(b));
  return r;
}
__device__ __forceinline__ float bflo(unsigned u) { return __uint_as_float(u << 16); }
__device__ __forceinline__ float bfhi(unsigned u) { return __uint_as_float(u & 0xffff0000u); }
__device__ __forceinline__ float sigm(float x) { return __builtin_amdgcn_rcpf(1.f + __expf(-x)); }
__device__ __forceinline__ float silu(float x) { return x * sigm(x); }
__device__ __forceinline__ float logsig(float x) { return fminf(x, 0.f) - log1pf(__expf(-fabsf(x))); }
__device__ __forceinline__ float shf(float v, int src) {
  return __int_as_float(__builtin_amdgcn_ds_bpermute(src << 2, __float_as_int(v)));
}
#define SHX(v, o) shf((v), lane ^ (o))
#define SHU(v, o) shf((v), (lane >= (o)) ? lane - (o) : lane)
__device__ __forceinline__ float wave_sum_l(float v, int lane) {
#pragma unroll
  for (int o = 1; o < 64; o <<= 1) v += shf(v, lane ^ o);
  return v;
}
#define wave_sum(v) wave_sum_l((v), lane)
__device__ __forceinline__ f32x4 mfma16(bf16x8 a, bf16x8 b, f32x4 c) {
  return __builtin_amdgcn_mfma_f32_16x16x32_bf16(a, b, c, 0, 0, 0);
}
__device__ __forceinline__ bf16x8 frag_t(const bf16_t* T, int stride, int r0, int k0, int lane) {
  const int fr = lane & 15, fq = lane >> 4;
  const bf16_t* q = T + (k0 + fq * 8 + (fr >> 2)) * stride + r0 + (fr & 3) * 4;
  s16x4 a = __builtin_amdgcn_ds_read_tr16_b64_v4i16((LDSP(s16x4))q);
  s16x4 b = __builtin_amdgcn_ds_read_tr16_b64_v4i16((LDSP(s16x4))(q + 4 * stride));
  bf16x8 r = {a[0], a[1], a[2], a[3], b[0], b[1], b[2], b[3]};
  return r;
}
__device__ __forceinline__ void unpack8(uint4 v, float* f) {
  f[0] = bflo(v.x); f[1] = bfhi(v.x); f[2] = bflo(v.y); f[3] = bfhi(v.y);
  f[4] = bflo(v.z); f[5] = bfhi(v.z); f[6] = bflo(v.w); f[7] = bfhi(v.w);
}
__device__ __forceinline__ uint4 pack8(const float* f) {
  uint4 o; o.x = pk2(f[0], f[1]); o.y = pk2(f[2], f[3]); o.z = pk2(f[4], f[5]); o.w = pk2(f[6], f[7]);
  return o;
}

__device__ __forceinline__ int otid() { int t = threadIdx.x; asm volatile("" : "+v"(t)); return t; }

__device__ __forceinline__ void tconv_item(const float* src, int lds_, bf16_t* dst, int ldd, int k0, int n0s, int n0d,
                                           float* scr, int lane) {
#pragma unroll 8
  for (int i = 0; i < 32; ++i) {
    const int kk = 2 * i + (lane >> 5);
    scr[kk * 33 + (lane & 31)] = src[(size_t)(k0 + kk) * lds_ + n0s + (lane & 31)];
  }
  const int c = lane & 7;
#pragma unroll
  for (int j = 0; j < 4; ++j) {
    const int n = (lane >> 3) + 8 * j;
    const float* t = scr + (8 * c) * 33 + n;
    uint4 o;
    o.x = pk2(t[0 * 33], t[1 * 33]); o.y = pk2(t[2 * 33], t[3 * 33]);
    o.z = pk2(t[4 * 33], t[5 * 33]); o.w = pk2(t[6 * 33], t[7 * 33]);
    *(uint4*)(dst + (size_t)(n0d + n) * ldd + k0 + 8 * c) = o;
  }
}

__device__ __forceinline__ void phase_convert(const Params& p, char* smem) {
  const int tid = otid(), lane = tid & 63, wid = tid >> 6;
  float* scr = (float*)smem + wid * (64 * 33);
  constexpr int N_IN = NL * 16 * 416, N_PJ = NL * 4 * 16 * 32, N_LR = NL * 2 * 8 * 8;
  for (int it = blockIdx.x * 8 + wid; it < N_IN + N_PJ + N_LR; it += gridDim.x * 8) {
    int r = it;
    if (r < N_IN) {
      int l = r / (16 * 416), q = r % (16 * 416), kt = q / 416, nt = q % 416;
      int n0d = nt * 32, n0s = n0d + (n0d >= 5120 ? 8 : 0);
      tconv_item(p.in[I_WIN] + (size_t)l * D * INW, INW, (bf16_t*)(p.ws + W_WTIN) + (size_t)l * NPJ * D, D, kt * 64, n0s,
                 n0d, scr, lane);
      continue;
    }
    r -= N_IN;
    if (r < N_PJ) {
      int lm = r >> 9, q = r & 511, kt = q >> 5, nt = q & 31, l = lm >> 2, mat = lm & 3;
      const float* src = p.in[I_WPA + mat] + (size_t)l * D * D;
      tconv_item(src, D, (bf16_t*)(p.ws + W_WTP) + (size_t)lm * D * D, D, kt * 64, nt * 32, nt * 32, scr, lane);
      continue;
    }
    r -= N_PJ;
    {
      int q = r & 7, lmn = r >> 3, n = lmn & 7, mat = (lmn >> 3) & 1, l = lmn >> 4;
      const float* src = p.in[mat ? I_WX : I_WA] + (size_t)(l * 8 + n) * 16384;
      tconv_item(src, 128, (bf16_t*)(p.ws + W_WTL) + (size_t)((l * 2 + mat) * 8 + n) * 16384, 128, (q >> 2) * 64,
                 (q & 3) * 32, (q & 3) * 32, scr, lane);
    }
  }
  __syncthreads();
  bf16_t* wm = (bf16_t*)(p.ws + W_WM);
  const float* gws = p.in[I_GWS];
  for (int idx = blockIdx.x * 512 + otid(); idx < NL * 4 * 128 * 128; idx += gridDim.x * 512) {
    int t = (idx >> 7) & 127, s = idx & 127;
    wm[idx] = f2bf(s <= t ? gws[idx] : 0.f);
  }
}

__device__ __forceinline__ void row_pass(const Params& p, int l, char* smem) {
  const int tid = otid(), lane = tid & 63, wid = tid >> 6;
  float* sWg = (float*)smem;
  if (l < NL) {
    const float* w = p.in[I_WIN] + (size_t)l * D * INW;
    for (int idx = tid; idx < 8192; idx += 512) {
      int j = idx >> 10, k = idx & 1023;
      sWg[idx] = w[(size_t)k * INW + 5120 + j];
    }
  }
  __syncthreads();
  bf16_t* XB = (bf16_t*)(p.ws + W_XB);
  float* XF = (float*)(p.ws + W_XF);
  const float* PRE = (const float*)(p.ws + W_PRE);
  float* GATE = (float*)(p.ws + W_GATE);
  for (int r = blockIdx.x * 8 + wid; r < MT; r += gridDim.x * 8) {
    float4 v[4];
    if (l == 0) {
      const float* src = r < NPR ? p.in[I_XP] + (size_t)r * D : p.in[I_XS] + (size_t)(r - NPR) * D;
#pragma unroll
      for (int i = 0; i < 4; ++i) v[i] = ((const float4*)src)[lane + 64 * i];
    } else {
      const float* src = PRE + (size_t)r * D;
      float s = 0.f;
#pragma unroll
      for (int i = 0; i < 4; ++i) { v[i] = ((const float4*)src)[lane + 64 * i]; s += (v[i].x + v[i].y) + (v[i].z + v[i].w); }
      const float mean = wave_sum(s) * (1.f / D);
      float s2 = 0.f;
#pragma unroll
      for (int i = 0; i < 4; ++i) {
        v[i].x -= mean; v[i].y -= mean; v[i].z -= mean; v[i].w -= mean;
        s2 += (v[i].x * v[i].x + v[i].y * v[i].y) + (v[i].z * v[i].z + v[i].w * v[i].w);
      }
      const float rstd = rsqrtf(wave_sum(s2) * (1.f / D) + EPS);
      const float4* g4 = (const float4*)(p.in[I_LNG] + (size_t)(l - 1) * D);
      const float4* b4 = (const float4*)(p.in[I_LNB] + (size_t)(l - 1) * D);
      float* dst = (l == NL) ? p.out + O_Y + (size_t)r * D : XF + (size_t)r * D;
#pragma unroll
      for (int i = 0; i < 4; ++i) {
        float4 g = g4[lane + 64 * i], b = b4[lane + 64 * i];
        v[i].x = v[i].x * rstd * g.x + b.x; v[i].y = v[i].y * rstd * g.y + b.y;
        v[i].z = v[i].z * rstd * g.z + b.z; v[i].w = v[i].w * rstd * g.w + b.w;
        ((float4*)dst)[lane + 64 * i] = v[i];
      }
    }
    if (l < NL) {
#pragma unroll
      for (int i = 0; i < 4; ++i) {
        uint2 o; o.x = pk2(v[i].x, v[i].y); o.y = pk2(v[i].z, v[i].w);
        ((uint2*)(XB + (size_t)r * D))[lane + 64 * i] = o;
      }
      float ga[8];
#pragma unroll
      for (int j = 0; j < 8; ++j) {
        float a = 0.f;
#pragma unroll
        for (int i = 0; i < 4; ++i) {
          float4 w = ((const float4*)(sWg + j * 1024))[lane + 64 * i];
          a += v[i].x * w.x + v[i].y * w.y + v[i].z * w.z + v[i].w * w.w;
        }
        ga[j] = wave_sum(a);
      }
      if (lane == 0) {
        const float* bi = p.in[I_BIN] + (size_t)l * INW + 5120;
        float4 o0 = {ga[0] + bi[0], ga[1] + bi[1], ga[2] + bi[2], ga[3] + bi[3]};
        float4 o1 = {ga[4] + bi[4], ga[5] + bi[5], ga[6] + bi[6], ga[7] + bi[7]};
        ((float4*)(GATE + (size_t)r * 8))[0] = o0;
        ((float4*)(GATE + (size_t)r * 8))[1] = o1;
      }
    }
  }
  __syncthreads();
}

constexpr int KD = 1024, BK = 64, HALF = 128, HTB = HALF * BK * 2;
__device__ __forceinline__ int lds_byte(int r, int c) {
  int st = (r >> 4) * 2 + (c >> 5), rr = r & 15, cc = c & 31, ob = rr * 64 + cc * 2;
  return st * 1024 + (ob ^ (((ob >> 9) & 1) << 5));
}
__device__ __forceinline__ void stage_rc(int b, int& R, int& C) {
  int st = b / 1024, sb = b % 1024, swz = sb ^ (((sb >> 9) & 1) << 5);
  R = (st >> 1) * 16 + swz / 64;
  C = (st & 1) * 32 + (swz % 64) / 2;
}
__device__ __forceinline__ void tile_map(int L, int nM, int nN, int& pm, int& pn, int WGM_ = 8) {
  int nwg = nM * nN, q = nwg / 8, r = nwg % 8, xcd = L % 8, off = L / 8;
  int wgid = (xcd < r ? xcd * (q + 1) : r * (q + 1) + (xcd - r) * q) + off;
  int nig = WGM_ * nN, gid = wgid / nig, fm = gid * WGM_, gsz = min(nM - fm, WGM_);
  pm = fm + ((wgid % nig) % gsz);
  pn = (wgid % nig) / gsz;
}

__device__ __forceinline__ void gemm_tile(const bf16_t* __restrict__ A, const bf16_t* __restrict__ Bt, int brow, int bcol,
                                          char* shm, f32x4 (&acc)[2][2][4][2], bool primed = false, bool prime_only = false) {
#define SAO(b, h) (((b) * 2 + (h)) * HTB)
#define SBO(b, h) ((4 + (b) * 2 + (h)) * HTB)
#define STAGE(BO, BASE, br, kt)                                                                              \
  do {                                                                                                       \
    const char* _gb = (const char*)(BASE) + ((size_t)(br) * KD + (size_t)(kt) * BK) * 2;                     \
    __builtin_amdgcn_global_load_lds((const unsigned*)(_gb + toff0), (unsigned*)(shm + (BO) + tb0), 16, 0, 0); \
    __builtin_amdgcn_global_load_lds((const unsigned*)(_gb + toff1), (unsigned*)(shm + (BO) + tb1), 16, 0, 0); \
  } while (0)
#define LDA(dst, b, h)                                                                                         \
  _Pragma("unroll") for (int m = 0; m < 4; ++m) _Pragma("unroll") for (int k = 0; k < 2; ++k) dst[m][k] =      \
      *reinterpret_cast<const bf16x8*>(shm + SAO(b, h) + lds_byte(wr * 64 + m * 16 + fr, k * 32 + fq * 8))
#define LDB(dst, b, h)                                                                                         \
  _Pragma("unroll") for (int n = 0; n < 2; ++n) _Pragma("unroll") for (int k = 0; k < 2; ++k) dst[n][k] =      \
      *reinterpret_cast<const bf16x8*>(shm + SBO(b, h) + lds_byte(wc * 32 + n * 16 + fr, k * 32 + fq * 8))
#define MMA(ai, bj, At_, Bt_)                                                                               \
  do {                                                                                                      \
    __builtin_amdgcn_s_setprio(1);                                                                          \
    _Pragma("unroll") for (int m = 0; m < 4; ++m) _Pragma("unroll") for (int n = 0; n < 2; ++n)             \
        _Pragma("unroll") for (int k = 0; k < 2; ++k) acc[ai][bj][m][n] =                                   \
            __builtin_amdgcn_mfma_f32_16x16x32_bf16(Bt_[n][k], At_[m][k], acc[ai][bj][m][n], 0, 0, 0);     \
    __builtin_amdgcn_s_setprio(0);                                                                          \
  } while (0)
#define WAIT_V(n) asm volatile("s_waitcnt vmcnt(" #n ")" ::: "memory")
#define WAIT_L(n) asm volatile("s_waitcnt lgkmcnt(" #n ")" ::: "memory")
#define BAR __builtin_amdgcn_s_barrier()
#define SCHED __builtin_amdgcn_sched_barrier(0)
  const int tidg = otid();
  const int wid = tidg >> 6, lane = tidg & 63, wr = wid >> 2, wc = wid & 3, fr = lane & 15, fq = lane >> 4;
  const int tb0 = tidg * 16, tb1 = tb0 + 8192;
  unsigned toff0, toff1;
  {
    int r_, c_;
    stage_rc(tb0, r_, c_); toff0 = (unsigned)(r_ * KD + c_) * 2u;
    stage_rc(tb1, r_, c_); toff1 = (unsigned)(r_ * KD + c_) * 2u;
  }
  if (prime_only) {
    STAGE(SBO(0, 0), Bt, bcol, 0); STAGE(SAO(0, 0), A, brow, 0);
    STAGE(SBO(0, 1), Bt, bcol + HALF, 0); STAGE(SAO(0, 1), A, brow + HALF, 0);
    STAGE(SBO(1, 0), Bt, bcol, 1); STAGE(SAO(1, 0), A, brow, 1); STAGE(SBO(1, 1), Bt, bcol + HALF, 1);
    return;
  }
#pragma unroll
  for (int a = 0; a < 2; ++a)
#pragma unroll
    for (int b = 0; b < 2; ++b)
#pragma unroll
      for (int m = 0; m < 4; ++m)
#pragma unroll
        for (int n = 0; n < 2; ++n) acc[a][b][m][n] = f32x4{0.f, 0.f, 0.f, 0.f};
  bf16x8 At[4][2], B0[2][2], B1[2][2];
  constexpr int nt = KD / BK;
  if (!primed) {
    __syncthreads();
    STAGE(SBO(0, 0), Bt, bcol, 0); STAGE(SAO(0, 0), A, brow, 0);
    STAGE(SBO(0, 1), Bt, bcol + HALF, 0); STAGE(SAO(0, 1), A, brow + HALF, 0);
    STAGE(SBO(1, 0), Bt, bcol, 1); STAGE(SAO(1, 0), A, brow, 1); STAGE(SBO(1, 1), Bt, bcol + HALF, 1);
  }
  if (wr == 1) BAR;
  WAIT_V(0); BAR;
  BAR;
#pragma unroll 1
  for (int t = 0; t < nt - 2; t += 2) {
    LDB(B0, 0, 0); SCHED; LDA(At, 0, 0); STAGE(SAO(1, 1), A, brow + HALF, t + 1);
    WAIT_L(8); BAR; WAIT_L(0); MMA(0, 0, At, B0); BAR; SCHED;
    LDB(B1, 0, 1); STAGE(SBO(0, 0), Bt, bcol, t + 2);
    BAR; WAIT_L(0); MMA(0, 1, At, B1); BAR;
    LDA(At, 0, 1); STAGE(SAO(0, 0), A, brow, t + 2);
    BAR; WAIT_L(0); MMA(1, 0, At, B0); BAR; SCHED;
    STAGE(SBO(0, 1), Bt, bcol + HALF, t + 2);
    WAIT_V(6); BAR; MMA(1, 1, At, B1); BAR;
    LDB(B0, 1, 0); SCHED; LDA(At, 1, 0); STAGE(SAO(0, 1), A, brow + HALF, t + 2);
    WAIT_L(8); BAR; WAIT_L(0); MMA(0, 0, At, B0); BAR; SCHED;
    LDB(B1, 1, 1); STAGE(SBO(1, 0), Bt, bcol, t + 3);
    BAR; WAIT_L(0); MMA(0, 1, At, B1); BAR;
    LDA(At, 1, 1); STAGE(SAO(1, 0), A, brow, t + 3);
    BAR; WAIT_L(0); MMA(1, 0, At, B0); BAR; SCHED;
    STAGE(SBO(1, 1), Bt, bcol + HALF, t + 3);
    WAIT_V(6); BAR; MMA(1, 1, At, B1); BAR;
  }
  {
    LDB(B0, 0, 0); LDA(At, 0, 0); STAGE(SAO(1, 1), A, brow + HALF, nt - 1);
    BAR; WAIT_L(0); MMA(0, 0, At, B0); BAR;
    LDB(B1, 0, 1); BAR; WAIT_L(0); MMA(0, 1, At, B1); BAR;
    LDA(At, 0, 1); WAIT_V(4); BAR; WAIT_L(0); MMA(1, 0, At, B0); MMA(1, 1, At, B1); BAR;
  }
  {
    LDB(B0, 1, 0); LDA(At, 1, 0); WAIT_V(2); BAR; WAIT_L(0); MMA(0, 0, At, B0); BAR;
    LDB(B1, 1, 1); WAIT_V(0); BAR; WAIT_L(0); MMA(0, 1, At, B1); BAR;
    LDA(At, 1, 1); BAR; WAIT_L(0); MMA(1, 0, At, B0); MMA(1, 1, At, B1); BAR;
  }
  if (wr == 0) BAR;
}
#define EPI_IDX const int tide = otid(), wid = tide >> 6, lane = tide & 63, wr = wid >> 2, wc = wid & 3, fr = lane & 15, fq = lane >> 4;
#define EPI_LOOP                                                                     \
  _Pragma("unroll") for (int ai = 0; ai < 2; ++ai) _Pragma("unroll") for (int bj = 0; bj < 2; ++bj) \
      _Pragma("unroll") for (int m = 0; m < 4; ++m) _Pragma("unroll") for (int n = 0; n < 2; ++n)

__device__ __forceinline__ void mlstm_scalars(const Params& p, int l, int bh, char* smem) {
  const int tid = otid(), lane = tid & 63, wid = tid >> 6;
  float* sred = (float*)smem;
  const float* GATE = (const float*)(p.ws + W_GATE);
  const int b = bh >> 2, h = bh & 3;
  float itv[4], c[4];
#pragma unroll
  for (int r = 0; r < 4; ++r) {
    size_t row = (size_t)b * SEQ + tid * 4 + r;
    itv[r] = GATE[row * 8 + h];
    c[r] = logsig(GATE[row * 8 + 4 + h]);
  }
  c[1] += c[0]; c[2] += c[1]; c[3] += c[2];
  float inc = c[3];
#pragma unroll
  for (int o = 1; o < 64; o <<= 1) { float t = SHU(inc, o); if (lane >= o) inc += t; }
  if (lane == 63) sred[wid] = inc;
  __syncthreads();
  float base = 0.f;
  for (int w = 0; w < wid; ++w) base += sred[w];
  __syncthreads();
  const float excl = base + inc - c[3];
  float g[4], mx[4];
#pragma unroll
  for (int r = 0; r < 4; ++r) { c[r] += excl; g[r] = itv[r] - c[r]; }
  mx[0] = g[0]; mx[1] = fmaxf(mx[0], g[1]); mx[2] = fmaxf(mx[1], g[2]); mx[3] = fmaxf(mx[2], g[3]);
  float minc = mx[3];
#pragma unroll
  for (int o = 1; o < 64; o <<= 1) { float t = SHU(minc, o); if (lane >= o) minc = fmaxf(minc, t); }
  if (lane == 63) sred[wid] = minc;
  __syncthreads();
  float mb = 0.f;
  for (int w = 0; w < wid; ++w) mb = fmaxf(mb, sred[w]);
  float prev = SHU(minc, 1);
  if (lane > 0) mb = fmaxf(mb, prev);
  __syncthreads();
  float* G = (float*)(p.ws + W_G) + (size_t)bh * SEQ;
  float* MX = (float*)(p.ws + W_MX) + (size_t)bh * SEQ;
  float* EM = (float*)(p.ws + W_EM) + (size_t)bh * SEQ;
  float4 og, om, oe;
  float mxv[4], mv[4];
#pragma unroll
  for (int r = 0; r < 4; ++r) { mxv[r] = fmaxf(mb, mx[r]); mv[r] = c[r] + mxv[r]; }
  og = float4{g[0], g[1], g[2], g[3]};
  om = float4{mxv[0], mxv[1], mxv[2], mxv[3]};
  oe = float4{__expf(-mv[0]), __expf(-mv[1]), __expf(-mv[2]), __expf(-mv[3])};
  ((float4*)G)[tid] = og; ((float4*)MX)[tid] = om; ((float4*)EM)[tid] = oe;
  if (tid == 511) p.out[O_MP + (size_t)l * 32 + bh] = mv[3];
}

__device__ __forceinline__ void mlstm_flash(const Params& p, int l, int bh, int qi, char* smem) {
  const int tid = otid(), lane = tid & 63, wid = tid >> 6, fr = lane & 15, fq = lane >> 4, wr = wid >> 1, wc = wid & 1;
  const int b = bh >> 2, h = bh & 3;
  char* sKb = smem;
  char* sVb = smem + 65536;
  bf16_t* sP = (bf16_t*)(smem + 131072);
  float* sRed = (float*)(smem + 131072);
  const bf16_t* P = (const bf16_t*)(p.ws + W_P);
  const float* G = (const float*)(p.ws + W_G) + (size_t)bh * SEQ;
  const float* MX = (const float*)(p.ws + W_MX) + (size_t)bh * SEQ;
  const float* EM = (const float*)(p.ws + W_EM) + (size_t)bh * SEQ;
  const size_t rowbase = (size_t)b * SEQ;
  const int nblk = 2 * qi + 2;
#define FL_ISSUE(jb)                                                                                              \
  do {                                                                                                            \
    const int buf_ = (jb) & 1;                                                                                    \
    const bf16_t* rp0_ = P + (rowbase + (size_t)(jb) * 64) * NPJ + h * 256;                                       \
    _Pragma("unroll") for (int i_ = 0; i_ < 4; ++i_) {                                                            \
      const int r_ = (wid * 4 + i_) * 2 + (lane >> 5), cs_ = lane & 31;                                           \
      const int ck_ = cs_ ^ (r_ & 31), cv_ = cs_ ^ (((r_ & 3) << 1) | (r_ & 8));                                  \
      __builtin_amdgcn_global_load_lds((const unsigned*)(rp0_ + (size_t)r_ * NPJ + C_K + ck_ * 8),                \
                                       (unsigned*)(sKb + buf_ * 32768 + (wid * 4 + i_) * 1024 + lane * 16), 16, 0, 0); \
      __builtin_amdgcn_global_load_lds((const unsigned*)(rp0_ + (size_t)r_ * NPJ + C_V + cv_ * 8),                \
                                       (unsigned*)(sVb + buf_ * 32768 + (wid * 4 + i_) * 1024 + lane * 16), 16, 0, 0); \
    }                                                                                                             \
  } while (0)
  FL_ISSUE(0);
  bf16x8 qf[2][8];
  float mxr[2];
#pragma unroll
  for (int m = 0; m < 2; ++m) {
    const int t = qi * 128 + wr * 32 + m * 16 + fr;
    const bf16_t* qp = P + (rowbase + t) * NPJ + C_Q + h * 256 + fq * 8;
#pragma unroll
    for (int kk = 0; kk < 8; ++kk) qf[m][kk] = *(const bf16x8*)(qp + kk * 32);
    mxr[m] = MX[t];
  }
  f32x4 oacc[2][8];
#pragma unroll
  for (int m = 0; m < 2; ++m)
#pragma unroll
    for (int n = 0; n < 8; ++n) oacc[m][n] = f32x4{0.f, 0.f, 0.f, 0.f};
  float den[2] = {0.f, 0.f};
#pragma unroll 1
  for (int j = 0; j < nblk; ++j) {
    asm volatile("s_waitcnt vmcnt(0)" ::: "memory");
    __syncthreads();
    if (j + 1 < nblk) FL_ISSUE(j + 1);
    const char* sK = sKb + (j & 1) * 32768;
    const char* sV = sVb + (j & 1) * 32768;
    f32x4 sacc[2][2];
#pragma unroll
    for (int m = 0; m < 2; ++m)
#pragma unroll
      for (int n = 0; n < 2; ++n) sacc[m][n] = f32x4{0.f, 0.f, 0.f, 0.f};
#pragma unroll
    for (int kk = 0; kk < 8; ++kk)
#pragma unroll
      for (int n = 0; n < 2; ++n) {
        const int row = wc * 32 + n * 16 + fr, c = kk * 4 + fq;
        bf16x8 kf = *(const bf16x8*)(sK + row * 512 + ((c ^ (row & 31)) << 4));
        sacc[0][n] = mfma16(kf, qf[0][kk], sacc[0][n]);
        sacc[1][n] = mfma16(kf, qf[1][kk], sacc[1][n]);
      }
#pragma unroll
    for (int n = 0; n < 2; ++n) {
      const int s0 = j * 64 + wc * 32 + n * 16 + fq * 4;
      const float4 g4 = *(const float4*)(G + s0);
      const float gs[4] = {g4.x, g4.y, g4.z, g4.w};
#pragma unroll
      for (int m = 0; m < 2; ++m) {
        const int t = qi * 128 + wr * 32 + m * 16 + fr;
        float v[4];
#pragma unroll
        for (int r = 0; r < 4; ++r) {
          float w = (s0 + r <= t) ? __expf(gs[r] - mxr[m]) : 0.f;
          v[r] = sacc[m][n][r] * 0.0625f * w;
          den[m] += v[r];
        }
        uint2 pk; pk.x = pk2(v[0], v[1]); pk.y = pk2(v[2], v[3]);
        *(uint2*)(sP + (wr * 32 + m * 16 + fr) * 72 + wc * 32 + n * 16 + fq * 4) = pk;
      }
    }
    __syncthreads();
#pragma unroll
    for (int kk = 0; kk < 2; ++kk) {
      bf16x8 pf0 = *(const bf16x8*)(sP + (wr * 32 + fr) * 72 + kk * 32 + fq * 8);
      bf16x8 pf1 = *(const bf16x8*)(sP + (wr * 32 + 16 + fr) * 72 + kk * 32 + fq * 8);
      const int srow = kk * 32 + fq * 8 + (fr >> 2);
      const int swz = ((srow & 3) << 1) | (srow & 8);
#pragma unroll
      for (int n2 = 0; n2 < 8; ++n2) {
        const int ch = ((wc * 128 + n2 * 16) >> 3) + ((fr & 3) >> 1);
        const char* va = sV + srow * 512 + ((ch ^ swz) << 4) + (fr & 1) * 8;
        s16x4 a = __builtin_amdgcn_ds_read_tr16_b64_v4i16((LDSP(s16x4))va);
        s16x4 bq = __builtin_amdgcn_ds_read_tr16_b64_v4i16((LDSP(s16x4))(va + 4 * 512));
        bf16x8 vf = {a[0], a[1], a[2], a[3], bq[0], bq[1], bq[2], bq[3]};
        oacc[0][n2] = mfma16(vf, pf0, oacc[0][n2]);
        oacc[1][n2] = mfma16(vf, pf1, oacc[1][n2]);
      }
    }
  }
  __syncthreads();
#undef FL_ISSUE
  float dn[2];
#pragma unroll
  for (int m = 0; m < 2; ++m) {
    float v = den[m];
    v += SHX(v, 16); v += SHX(v, 32);
    if (fq == 0) sRed[wc * 128 + wr * 32 + m * 16 + fr] = v;
  }
  __syncthreads();
#pragma unroll
  for (int m = 0; m < 2; ++m) {
    const int tl = wr * 32 + m * 16 + fr;
    float d = sRed[tl] + sRed[128 + tl];
    dn[m] = 1.f / fmaxf(fabsf(d), EM[qi * 128 + tl]);
  }
  float s1[2] = {0.f, 0.f}, s2[2] = {0.f, 0.f};
#pragma unroll
  for (int m = 0; m < 2; ++m) {
    const size_t row = rowbase + qi * 128 + wr * 32 + m * 16 + fr;
#pragma unroll
    for (int n2 = 0; n2 < 8; ++n2) {
      const int col = h * 256 + wc * 128 + n2 * 16 + fq * 4;
      const uint2 ov = *(const uint2*)(P + row * NPJ + C_O + col);
      const float o[4] = {bflo(ov.x), bfhi(ov.x), bflo(ov.y), bfhi(ov.y)};
#pragma unroll
      for (int r = 0; r < 4; ++r) {
        float hv = oacc[m][n2][r] * dn[m] * sigm(o[r]);
        oacc[m][n2][r] = hv;
        s1[m] += hv; s2[m] += hv * hv;
      }
    }
  }
#pragma unroll
  for (int m = 0; m < 2; ++m) {
    float a = s1[m], q = s2[m];
    a += SHX(a, 16); a += SHX(a, 32);
    q += SHX(q, 16); q += SHX(q, 32);
    if (fq == 0) { sRed[256 + wc * 128 + wr * 32 + m * 16 + fr] = a; sRed[512 + wc * 128 + wr * 32 + m * 16 + fr] = q; }
  }
  __syncthreads();
  bf16_t* Y0 = (bf16_t*)(p.ws + W_Y);
  const float* ng = p.in[I_NORMG] + (size_t)l * D;
#pragma unroll
  for (int m = 0; m < 2; ++m) {
    const int tl = wr * 32 + m * 16 + fr;
    const float mean = (sRed[256 + tl] + sRed[256 + 128 + tl]) * (1.f / 256.f);
    const float var = (sRed[512 + tl] + sRed[512 + 128 + tl]) * (1.f / 256.f) - mean * mean;
    const float rstd = rsqrtf(fmaxf(var, 0.f) + EPS);
    const size_t row = rowbase + qi * 128 + tl;
#pragma unroll
    for (int n2 = 0; n2 < 8; ++n2) {
      const int col = h * 256 + wc * 128 + n2 * 16 + fq * 4;
      const uint2 zv = *(const uint2*)(P + row * NPJ + C_ZA + col);
      const float4 g4 = *(const float4*)(ng + col);
      const float z[4] = {bflo(zv.x), bfhi(zv.x), bflo(zv.y), bfhi(zv.y)};
      const float gg[4] = {g4.x, g4.y, g4.z, g4.w};
      float y[4];
#pragma unroll
      for (int r = 0; r < 4; ++r) y[r] = (oacc[m][n2][r] - mean) * rstd * gg[r] * silu(z[r]);
      uint2 o; o.x = pk2(y[0], y[1]); o.y = pk2(y[2], y[3]);
      *(uint2*)(Y0 + row * D + col) = o;
    }
  }
  __syncthreads();
}

__device__ __forceinline__ void mlstm_final(const Params& p, int l, int bh, int dq, char* smem) {
  const int tid = otid(), lane = tid & 63, wid = tid >> 6, fr = lane & 15, fq = lane >> 4, wr = wid >> 2, wc = wid & 3;
  const int b = bh >> 2, h = bh & 3;
  char* sVb = smem;
  char* sKb = smem + 98304;
  float* sWall = (float*)(smem + 122880);
  float* sW = (float*)(smem + 131072);
  const bf16_t* P = (const bf16_t*)(p.ws + W_P);
  const float* G = (const float*)(p.ws + W_G) + (size_t)bh * SEQ;
  const float mxl = ((const float*)(p.ws + W_MX))[(size_t)bh * SEQ + SEQ - 1];
  const size_t rowbase = (size_t)b * SEQ;
  {
    const float4 g4 = ((const float4*)G)[tid];
    float4 w4 = {__expf(g4.x - mxl) * 0.0625f, __expf(g4.y - mxl) * 0.0625f, __expf(g4.z - mxl) * 0.0625f, __expf(g4.w - mxl) * 0.0625f};
    ((float4*)sWall)[tid] = w4;
  }
#define FN_ISSUE(jb)                                                                                                  \
  do {                                                                                                                \
    const int buf_ = (jb) % 3;                                                                                        \
    const bf16_t* rp0_ = P + (rowbase + (size_t)(jb) * 64) * NPJ + h * 256;                                           \
    _Pragma("unroll") for (int i_ = 0; i_ < 4; ++i_) {                                                                \
      const int r_ = (wid * 4 + i_) * 2 + (lane >> 5), cs_ = lane & 31;                                               \
      const int cv_ = cs_ ^ (((r_ & 3) << 1) | (r_ & 8));                                                             \
      __builtin_amdgcn_global_load_lds((const unsigned*)(rp0_ + (size_t)r_ * NPJ + C_V + cv_ * 8),                    \
                                       (unsigned*)(sVb + buf_ * 32768 + (wid * 4 + i_) * 1024 + lane * 16), 16, 0, 0); \
    }                                                                                                                 \
    {                                                                                                                 \
      const int r_ = wid * 8 + (lane >> 3), cs_ = lane & 7;                                                           \
      const int ck_ = cs_ ^ ((r_ & 3) << 1);                                                                          \
      __builtin_amdgcn_global_load_lds((const unsigned*)(rp0_ + (size_t)r_ * NPJ + C_K + dq * 64 + ck_ * 8),          \
                                       (unsigned*)(sKb + buf_ * 8192 + wid * 1024 + lane * 16), 16, 0, 0);            \
    }                                                                                                                 \
  } while (0)
  asm volatile("s_waitcnt vmcnt(0)" ::: "memory");
  FN_ISSUE(0);
  FN_ISSUE(1);
  f32x4 acc[2][4];
#pragma unroll
  for (int m = 0; m < 2; ++m)
#pragma unroll
    for (int n = 0; n < 4; ++n) acc[m][n] = f32x4{0.f, 0.f, 0.f, 0.f};
  float nacc = 0.f;
#pragma unroll 1
  for (int j = 0; j < 32; ++j) {
    if (j + 1 < 32) asm volatile("s_waitcnt vmcnt(5)" ::: "memory");
    else asm volatile("s_waitcnt vmcnt(0)" ::: "memory");
    __syncthreads();
    if (j + 2 < 32) FN_ISSUE(j + 2);
    const char* sV = sVb + (j % 3) * 32768;
    const char* sK = sKb + (j % 3) * 8192;
#pragma unroll
    for (int kk = 0; kk < 2; ++kk) {
      const int srow = kk * 32 + fq * 8 + (fr >> 2);
      const float4 wa = *(const float4*)(sWall + j * 64 + kk * 32 + fq * 8);
      const float4 wb = *(const float4*)(sWall + j * 64 + kk * 32 + fq * 8 + 4);
      bf16x8 kf[2];
#pragma unroll
      for (int m = 0; m < 2; ++m) {
        const int d0 = wr * 32 + m * 16 + (fr & 3) * 4;
        const char* ka = sK + srow * 128 + ((((d0 >> 3) ^ ((srow & 3) << 1)) & 7) << 4) + ((d0 >> 2) & 1) * 8;
        s16x4 a = __builtin_amdgcn_ds_read_tr16_b64_v4i16((LDSP(s16x4))ka);
        s16x4 bq = __builtin_amdgcn_ds_read_tr16_b64_v4i16((LDSP(s16x4))(ka + 4 * 128));
        const unsigned u0 = pk2(bf2f((bf16_t)a[0]) * wa.x, bf2f((bf16_t)a[1]) * wa.y);
        const unsigned u1 = pk2(bf2f((bf16_t)a[2]) * wa.z, bf2f((bf16_t)a[3]) * wa.w);
        const unsigned u2 = pk2(bf2f((bf16_t)bq[0]) * wb.x, bf2f((bf16_t)bq[1]) * wb.y);
        const unsigned u3 = pk2(bf2f((bf16_t)bq[2]) * wb.z, bf2f((bf16_t)bq[3]) * wb.w);
        kf[m] = bf16x8{(short)(u0 & 0xffff), (short)(u0 >> 16), (short)(u1 & 0xffff), (short)(u1 >> 16),
                       (short)(u2 & 0xffff), (short)(u2 >> 16), (short)(u3 & 0xffff), (short)(u3 >> 16)};
      }
      const int swz = ((srow & 3) << 1) | (srow & 8);
#pragma unroll
      for (int n = 0; n < 4; ++n) {
        const int ch = ((wc * 64 + n * 16) >> 3) + ((fr & 3) >> 1);
        const char* va = sV + srow * 512 + ((ch ^ swz) << 4) + (fr & 1) * 8;
        s16x4 a = __builtin_amdgcn_ds_read_tr16_b64_v4i16((LDSP(s16x4))va);
        s16x4 bq = __builtin_amdgcn_ds_read_tr16_b64_v4i16((LDSP(s16x4))(va + 4 * 512));
        bf16x8 vf = {a[0], a[1], a[2], a[3], bq[0], bq[1], bq[2], bq[3]};
        acc[0][n] = mfma16(vf, kf[0], acc[0][n]);
        acc[1][n] = mfma16(vf, kf[1], acc[1][n]);
      }
    }
    {
      float a = 0.f;
#pragma unroll
      for (int s8 = 0; s8 < 8; ++s8) {
        const int srow = wid * 8 + s8;
        const bf16_t kv = *(const bf16_t*)(sK + srow * 128 + ((((lane >> 3) ^ ((srow & 3) << 1)) & 7) << 4) + (lane & 7) * 2);
        a += bf2f(kv) * sWall[j * 64 + srow];
      }
      nacc += a;
    }
  }
  __syncthreads();
#undef FN_ISSUE
  float* oc = p.out + O_CP + ((size_t)l * 32 + bh) * 65536;
#pragma unroll
  for (int m = 0; m < 2; ++m)
#pragma unroll
    for (int n = 0; n < 4; ++n) {
      const int d = dq * 64 + wr * 32 + m * 16 + fr, e = wc * 64 + n * 16 + fq * 4;
      *(float4*)(oc + (size_t)d * 256 + e) = float4{acc[m][n][0], acc[m][n][1], acc[m][n][2], acc[m][n][3]};
    }
  sW[tid] = nacc;
  __syncthreads();
  if (tid < 64) {
    float a = 0.f;
#pragma unroll
    for (int w8 = 0; w8 < 8; ++w8) a += sW[w8 * 64 + tid];
    p.out[O_NP + ((size_t)l * 32 + bh) * 256 + dq * 64 + tid] = a;
  }
  __syncthreads();
}

__device__ __forceinline__ void mlstm_sample(const Params& p, int l, int b, int h, char* smem) {
  const int tid = otid(), lane = tid & 63, wid = tid >> 6;
  float* sq = (float*)smem;
  float* sk = sq + 1024;
  float* sv = sk + 1024;
  float* sn0 = sv + 1024;
  float* sqk = sn0 + 256;
  float* ssc = sqk + 32;
  float* sst = ssc + 32;
  float* snum = sst + 32;
  const bf16_t* P = (const bf16_t*)(p.ws + W_P);
  const float* GATE = (const float*)(p.ws + W_GATE);
  const size_t R0 = (size_t)NPR + b * 4;
  const size_t sidx = ((size_t)l * 128 + b) * 4 + h;
#pragma unroll
  for (int i = 0; i < 6; ++i) {
    int idx = tid + 512 * i, which = idx >> 10, t = (idx >> 8) & 3, d = idx & 255;
    sq[idx] = bf2f(P[(R0 + t) * NPJ + which * 1024 + h * 256 + d]);
  }
  if (tid < 256) sn0[tid] = p.in[I_SN][sidx * 256 + tid];
  const float m0 = p.in[I_SM][sidx];
  float g[4], cm[4], mm[4];
  {
    float bc = 0.f, run = m0;
#pragma unroll
    for (int t = 0; t < 4; ++t) {
      float itv = GATE[(R0 + t) * 8 + h];
      bc += logsig(GATE[(R0 + t) * 8 + 4 + h]);
      g[t] = itv - bc;
      run = fmaxf(run, g[t]);
      cm[t] = run;
      mm[t] = bc + run;
    }
  }
  __syncthreads();
  {
    const int pp = tid >> 5, li = tid & 31, t = pp >> 2, s = pp & 3;
    float part = 0.f;
#pragma unroll
    for (int d8 = 0; d8 < 8; ++d8) part += sq[t * 256 + li * 8 + d8] * sk[s * 256 + li * 8 + d8];
#pragma unroll
    for (int o = 16; o >= 1; o >>= 1) part += SHX(part, o);
    if (li == 0) sqk[pp] = part * 0.0625f;
    float part2 = 0.f;
    const int t2 = pp & 3;
#pragma unroll
    for (int d8 = 0; d8 < 8; ++d8) part2 += sq[t2 * 256 + li * 8 + d8] * sn0[li * 8 + d8];
#pragma unroll
    for (int o = 16; o >= 1; o >>= 1) part2 += SHX(part2, o);
    if (li == 0 && pp < 4) sqk[16 + pp] = part2;
  }
  __syncthreads();
  float w[4];
#pragma unroll
  for (int s = 0; s < 4; ++s) w[s] = __expf(g[s] - cm[3]) * 0.0625f;
  const float decay = __expf(m0 - cm[3]);
  if (tid == 0) {
#pragma unroll
    for (int t = 0; t < 4; ++t) {
      const float inter = __expf(m0 - cm[t]);
      float dsum = inter * sqk[16 + t];
#pragma unroll
      for (int s = 0; s < 4; ++s) {
        float st = (s <= t) ? sqk[t * 4 + s] * __expf(g[s] - cm[t]) : 0.f;
        ssc[t * 4 + s] = st;
        dsum += st;
      }
      ssc[16 + t] = inter;
      ssc[20 + t] = 1.f / fmaxf(fabsf(dsum), __expf(-mm[t]));
    }
  }
#pragma unroll
  for (int i = 0; i < 2; ++i) {
    int idx = tid + 512 * i;
    sk[idx] *= w[idx >> 8];
  }
  __syncthreads();
  {
    const int e4 = lane * 4, d0 = wid * 32;
    float4 vv[4], np[4];
#pragma unroll
    for (int s = 0; s < 4; ++s) { vv[s] = *(const float4*)(sv + s * 256 + e4); np[s] = float4{0.f, 0.f, 0.f, 0.f}; }
    const float* c0p = p.in[I_SC] + sidx * 65536;
    float* cop = p.out + O_CS + sidx * 65536;
#pragma unroll 1
    for (int dd = 0; dd < 32; dd += 8) {
      float4 c[8];
#pragma unroll
      for (int u = 0; u < 8; ++u) c[u] = *(const float4*)(c0p + (size_t)(d0 + dd + u) * 256 + e4);
#pragma unroll
      for (int u = 0; u < 8; ++u) {
        const int d = d0 + dd + u;
        float4 cn = {decay * c[u].x, decay * c[u].y, decay * c[u].z, decay * c[u].w};
#pragma unroll
        for (int t = 0; t < 4; ++t) {
          const float qv = sq[t * 256 + d], kv = sk[t * 256 + d];
          np[t].x += qv * c[u].x; np[t].y += qv * c[u].y; np[t].z += qv * c[u].z; np[t].w += qv * c[u].w;
          cn.x += kv * vv[t].x; cn.y += kv * vv[t].y; cn.z += kv * vv[t].z; cn.w += kv * vv[t].w;
        }
        *(float4*)(cop + (size_t)d * 256 + e4) = cn;
      }
    }
#pragma unroll
    for (int t = 0; t < 4; ++t) *(float4*)(snum + (wid * 4 + t) * 256 + e4) = np[t];
  }
  __syncthreads();
  {
    const int t = tid >> 7, e2 = (tid & 127) * 2;
    float hv[2];
    const unsigned ov = *(const unsigned*)(P + (R0 + t) * NPJ + C_O + h * 256 + e2);
    const float o2[2] = {bflo(ov), bfhi(ov)};
    const float inter = ssc[16 + t], dnm = ssc[20 + t];
#pragma unroll
    for (int k = 0; k < 2; ++k) {
      const int e = e2 + k;
      float a = 0.f;
#pragma unroll
      for (int w8 = 0; w8 < 8; ++w8) a += snum[(w8 * 4 + t) * 256 + e];
      float x = inter * a;
#pragma unroll
      for (int s = 0; s < 4; ++s) x += ssc[t * 4 + s] * sv[s * 256 + e];
      hv[k] = x * dnm * sigm(o2[k]);
    }
    float a1 = wave_sum(hv[0] + hv[1]), a2 = wave_sum(hv[0] * hv[0] + hv[1] * hv[1]);
    if (lane == 0) { sst[wid * 2] = a1; sst[wid * 2 + 1] = a2; }
    __syncthreads();
    const float mean = (sst[(2 * t) * 2] + sst[(2 * t + 1) * 2]) * (1.f / 256.f);
    const float var = (sst[(2 * t) * 2 + 1] + sst[(2 * t + 1) * 2 + 1]) * (1.f / 256.f) - mean * mean;
    const float rstd = rsqrtf(fmaxf(var, 0.f) + EPS);
    const unsigned zv = *(const unsigned*)(P + (R0 + t) * NPJ + C_ZA + h * 256 + e2);
    const float* ng = p.in[I_NORMG] + (size_t)l * D + h * 256 + e2;
    float y0 = (hv[0] - mean) * rstd * ng[0] * silu(bflo(zv));
    float y1 = (hv[1] - mean) * rstd * ng[1] * silu(bfhi(zv));
    __hip_atomic_store((unsigned*)((bf16_t*)(p.ws + W_Y) + (R0 + t) * D + h * 256 + e2), pk2(y0, y1), __ATOMIC_RELAXED,
                       __HIP_MEMORY_SCOPE_AGENT);
  }
  if (tid < 256) {
    float nn = decay * sn0[tid];
#pragma unroll
    for (int s = 0; s < 4; ++s) nn += sk[s * 256 + tid];
    p.out[O_NS + sidx * 256 + tid] = nn;
  }
  if (tid == 0) p.out[O_MS + sidx] = mm[3];
  __syncthreads();
}

__device__ __forceinline__ void gmlp_prompt(const Params& p, int l, int b, int chunk, int g, char* smem) {
  const int tid = otid(), lane = tid & 63, wid = tid >> 6, fr = lane & 15, fq = lane >> 4, wr = wid >> 2, wc = wid & 3;
  bf16_t* sVn = (bf16_t*)smem;
  bf16_t* sW = (bf16_t*)(smem + 69632);
  float* sMu = (float*)(smem + 69632 + 34816);
  float* sRs = sMu + 128;
  const bf16_t* P = (const bf16_t*)(p.ws + W_P);
  const size_t R0 = (size_t)b * SEQ + chunk * 128;
  for (int rr = 0; rr < 16; ++rr) {
    const int s = wid * 16 + rr;
    const bf16_t* rp = P + (R0 + s) * NPJ + C_VB;
    float f[16];
    unpack8(*(const uint4*)(rp + lane * 8), f);
    unpack8(*(const uint4*)(rp + 512 + lane * 8), f + 8);
    float a = 0.f, q = 0.f;
#pragma unroll
    for (int e = 0; e < 16; ++e) { a += f[e]; q += f[e] * f[e]; }
    a = wave_sum(a); q = wave_sum(q);
    if (lane == 0) {
      const float mean = a * (1.f / D);
      sMu[s] = mean;
      sRs[s] = rsqrtf(fmaxf(q * (1.f / D) - mean * mean, 0.f) + EPS);
    }
  }
  __syncthreads();
  const float* lg = p.in[I_GLNG] + (size_t)l * D + g * 256;
  const float* lb = p.in[I_GLNB] + (size_t)l * D + g * 256;
#pragma unroll
  for (int i = 0; i < 8; ++i) {
    int c = tid + 512 * i, r = c >> 5, c8 = c & 31;
    float f[8];
    unpack8(*(const uint4*)(P + (R0 + r) * NPJ + C_VB + g * 256 + c8 * 8), f);
    const float mu = sMu[r], rs = sRs[r];
    const float4 g0 = *(const float4*)(lg + c8 * 8), g1 = *(const float4*)(lg + c8 * 8 + 4);
    const float4 b0 = *(const float4*)(lb + c8 * 8), b1 = *(const float4*)(lb + c8 * 8 + 4);
    f[0] = (f[0] - mu) * rs * g0.x + b0.x; f[1] = (f[1] - mu) * rs * g0.y + b0.y;
    f[2] = (f[2] - mu) * rs * g0.z + b0.z; f[3] = (f[3] - mu) * rs * g0.w + b0.w;
    f[4] = (f[4] - mu) * rs * g1.x + b1.x; f[5] = (f[5] - mu) * rs * g1.y + b1.y;
    f[6] = (f[6] - mu) * rs * g1.z + b1.z; f[7] = (f[7] - mu) * rs * g1.w + b1.w;
    *(uint4*)(sVn + r * 272 + c8 * 8) = pack8(f);
  }
  const bf16_t* wm = (const bf16_t*)(p.ws + W_WM) + (size_t)(l * 4 + g) * 16384;
#pragma unroll
  for (int i = 0; i < 4; ++i) {
    int c = tid + 512 * i, r = c >> 4, c8 = c & 15;
    *(uint4*)(sW + r * 136 + c8 * 8) = *(const uint4*)(wm + r * 128 + c8 * 8);
  }
  __syncthreads();
  f32x4 acc[4][4];
#pragma unroll
  for (int m = 0; m < 4; ++m)
#pragma unroll
    for (int n = 0; n < 4; ++n) acc[m][n] = f32x4{0.f, 0.f, 0.f, 0.f};
#pragma unroll
  for (int kk = 0; kk < 4; ++kk) {
    bf16x8 tf[4];
#pragma unroll
    for (int m = 0; m < 4; ++m) tf[m] = *(const bf16x8*)(sW + (wr * 64 + m * 16 + fr) * 136 + kk * 32 + fq * 8);
#pragma unroll
    for (int n = 0; n < 4; ++n) {
      bf16x8 cf = frag_t(sVn, 272, wc * 64 + n * 16, kk * 32, lane);
#pragma unroll
      for (int m = 0; m < 4; ++m) acc[m][n] = mfma16(cf, tf[m], acc[m][n]);
    }
  }
  bf16_t* Y1 = (bf16_t*)(p.ws + W_Y) + (size_t)MT * D;
  const float* bs = p.in[I_GBS] + (size_t)(l * 4 + g) * 128;
#pragma unroll
  for (int m = 0; m < 4; ++m) {
    const int t = wr * 64 + m * 16 + fr;
    const float bsv = bs[t];
    const size_t row = R0 + t;
#pragma unroll
    for (int n = 0; n < 4; ++n) {
      const int col = g * 256 + wc * 64 + n * 16 + fq * 4;
      const uint2 uv = *(const uint2*)(P + row * NPJ + C_UB + col);
      const uint2 zv = *(const uint2*)(P + row * NPJ + C_ZB + col);
      const float u[4] = {bflo(uv.x), bfhi(uv.x), bflo(uv.y), bfhi(uv.y)};
      const float z[4] = {bflo(zv.x), bfhi(zv.x), bflo(zv.y), bfhi(zv.y)};
      float y[4];
#pragma unroll
      for (int r = 0; r < 4; ++r) y[r] = u[r] * (acc[m][n][r] + bsv) * silu(z[r]);
      uint2 o; o.x = pk2(y[0], y[1]); o.y = pk2(y[2], y[3]);
      *(uint2*)(Y1 + row * D + col) = o;
    }
  }
  __syncthreads();
}

__device__ __forceinline__ void gmlp_sample(const Params& p, int l, int b, char* smem) {
  const int tid = otid(), lane = tid & 63, wid = tid >> 6;
  float* svn = (float*)smem;
  const bf16_t* P = (const bf16_t*)(p.ws + W_P);
  const size_t R0 = (size_t)NPR + b * 4;
  if (wid < 4) {
    const int t = wid;
    const bf16_t* rp = P + (R0 + t) * NPJ + C_VB;
    float f[16];
    unpack8(*(const uint4*)(rp + lane * 8), f);
    unpack8(*(const uint4*)(rp + 512 + lane * 8), f + 8);
    float a = 0.f;
#pragma unroll
    for (int e = 0; e < 16; ++e) a += f[e];
    const float mean = wave_sum(a) * (1.f / D);
    float q = 0.f;
#pragma unroll
    for (int e = 0; e < 16; ++e) { f[e] -= mean; q += f[e] * f[e]; }
    const float rs = rsqrtf(wave_sum(q) * (1.f / D) + EPS);
    const float* lg = p.in[I_GLNG] + (size_t)l * D;
    const float* lb = p.in[I_GLNB] + (size_t)l * D;
    float* ov = p.out + O_VS + (((size_t)l * 128 + b) * 4 + t) * D;
#pragma unroll
    for (int hh = 0; hh < 2; ++hh) {
      const int c0 = hh * 512 + lane * 8;
#pragma unroll
      for (int e = 0; e < 8; ++e) f[hh * 8 + e] = f[hh * 8 + e] * rs * lg[c0 + e] + lb[c0 + e];
      *(float4*)(svn + t * 1024 + c0) = float4{f[hh * 8], f[hh * 8 + 1], f[hh * 8 + 2], f[hh * 8 + 3]};
      *(float4*)(svn + t * 1024 + c0 + 4) = float4{f[hh * 8 + 4], f[hh * 8 + 5], f[hh * 8 + 6], f[hh * 8 + 7]};
      *(float4*)(ov + c0) = float4{f[hh * 8], f[hh * 8 + 1], f[hh * 8 + 2], f[hh * 8 + 3]};
      *(float4*)(ov + c0 + 4) = float4{f[hh * 8 + 4], f[hh * 8 + 5], f[hh * 8 + 6], f[hh * 8 + 7]};
    }
  }
  __syncthreads();
  bf16_t* Y1 = (bf16_t*)(p.ws + W_Y) + (size_t)MT * D;
#pragma unroll
  for (int i = 0; i < 8; ++i) {
    const int idx = tid + 512 * i, t = idx >> 10, c = idx & 1023, g = c >> 8;
    const float* wrow = p.in[I_GWS] + ((size_t)(l * 4 + g) * 128 + t) * 128;
    float mixed = p.in[I_GBS][(size_t)(l * 4 + g) * 128 + t];
#pragma unroll
    for (int s = 0; s < 4; ++s)
      if (s <= t) mixed += wrow[s] * svn[s * 1024 + c];
    const float u = bf2f(P[(R0 + t) * NPJ + C_UB + c]), z = bf2f(P[(R0 + t) * NPJ + C_ZB + c]);
    __hip_atomic_store(Y1 + (R0 + t) * D + c, f2bf(u * mixed * silu(z)), __ATOMIC_RELAXED, __HIP_MEMORY_SCOPE_AGENT);
  }
  __syncthreads();
}

__device__ __forceinline__ void lru_gemm_pass(const Params& p, int l, int mat, int cp, const bf16_t* sX, bf16_t* sWt,
                                              f32x4 (&acc)[8][2]) {
  const int tid = otid(), lane = tid & 63, wid = tid >> 6, fr = lane & 15, fq = lane >> 4;
  const bf16_t* src = (const bf16_t*)(p.ws + W_WTL) + (size_t)((l * 2 + mat) * 8 + cp * 2) * 16384;
  __syncthreads();
#pragma unroll
  for (int i = 0; i < 8; ++i) {
    int c = tid + 512 * i, r = c >> 4, c8 = c & 15;
    *(uint4*)(sWt + r * 136 + c8 * 8) = *(const uint4*)(src + r * 128 + c8 * 8);
  }
  __syncthreads();
  const int kb = (wid >> 2) * 128;
#pragma unroll
  for (int m = 0; m < 8; ++m) { acc[m][0] = f32x4{0.f, 0.f, 0.f, 0.f}; acc[m][1] = f32x4{0.f, 0.f, 0.f, 0.f}; }
#pragma unroll
  for (int kk = 0; kk < 4; ++kk) {
    bf16x8 wf0 = *(const bf16x8*)(sWt + (wid * 32 + fr) * 136 + kk * 32 + fq * 8);
    bf16x8 wf1 = *(const bf16x8*)(sWt + (wid * 32 + 16 + fr) * 136 + kk * 32 + fq * 8);
#pragma unroll
    for (int m = 0; m < 8; ++m) {
      bf16x8 xf = *(const bf16x8*)(sX + (m * 16 + fr) * 264 + kb + kk * 32 + fq * 8);
      acc[m][0] = mfma16(xf, wf0, acc[m][0]);
      acc[m][1] = mfma16(xf, wf1, acc[m][1]);
    }
  }
}

__device__ __forceinline__ void lru_tile(const Params& p, int l, int tile, int cp, bool sample, char* smem) {
  const int tid = otid(), lane = tid & 63, wid = tid >> 6, fr = lane & 15, fq = lane >> 4;
  bf16_t* sX = (bf16_t*)smem;
  bf16_t* sWt = (bf16_t*)(smem + 67584);
  const bf16_t* P = (const bf16_t*)(p.ws + W_P);
  {
    const int cg8 = tid & 31, tg = tid >> 5, c = cp * 256 + cg8 * 8;
    float w0[8], w1[8], w2[8], w3[8], bb[8];
    const float* cw = p.in[I_CONVW] + (size_t)l * 4 * D + c;
#pragma unroll
    for (int e = 0; e < 8; ++e) { w0[e] = cw[e]; w1[e] = cw[D + e]; w2[e] = cw[2 * D + e]; w3[e] = cw[3 * D + e]; bb[e] = p.in[I_CONVB][(size_t)l * D + c + e]; }
    if (!sample) {
      const int b = tile >> 4, tt0 = (tile & 15) * 128 + tg * 8;
      const size_t rb = (size_t)b * SEQ;
      float x3[8], x2[8], x1[8], cur[8];
#pragma unroll
      for (int e = 0; e < 8; ++e) { x3[e] = 0.f; x2[e] = 0.f; x1[e] = 0.f; }
      if (tt0 > 0) {
        unpack8(*(const uint4*)(P + (rb + tt0 - 3) * NPJ + C_XC + c), x3);
        unpack8(*(const uint4*)(P + (rb + tt0 - 2) * NPJ + C_XC + c), x2);
        unpack8(*(const uint4*)(P + (rb + tt0 - 1) * NPJ + C_XC + c), x1);
      }
#pragma unroll
      for (int i = 0; i < 8; ++i) {
        unpack8(*(const uint4*)(P + (rb + tt0 + i) * NPJ + C_XC + c), cur);
        float xc[8];
#pragma unroll
        for (int e = 0; e < 8; ++e) xc[e] = bb[e] + w0[e] * x3[e] + w1[e] * x2[e] + w2[e] * x1[e] + w3[e] * cur[e];
        *(uint4*)(sX + (tg * 8 + i) * 264 + cg8 * 8) = pack8(xc);
        if ((tile & 15) == 15 && tg == 15 && i >= 5) {
          float* o = p.out + O_CONVP + (((size_t)l * 8 + b) * 3 + (i - 5)) * D + c;
          *(float4*)o = float4{cur[0], cur[1], cur[2], cur[3]};
          *(float4*)(o + 4) = float4{cur[4], cur[5], cur[6], cur[7]};
        }
#pragma unroll
        for (int e = 0; e < 8; ++e) { x3[e] = x2[e]; x2[e] = x1[e]; x1[e] = cur[e]; }
      }
    } else {
#pragma unroll
      for (int q = 0; q < 2; ++q) {
        const int bbi = tile * 32 + tg * 2 + q;
        const float* cb = p.in[I_SCONV] + ((size_t)l * 128 + bbi) * 3 * D + c;
        float x3[8], x2[8], x1[8], cur[8];
#pragma unroll
        for (int e = 0; e < 8; ++e) { x3[e] = cb[e]; x2[e] = cb[D + e]; x1[e] = cb[2 * D + e]; }
#pragma unroll
        for (int i = 0; i < 4; ++i) {
          unpack8(*(const uint4*)(P + ((size_t)NPR + bbi * 4 + i) * NPJ + C_XC + c), cur);
          float xc[8];
#pragma unroll
          for (int e = 0; e < 8; ++e) xc[e] = bb[e] + w0[e] * x3[e] + w1[e] * x2[e] + w2[e] * x1[e] + w3[e] * cur[e];
          *(uint4*)(sX + (tg * 8 + q * 4 + i) * 264 + cg8 * 8) = pack8(xc);
          if (i >= 1) {
            float* o = p.out + O_CONVS + (((size_t)l * 128 + bbi) * 3 + (i - 1)) * D + c;
            *(float4*)o = float4{cur[0], cur[1], cur[2], cur[3]};
            *(float4*)(o + 4) = float4{cur[4], cur[5], cur[6], cur[7]};
          }
#pragma unroll
          for (int e = 0; e < 8; ++e) { x3[e] = x2[e]; x2[e] = x1[e]; x1[e] = cur[e]; }
        }
      }
    }
  }
  f32x4 racc[8][2], iacc[8][2];
  lru_gemm_pass(p, l, 0, cp, sX, sWt, racc);
  lru_gemm_pass(p, l, 1, cp, sX, sWt, iacc);
  const bool first = (!sample) && ((tile & 15) == 0);
#pragma unroll
  for (int n = 0; n < 2; ++n) {
    const int jl = wid * 32 + n * 16 + fr, c = cp * 256 + jl;
    const float bav = p.in[I_BA][(size_t)l * D + c], bxv = p.in[I_BX][(size_t)l * D + c];
    const float ls8 = 8.f * logsig(p.in[I_LAM][(size_t)l * D + c]);
#pragma unroll
    for (int m = 0; m < 8; ++m) {
      int mo = m * 16 + fq * 4;
      asm volatile("" : "+v"(mo));
#pragma unroll
      for (int r = 0; r < 4; ++r) {
        const int t = mo + r;
        const float rg = sigm(racc[m][n][r] + bav), ig = sigm(iacc[m][n][r] + bxv);
        const float av = __expf(ls8 * rg);
        float mult = __builtin_amdgcn_sqrtf(fmaxf(1.f - av * av, 0.f));
        if (first && t == 0) mult = 1.f;
        racc[m][n][r] = av;
        iacc[m][n][r] = mult * ig * bf2f(sX[t * 264 + jl]);
      }
    }
  }
  if (sample) {
    bf16_t* Y2 = (bf16_t*)(p.ws + W_Y) + (size_t)2 * MT * D;
#pragma unroll
    for (int n = 0; n < 2; ++n) {
      const int c = cp * 256 + wid * 32 + n * 16 + fr;
#pragma unroll
      for (int m = 0; m < 8; ++m) {
        int bbi = tile * 32 + m * 4 + fq;
        asm volatile("" : "+v"(bbi));
        float hh = p.in[I_SH][((size_t)l * 128 + bbi) * D + c];
#pragma unroll
        for (int r = 0; r < 4; ++r) {
          hh = racc[m][n][r] * hh + iacc[m][n][r];
          const size_t row = (size_t)NPR + bbi * 4 + r;
          const float z = bf2f(P[row * NPJ + C_ZC + c]);
          __hip_atomic_store(Y2 + row * D + c, f2bf(hh * silu(z)), __ATOMIC_RELAXED, __HIP_MEMORY_SCOPE_AGENT);
        }
        p.out[O_HS + ((size_t)l * 128 + bbi) * D + c] = hh;
      }
    }
  } else {
    bf16_t* LH = (bf16_t*)(p.ws + W_LH);
    bf16_t* LA = (bf16_t*)(p.ws + W_LA);
    const size_t rb = (size_t)(tile >> 4) * SEQ + (tile & 15) * 128;
#pragma unroll
    for (int n = 0; n < 2; ++n) {
      const int c = cp * 256 + wid * 32 + n * 16 + fr;
      float cA = 1.f, cH = 0.f;
#pragma unroll
      for (int m = 0; m < 8; ++m) {
        int mo = m * 16 + fq * 4;
        asm volatile("" : "+v"(mo));
        float la_[4], lh_[4];
        la_[0] = racc[m][n][0]; lh_[0] = iacc[m][n][0];
#pragma unroll
        for (int r = 1; r < 4; ++r) { la_[r] = la_[r - 1] * racc[m][n][r]; lh_[r] = racc[m][n][r] * lh_[r - 1] + iacc[m][n][r]; }
        float A = la_[3], H = lh_[3];
        float pA = SHU(A, 16), pH = SHU(H, 16);
        if (fq >= 1) { H = A * pH + H; A = A * pA; }
        pA = SHU(A, 32); pH = SHU(H, 32);
        if (fq >= 2) { H = A * pH + H; A = A * pA; }
        float eA = SHU(A, 16), eH = SHU(H, 16);
        if (fq == 0) { eA = 1.f; eH = 0.f; }
        const float tA = shf(A, 48 + fr), tH = shf(H, 48 + fr);
        const float PA = cA * eA, PH = eA * cH + eH;
#pragma unroll
        for (int r = 0; r < 4; ++r) {
          const size_t row = rb + mo + r;
          LA[row * D + c] = f2bf(PA * la_[r]);
          LH[row * D + c] = f2bf(la_[r] * PH + lh_[r]);
        }
        cH = tA * cH + tH;
        cA = cA * tA;
      }
      if (fq == 0) {
        float* LE = (float*)(p.ws + W_LE) + ((size_t)tile * D + c) * 2;
        LE[0] = cA; LE[1] = cH;
      }
    }
  }
  __syncthreads();
}

__device__ __forceinline__ void lru_fix(const Params& p, int l, int tile, int half) {
  const int tid = otid(), c = tid * 2;
  const int b = tile >> 4, seg = tile & 15;
  const float* LE = (const float*)(p.ws + W_LE);
  float H0 = 0.f, H1 = 0.f;
  for (int k = 0; k < seg; ++k) {
    const float4 e = *(const float4*)(LE + ((size_t)(b * 16 + k) * D + c) * 2);
    H0 = e.x * H0 + e.y;
    H1 = e.z * H1 + e.w;
  }
  const bf16_t* P = (const bf16_t*)(p.ws + W_P);
  const bf16_t* LH = (const bf16_t*)(p.ws + W_LH);
  const bf16_t* LA = (const bf16_t*)(p.ws + W_LA);
  bf16_t* Y2 = (bf16_t*)(p.ws + W_Y) + (size_t)2 * MT * D;
  const size_t R0 = (size_t)b * SEQ + seg * 128 + half * 64;
#pragma unroll 8
  for (int rr = 0; rr < 64; ++rr) {
    const size_t row = R0 + rr;
    const unsigned hl = *(const unsigned*)(LH + row * D + c);
    const unsigned al = *(const unsigned*)(LA + row * D + c);
    const unsigned zv = *(const unsigned*)(P + row * NPJ + C_ZC + c);
    const float h0 = bflo(hl) + bflo(al) * H0, h1 = bfhi(hl) + bfhi(al) * H1;
    *(unsigned*)(Y2 + row * D + c) = pk2(h0 * silu(bflo(zv)), h1 * silu(bfhi(zv)));
  }
  if (seg == 15 && half == 1) {
    const float4 e = *(const float4*)(LE + ((size_t)(b * 16 + 15) * D + c) * 2);
    float2 o = {e.x * H0 + e.y, e.z * H1 + e.w};
    *(float2*)(p.out + O_HP + ((size_t)l * 8 + b) * D + c) = o;
  }
}

__device__ __forceinline__ void x4_unit(const Params& p, int l, int pm, int pn, char* smem) {
  float* MF = (float*)(p.ws + W_MF);
  bf16_t* MB = (bf16_t*)(p.ws + W_MB);
  const bf16_t* const P = (const bf16_t*)(p.ws + W_P);
#pragma unroll 1
  for (int br = 0; br < 3; ++br) {
    const bf16_t* A = (const bf16_t*)(p.ws + W_Y) + (size_t)br * MT * D;
    const bf16_t* Bt = (const bf16_t*)(p.ws + W_WTP) + (size_t)(l * 4 + br) * D * D;
    f32x4 acc[2][2][4][2];
    gemm_tile(A, Bt, pm * 256, pn * 256, smem, acc);
    EPI_IDX
    EPI_LOOP {
      const int row = pm * 256 + ai * 128 + wr * 64 + m * 16 + fr, col = pn * 256 + bj * 128 + wc * 32 + n * 16 + fq * 4;
      const uint2 gv = *(const uint2*)(P + (size_t)row * NPJ + C_GA + br * 1024 + col);
      float4 v = {acc[ai][bj][m][n][0] * sigm(bflo(gv.x)), acc[ai][bj][m][n][1] * sigm(bfhi(gv.x)),
                  acc[ai][bj][m][n][2] * sigm(bflo(gv.y)), acc[ai][bj][m][n][3] * sigm(bfhi(gv.y))};
      uint2* mf = (uint2*)((bf16_t*)MF + (size_t)row * D + col);
      if (br == 0) {
        uint2 ob; ob.x = pk2(v.x, v.y); ob.y = pk2(v.z, v.w); *mf = ob;
      } else {
        const uint2 o = *mf;
        v.x += bflo(o.x); v.y += bfhi(o.x); v.z += bflo(o.y); v.w += bfhi(o.y);
        uint2 ob; ob.x = pk2(v.x, v.y); ob.y = pk2(v.z, v.w);
        if (br == 1) *mf = ob;
        else *(uint2*)(MB + (size_t)row * D + col) = ob;
      }
    }
  }
}
__device__ __forceinline__ void x5_unit(const Params& p, int l, int pm, int pn, char* smem) {
  const bf16_t* A = (const bf16_t*)(p.ws + W_MB);
  const bf16_t* Bt = (const bf16_t*)(p.ws + W_WTP) + (size_t)(l * 4 + 3) * D * D;
  float* PRE = (float*)(p.ws + W_PRE);
  const float* XF = (const float*)(p.ws + W_XF);
  f32x4 acc[2][2][4][2];
  gemm_tile(A, Bt, pm * 256, pn * 256, smem, acc);
  EPI_IDX
  EPI_LOOP {
    const int row = pm * 256 + ai * 128 + wr * 64 + m * 16 + fr, col = pn * 256 + bj * 128 + wc * 32 + n * 16 + fq * 4;
    const float* xr = (l == 0) ? (row < NPR ? p.in[I_XP] + (size_t)row * D : p.in[I_XS] + (size_t)(row - NPR) * D)
                               : XF + (size_t)row * D;
    const float4 xv = *(const float4*)(xr + col);
    float4 v = {ALPHA * xv.x + acc[ai][bj][m][n][0], ALPHA * xv.y + acc[ai][bj][m][n][1],
                ALPHA * xv.z + acc[ai][bj][m][n][2], ALPHA * xv.w + acc[ai][bj][m][n][3]};
    *(float4*)(PRE + (size_t)row * D + col) = v;
  }
}
__device__ __forceinline__ void dep_signal(unsigned* ctr) {
  asm volatile("s_waitcnt vmcnt(0)" ::: "memory");
  __syncthreads();
  if (threadIdx.x == 0) {
    __builtin_amdgcn_fence(__ATOMIC_RELEASE, "agent");
    asm volatile("s_waitcnt vmcnt(0)" ::: "memory");
    (void)__hip_atomic_fetch_add(ctr, 1u, __ATOMIC_RELAXED, __HIP_MEMORY_SCOPE_AGENT);
  }
}
__device__ __forceinline__ void dep_signal_wt(unsigned* ctr) {
  asm volatile("s_waitcnt vmcnt(0)" ::: "memory");
  __syncthreads();
  if (threadIdx.x == 0) (void)__hip_atomic_fetch_add(ctr, 1u, __ATOMIC_RELAXED, __HIP_MEMORY_SCOPE_AGENT);
}
__device__ __forceinline__ void dep_wait(unsigned* ctr, unsigned target) {
  if (threadIdx.x == 0) {
    unsigned sp = 0;
    while (__hip_atomic_load(ctr, __ATOMIC_RELAXED, __HIP_MEMORY_SCOPE_AGENT) < target) {
      __builtin_amdgcn_s_sleep(2);
      if (++sp > (1u << 24)) break;
    }
    __builtin_amdgcn_fence(__ATOMIC_ACQUIRE, "agent");
    asm volatile("s_waitcnt vmcnt(0)" ::: "memory");
  }
  __syncthreads();
}

#define XB_TMO 128
#define XB_XCNT(j) (256 + 64 * (j))
#define XB_XSUB(j) (1280 + 64 * (j))
#define XB_XGEN(j) (2304 + 64 * (j))
#define XB_TOP 3328
#define XB_TOPGEN 3392
#define XCD_BAR_WORDS 3456
#define XB_SPIN_CAP (1u << 22)
__device__ __forceinline__ unsigned xb_ld(unsigned* p) { return __hip_atomic_load(p, __ATOMIC_RELAXED, __HIP_MEMORY_SCOPE_AGENT); }
__device__ __forceinline__ unsigned xb_add(unsigned* p, unsigned v) { return __hip_atomic_fetch_add(p, v, __ATOMIC_RELAXED, __HIP_MEMORY_SCOPE_AGENT); }
__device__ __forceinline__ unsigned xb_xcc_id() { return (unsigned)__builtin_amdgcn_s_getreg((3 << 11) | 20) & 0xFu; }
#define XB_SPIN(cond, bar) do { unsigned _sp = 0; while (cond) { __builtin_amdgcn_s_sleep(1); \
    if ((++_sp & 255u) == 0u) { if (xb_ld(&(bar)[XB_TMO])) break; if (_sp > XB_SPIN_CAP) { atomicAdd(&(bar)[XB_TMO], 1u); break; } } } } while (0)
struct XcdBarrier { unsigned* bar; unsigned x; volatile LDSP(unsigned) st; };
__device__ __forceinline__ XcdBarrier xcd_barrier_post(unsigned* bar, volatile LDSP(unsigned) st) {
  XcdBarrier b; b.bar = bar; b.x = xb_xcc_id(); b.st = st;
  if (threadIdx.x == 0) (void)xb_add(&bar[XB_XCNT(b.x)], 1u);
  return b;
}
__device__ __forceinline__ void xcd_barrier_complete(unsigned* bar, unsigned x, unsigned& nloc, unsigned& nx) {
  const unsigned G = gridDim.x * gridDim.y * gridDim.z;
  unsigned sum, cnt, mine, sp = 0u;
  for (;;) {
    sum = 0u; cnt = 0u; mine = 0u;
#pragma unroll
    for (unsigned j = 0; j < 16; ++j) { const unsigned c = xb_ld(&bar[XB_XCNT(j)]); sum += c; cnt += (c > 0u) ? 1u : 0u; mine = (j == x) ? c : mine; }
    if (sum == G) break;
    __builtin_amdgcn_s_sleep(1);
    if ((++sp & 255u) == 0u) { if (xb_ld(&bar[XB_TMO])) break; if (sp > XB_SPIN_CAP) { atomicAdd(&bar[XB_TMO], 1u); break; } }
  }
  nloc = mine > 0u ? mine : 1u; nx = cnt > 0u ? cnt : 1u;
}
__device__ __forceinline__ void xcd_barrier(const XcdBarrier& b) {
  asm volatile("s_waitcnt vmcnt(0)" ::: "memory");
  __syncthreads();
  if (threadIdx.x == 0) {
    unsigned* bar = b.bar;
    __builtin_amdgcn_s_waitcnt(0);
    unsigned nloc = b.st[0], nx = b.st[1];
    if (nloc == 0u) { xcd_barrier_complete(bar, b.x, nloc, nx); b.st[0] = nloc; b.st[1] = nx; }
    const unsigned old = xb_add(&bar[XB_XSUB(b.x)], 1u);
    const unsigned gen = old / nloc;
    if (old + 1u == (gen + 1u) * nloc) {
      __builtin_amdgcn_fence(__ATOMIC_RELEASE, "agent");
      asm volatile("s_waitcnt vmcnt(0)" ::: "memory");
      const unsigned og = xb_add(&bar[XB_TOP], 1u);
      const unsigned tg = og / nx;
      if (og + 1u == (tg + 1u) * nx) xb_add(&bar[XB_TOPGEN], 1u);
      else XB_SPIN(xb_ld(&bar[XB_TOPGEN]) == tg, bar);
      __builtin_amdgcn_fence(__ATOMIC_ACQUIRE, "agent");
      xb_add(&bar[XB_XGEN(b.x)], 1u);
      asm volatile("s_waitcnt vmcnt(0)" ::: "memory");
    } else {
      XB_SPIN(xb_ld(&bar[XB_XGEN(b.x)]) == gen, bar);
      __builtin_amdgcn_fence(__ATOMIC_ACQUIRE, "agent");
      asm volatile("s_waitcnt vmcnt(0)" ::: "memory");
    }
  }
  __syncthreads();
}

__global__ void __launch_bounds__(512) mega(Params p) {
  extern __shared__ __attribute__((aligned(16))) char smem[];
  cg::grid_group grid = cg::this_grid();
  const int G = gridDim.x, bid = blockIdx.x;
  volatile LDSP(unsigned) xst = (volatile LDSP(unsigned))(smem + LDS_TOTAL - 16);
  if (threadIdx.x == 0) { xst[0] = 0u; xst[1] = 0u; xst[2] = 0u; xst[3] = 0u; }
  __syncthreads();
  XcdBarrier xb = xcd_barrier_post((unsigned*)(p.ws + W_BAR), xst);
  phase_convert(p, smem);
  row_pass(p, 0, smem);
  grid.sync();
#pragma unroll 1
  for (int l = 0; l < NL; ++l) {
    for (int it = bid; it < 32; it += G) mlstm_scalars(p, l, it, smem);
    REP(0) {
      const bf16_t* A = (const bf16_t*)(p.ws + W_XB);
      const bf16_t* Bt = (const bf16_t*)(p.ws + W_WTIN) + (size_t)l * NPJ * D;
      const float* bias = p.in[I_BIN] + (size_t)l * INW;
      bf16_t* const P = (bf16_t*)(p.ws + W_P);
      bool primed = false;
#pragma unroll 1
      for (int L = bid; L < 66 * 52; L += G) {
        int pm, pn; tile_map(L, 66, 52, pm, pn, 4);
        f32x4 acc[2][2][4][2];
        gemm_tile(A, Bt, pm * 256, pn * 256, smem, acc, primed);
        EPI_IDX
        float4 bvv[2][2];
#pragma unroll
        for (int bj = 0; bj < 2; ++bj)
#pragma unroll
          for (int n = 0; n < 2; ++n) {
            const int col = pn * 256 + bj * 128 + wc * 32 + n * 16 + fq * 4;
            bvv[bj][n] = *(const float4*)(bias + col + (col >= 5120 ? 8 : 0));
          }
        asm volatile("s_waitcnt vmcnt(0)" ::: "memory");
        primed = (L + G < 66 * 52);
        if (primed) { int pm2, pn2; tile_map(L + G, 66, 52, pm2, pn2, 4); gemm_tile(A, Bt, pm2 * 256, pn2 * 256, smem, acc, false, true); }
        EPI_LOOP {
          const int row = pm * 256 + ai * 128 + wr * 64 + m * 16 + fr, col = pn * 256 + bj * 128 + wc * 32 + n * 16 + fq * 4;
          const float4 bv = bvv[bj][n];
          uint2 o;
          o.x = pk2(acc[ai][bj][m][n][0] + bv.x, acc[ai][bj][m][n][1] + bv.y);
          o.y = pk2(acc[ai][bj][m][n][2] + bv.z, acc[ai][bj][m][n][3] + bv.w);
          *(uint2*)(P + (size_t)row * NPJ + col) = o;
        }
      }
    }
    GSYNC;
    {
      constexpr int Q_S = 656, Q_X4 = Q_S + 8, Q_F1 = Q_X4 + 256, Q_X5 = Q_F1 + 8, Q_FN = Q_X5 + 128, Q_F2 = Q_FN + 128, Q_LR = Q_F2 + 512,
                    Q_F3 = Q_LR + 128, Q_G2 = Q_F3 + 512;
      unsigned* qbase = (unsigned*)(p.ws + W_QCT) + l * 64;
      volatile LDSP(int) qslot = (volatile LDSP(int))(smem + LDS_TOTAL - 32);
      if (threadIdx.x == 0) qslot[0] = (int)xb_add(qbase, 1u);
      __syncthreads();
      int it = qslot[0];
#pragma unroll 1
      while (it < Q_G2) {
        __syncthreads();
        int nxt = 0;
        int r = it, fq_ = -1, fbh = 0;
        if (r >= Q_X4 && r < Q_F1) { fq_ = 15 - ((r - Q_X4) >> 5); fbh = (r - Q_X4) & 31; }
        else if (r >= Q_FN && r < Q_F2) { fq_ = 7 - ((r - Q_FN) >> 5); fbh = (r - Q_FN) & 31; }
        else if (r >= Q_LR && r < Q_F3) { fq_ = 3 - ((r - Q_LR) >> 5); fbh = (r - Q_LR) & 31; }
        if (fq_ < 0 && threadIdx.x == 0) nxt = (int)xb_add(qbase, 1u);
        if (fq_ >= 0) { mlstm_flash(p, l, fbh, fq_, smem); if (threadIdx.x == 0) nxt = (int)xb_add(qbase, 1u); }
        else if (r < Q_S) {
          if (r < 512) mlstm_sample(p, l, r >> 2, r & 3, smem);
          else if (r < 640) gmlp_sample(p, l, r - 512, smem);
          else lru_tile(p, l, (r - 640) >> 2, r & 3, true, smem);
          dep_signal_wt(qbase + 16);
        }
        else if (r < Q_X4) { r -= Q_S; dep_wait(qbase + 16, 656u); x4_unit(p, l, 64 + (r >> 2), r & 3, smem); dep_signal(qbase + 32 + 16 * (r >> 2)); }
        else if (r < Q_X5) { r -= Q_F1; dep_wait(qbase + 32 + 16 * (r >> 2), 4u); x5_unit(p, l, 64 + (r >> 2), r & 3, smem); }
        else if (r < Q_FN) { r -= Q_X5; mlstm_final(p, l, r >> 2, r & 3, smem); }
        else if (r < Q_LR) { r -= Q_F2; lru_tile(p, l, r >> 2, r & 3, false, smem); }
        else { r -= Q_F3; gmlp_prompt(p, l, r >> 6, (r >> 2) & 15, r & 3, smem); }
        if (threadIdx.x == 0) qslot[0] = nxt;
        __syncthreads();
        it = qslot[0];
      }
    }
    GSYNC;
    for (int it = bid; it < 256; it += G) lru_fix(p, l, it >> 1, it & 1);
    GSYNC;
#pragma unroll 1
    for (int L = bid; L < 64 * 4; L += G) { int pm, pn; tile_map(L, 64, 4, pm, pn); x4_unit(p, l, pm, pn, smem); }
    GSYNC;
#pragma unroll 1
    for (int L = bid; L < 64 * 4; L += G) { int pm, pn; tile_map(L, 64, 4, pm, pn); x5_unit(p, l, pm, pn, smem); }
    GSYNC;
    row_pass(p, l + 1, smem);
    GSYNC;
  }
}

extern "C" void kernel_launch(void* const* d_in, const int* in_sizes, int n_in, void* d_out, int out_size, void* d_ws,
                              size_t ws_size, hipStream_t stream) {
  constexpr size_t kLds = LDS_TOTAL;
  static int grid_blocks = 0;
  if (!grid_blocks) {
    int dev = 0, cus = 0, per_cu = 0;
    (void)hipGetDevice(&dev);
    (void)hipDeviceGetAttribute(&cus, hipDeviceAttributeMultiprocessorCount, dev);
    (void)hipFuncSetAttribute((const void*)mega, hipFuncAttributeMaxDynamicSharedMemorySize, (int)kLds);
    (void)hipOccupancyMaxActiveBlocksPerMultiprocessor(&per_cu, (const void*)mega, 512, kLds);
    if (per_cu < 1) per_cu = 1;
    grid_blocks = cus * per_cu;
    if (grid_blocks % 8) grid_blocks -= grid_blocks % 8;
    if (ws_size < W_END || n_in != 27 || (size_t)out_size != O_END)
      fprintf(stderr, "kernel_launch: unexpected sizes ws %zu (need %zu) n_in %d out %d (expect %zu)\n", ws_size,
              (size_t)W_END, n_in, out_size, (size_t)O_END);
  }
  (void)hipMemsetAsync((char*)d_ws + W_BAR, 0, W_CTL_END - W_BAR, stream);
  Params p{};
  for (int i = 0; i < 27; ++i) p.in[i] = (const float*)d_in[i];
  p.out = (float*)d_out;
  p.ws = (char*)d_ws;
  void* args[] = {&p};
  hipError_t e = hipLaunchCooperativeKernel((const void*)mega, dim3(grid_blocks), dim3(512), args, kLds, stream);
  if (e != hipSuccess) fprintf(stderr, "cooperative launch failed: %s (grid %d)\n", hipGetErrorString(e), grid_blocks);
}
```

```cpp
#include <hip/hip_runtime.h>
#include <hip/hip_cooperative_groups.h>
#include <cstdio>
#include <cstdint>
namespace cg = cooperative_groups;

typedef unsigned short bf16_t;
typedef short bf16x8 __attribute__((ext_vector_type(8)));
typedef short s16x4 __attribute__((ext_vector_type(4)));
typedef float f32x4 __attribute__((ext_vector_type(4)));
#define LDSP(T) __attribute__((address_space(3))) T*

constexpr int D = 1024, NPR = 16384, NSM = 512, MT = 16896, NL = 4, SEQ = 2048;
constexpr int INW = 13320, NPJ = 13312;
constexpr int C_Q = 0, C_K = 1024, C_V = 2048, C_O = 3072, C_ZA = 4096, C_UB = 5120, C_VB = 6144, C_ZB = 7168,
              C_XC = 8192, C_ZC = 9216, C_GA = 10240;
constexpr float ALPHA = 1.6817928305074292f;
constexpr float EPS = 1e-5f;
constexpr int LDS_TOTAL = 150 * 1024;
#ifndef DUP_PHASE
#define DUP_PHASE -1
#endif
#define GSYNC xcd_barrier(xb)
#define REP(k) for (int rep_ = 0; rep_ < ((DUP_PHASE == (k)) ? 2 : 1); ++rep_)

constexpr size_t W_WTIN = 0;
constexpr size_t W_WTP = W_WTIN + (size_t)NL * NPJ * D * 2;
constexpr size_t W_WTL = W_WTP + (size_t)NL * 4 * D * D * 2;
constexpr size_t W_WM = W_WTL + (size_t)NL * 2 * 8 * 128 * 128 * 2;
constexpr size_t W_XB = W_WM + (size_t)NL * 4 * 128 * 128 * 2;
constexpr size_t W_XF = W_XB + (size_t)MT * D * 2;
constexpr size_t W_GATE = W_XF + (size_t)MT * D * 4;
constexpr size_t W_P = W_GATE + (size_t)MT * 8 * 4;
constexpr size_t W_PRE = W_P + (size_t)MT * NPJ * 2;
constexpr size_t W_MF = W_PRE + (size_t)MT * D * 4;
constexpr size_t W_MB = W_MF + (size_t)MT * D * 4;
constexpr size_t W_Y = W_MB + (size_t)MT * D * 2;
constexpr size_t W_G = W_Y + (size_t)3 * MT * D * 2;
constexpr size_t W_MX = W_G + (size_t)32 * 2048 * 4;
constexpr size_t W_EM = W_MX + (size_t)32 * 2048 * 4;
constexpr size_t W_LH = W_EM + (size_t)32 * 2048 * 4;
constexpr size_t W_LA = W_LH + (size_t)NPR * D * 2;
constexpr size_t W_LE = W_LA + (size_t)NPR * D * 2;
constexpr size_t W_BAR = W_LE + (size_t)8 * 16 * 1024 * 2 * 4;
constexpr size_t W_QCT = W_BAR + 3456 * 4;
constexpr size_t W_CTL_END = W_QCT + 4 * 256;
constexpr size_t W_ST = W_CTL_END;
constexpr size_t W_END = W_ST + (size_t)16 * NPR * 2 * 4;

constexpr size_t O_Y = 0;
constexpr size_t O_CP = (size_t)MT * D;
constexpr size_t O_NP = O_CP + (size_t)NL * 8 * 4 * 256 * 256;
constexpr size_t O_MP = O_NP + (size_t)NL * 8 * 4 * 256;
constexpr size_t O_CONVP = O_MP + (size_t)NL * 8 * 4;
constexpr size_t O_HP = O_CONVP + (size_t)NL * 8 * 3 * 1024;
constexpr size_t O_CS = O_HP + (size_t)NL * 8 * 1024;
constexpr size_t O_NS = O_CS + (size_t)NL * 128 * 4 * 256 * 256;
constexpr size_t O_MS = O_NS + (size_t)NL * 128 * 4 * 256;
constexpr size_t O_CONVS = O_MS + (size_t)NL * 128 * 4;
constexpr size_t O_HS = O_CONVS + (size_t)NL * 128 * 3 * 1024;
constexpr size_t O_VS = O_HS + (size_t)NL * 128 * 1024;
constexpr size_t O_END = O_VS + (size_t)NL * 128 * 4 * 1024;

enum { I_XP = 0, I_XS, I_SC, I_SN, I_SM, I_SCONV, I_SH, I_WIN, I_BIN, I_NORMG, I_GLNG, I_GLNB, I_GWS, I_GBS, I_CONVW,
       I_CONVB, I_WA, I_BA, I_WX, I_BX, I_LAM, I_WPA, I_WPB, I_WPC, I_WOUT, I_LNG, I_LNB };

struct Params {
  const float* in[27];
  float* out;
  char* ws;
};

__device__ __forceinline__ bf16_t f2bf(float f) {
  unsigned u = __float_as_uint(f);
  u += 0x7fffu + ((u >> 16) & 1u);
  return (bf16_t)(u >> 16);
}
__device__ __forceinline__ float bf2f(bf16_t h) { return __uint_as_float(((unsigned)h) << 16); }
__device__ __forceinline__ unsigned pk2(float a, float b) {
  unsigned r;
  asm("v_cvt_pk_bf16_f32 %0, %1, %2" : "=v"(r) : "v"(a), "v"(b));
  return r;
}
__device__ __forceinline__ float bflo(unsigned u) { return __uint_as_float(u << 16); }
__device__ __forceinline__ float bfhi(unsigned u) { return __uint_as_float(u & 0xffff0000u); }
__device__ __forceinline__ float sigm(float x) { return __builtin_amdgcn_rcpf(1.f + __expf(-x)); }
__device__ __forceinline__ float silu(float x) { return x * sigm(x); }
__device__ __forceinline__ float logsig(float x) { return fminf(x, 0.f) - log1pf(__expf(-fabsf(x))); }
__device__ __forceinline__ float shf(float v, int src) {
  return __int_as_float(__builtin_amdgcn_ds_bpermute(src << 2, __float_as_int(v)));
}
#define SHX(v, o) shf((v), lane ^ (o))
#define SHU(v, o) shf((v), (lane >= (o)) ? lane - (o) : lane)
__device__ __forceinline__ float wave_sum_l(float v, int lane) {
#pragma unroll
  for (int o = 1; o < 64; o <<= 1) v += shf(v, lane ^ o);
  return v;
}
#define wave_sum(v) wave_sum_l((v), lane)
__device__ __forceinline__ f32x4 mfma16(bf16x8 a, bf16x8 b, f32x4 c) {
  return __builtin_amdgcn_mfma_f32_16x16x32_bf16(a, b, c, 0, 0, 0);
}
__device__ __forceinline__ bf16x8 frag_t(const bf16_t* T, int stride, int r0, int k0, int lane) {
  const int fr = lane & 15, fq = lane >> 4;
  const bf16_t* q = T + (k0 + fq * 8 + (fr >> 2)) * stride + r0 + (fr & 3) * 4;
  s16x4 a = __builtin_amdgcn_ds_read_tr16_b64_v4i16((LDSP(s16x4))q);
  s16x4 b = __builtin_amdgcn_ds_read_tr16_b64_v4i16((LDSP(s16x4))(q + 4 * stride));
  bf16x8 r = {a[0], a[1], a[2], a[3], b[0], b[1], b[2], b[3]};
  return r;
}
__device__ __forceinline__ void unpack8(uint4 v, float* f) {
  f[0] = bflo(v.x); f[1] = bfhi(v.x); f[2] = bflo(v.y); f[3] = bfhi(v.y);
  f[4] = bflo(v.z); f[5] = bfhi(v.z); f[6] = bflo(v.w); f[7] = bfhi(v.w);
}
__device__ __forceinline__ uint4 pack8(const float* f) {
  uint4 o; o.x = pk2(f[0], f[1]); o.y = pk2(f[2], f[3]); o.z = pk2(f[4], f[5]); o.w = pk2(f[6], f[7]);
  return o;
}

__device__ __forceinline__ int otid() { int t = threadIdx.x; asm volatile("" : "+v"(t)); return t; }

__device__ __forceinline__ void tconv_item(const float* src, int lds_, bf16_t* dst, int ldd, int k0, int n0s, int n0d,
                                           float* scr, int lane) {
#pragma unroll 8
  for (int i = 0; i < 32; ++i) {
    const int kk = 2 * i + (lane >> 5);
    scr[kk * 33 + (lane & 31)] = src[(size_t)(k0 + kk) * lds_ + n0s + (lane & 31)];
  }
  const int c = lane & 7;
#pragma unroll
  for (int j = 0; j < 4; ++j) {
    const int n = (lane >> 3) + 8 * j;
    const float* t = scr + (8 * c) * 33 + n;
    uint4 o;
    o.x = pk2(t[0 * 33], t[1 * 33]); o.y = pk2(t[2 * 33], t[3 * 33]);
    o.z = pk2(t[4 * 33], t[5 * 33]); o.w = pk2(t[6 * 33], t[7 * 33]);
    *(uint4*)(dst + (size_t)(n0d + n) * ldd + k0 + 8 * c) = o;
  }
}

__device__ __forceinline__ void phase_convert(const Params& p, char* smem) {
  const int tid = otid(), lane = tid & 63, wid = tid >> 6;
  float* scr = (float*)smem + wid * (64 * 33);
  constexpr int N_IN = NL * 16 * 416, N_PJ = NL * 4 * 16 * 32, N_LR = NL * 2 * 8 * 8;
  for (int it = blockIdx.x * 8 + wid; it < N_IN + N_PJ + N_LR; it += gridDim.x * 8) {
    int r = it;
    if (r < N_IN) {
      int l = r / (16 * 416), q = r % (16 * 416), kt = q / 416, nt = q % 416;
      int n0d = nt * 32, n0s = n0d + (n0d >= 5120 ? 8 : 0);
      tconv_item(p.in[I_WIN] + (size_t)l * D * INW, INW, (bf16_t*)(p.ws + W_WTIN) + (size_t)l * NPJ * D, D, kt * 64, n0s,
                 n0d, scr, lane);
      continue;
    }
    r -= N_IN;
    if (r < N_PJ) {
      int lm = r >> 9, q = r & 511, kt = q >> 5, nt = q & 31, l = lm >> 2, mat = lm & 3;
      const float* src = p.in[I_WPA + mat] + (size_t)l * D * D;
      tconv_item(src, D, (bf16_t*)(p.ws + W_WTP) + (size_t)lm * D * D, D, kt * 64, nt * 32, nt * 32, scr, lane);
      continue;
    }
    r -= N_PJ;
    {
      int q = r & 7, lmn = r >> 3, n = lmn & 7, mat = (lmn >> 3) & 1, l = lmn >> 4;
      const float* src = p.in[mat ? I_WX : I_WA] + (size_t)(l * 8 + n) * 16384;
      tconv_item(src, 128, (bf16_t*)(p.ws + W_WTL) + (size_t)((l * 2 + mat) * 8 + n) * 16384, 128, (q >> 2) * 64,
                 (q & 3) * 32, (q & 3) * 32, scr, lane);
    }
  }
  __syncthreads();
  bf16_t* wm = (bf16_t*)(p.ws + W_WM);
  const float* gws = p.in[I_GWS];
  for (int idx = blockIdx.x * 512 + otid(); idx < NL * 4 * 128 * 128; idx += gridDim.x * 512) {
    int t = (idx >> 7) & 127, s = idx & 127;
    wm[idx] = f2bf(s <= t ? gws[idx] : 0.f);
  }
}

__device__ __forceinline__ void row_pass(const Params& p, int l, char* smem) {
  const int tid = otid(), lane = tid & 63, wid = tid >> 6;
  float* sWg = (float*)smem;
  if (l < NL) {
    const float* w = p.in[I_WIN] + (size_t)l * D * INW;
    for (int idx = tid; idx < 8192; idx += 512) {
      int j = idx >> 10, k = idx & 1023;
      sWg[idx] = w[(size_t)k * INW + 5120 + j];
    }
  }
  __syncthreads();
  bf16_t* XB = (bf16_t*)(p.ws + W_XB);
  float* XF = (float*)(p.ws + W_XF);
  const float* PRE = (const float*)(p.ws + W_PRE);
  float* GATE = (float*)(p.ws + W_GATE);
  for (int r = blockIdx.x * 8 + wid; r < MT; r += gridDim.x * 8) {
    float4 v[4];
    if (l == 0) {
      const float* src = r < NPR ? p.in[I_XP] + (size_t)r * D : p.in[I_XS] + (size_t)(r - NPR) * D;
#pragma unroll
      for (int i = 0; i < 4; ++i) v[i] = ((const float4*)src)[lane + 64 * i];
    } else {
      const float* src = PRE + (size_t)r * D;
      float s = 0.f;
#pragma unroll
      for (int i = 0; i < 4; ++i) { v[i] = ((const float4*)src)[lane + 64 * i]; s += (v[i].x + v[i].y) + (v[i].z + v[i].w); }
      const float mean = wave_sum(s) * (1.f / D);
      float s2 = 0.f;
#pragma unroll
      for (int i = 0; i < 4; ++i) {
        v[i].x -= mean; v[i].y -= mean; v[i].z -= mean; v[i].w -= mean;
        s2 += (v[i].x * v[i].x + v[i].y * v[i].y) + (v[i].z * v[i].z + v[i].w * v[i].w);
      }
      const float rstd = rsqrtf(wave_sum(s2) * (1.f / D) + EPS);
      const float4* g4 = (const float4*)(p.in[I_LNG] + (size_t)(l - 1) * D);
      const float4* b4 = (const float4*)(p.in[I_LNB] + (size_t)(l - 1) * D);
      float* dst = (l == NL) ? p.out + O_Y + (size_t)r * D : XF + (size_t)r * D;
#pragma unroll
      for (int i = 0; i < 4; ++i) {
        float4 g = g4[lane + 64 * i], b = b4[lane + 64 * i];
        v[i].x = v[i].x * rstd * g.x + b.x; v[i].y = v[i].y * rstd * g.y + b.y;
        v[i].z = v[i].z * rstd * g.z + b.z; v[i].w = v[i].w * rstd * g.w + b.w;
        ((float4*)dst)[lane + 64 * i] = v[i];
      }
    }
    if (l < NL) {
#pragma unroll
      for (int i = 0; i < 4; ++i) {
        uint2 o; o.x = pk2(v[i].x, v[i].y); o.y = pk2(v[i].z, v[i].w);
        ((uint2*)(XB + (size_t)r * D))[lane + 64 * i] = o;
      }
      float ga[8];
#pragma unroll
      for (int j = 0; j < 8; ++j) {
        float a = 0.f;
#pragma unroll
        for (int i = 0; i < 4; ++i) {
          float4 w = ((const float4*)(sWg + j * 1024))[lane + 64 * i];
          a += v[i].x * w.x + v[i].y * w.y + v[i].z * w.z + v[i].w * w.w;
        }
        ga[j] = wave_sum(a);
      }
      if (lane == 0) {
        const float* bi = p.in[I_BIN] + (size_t)l * INW + 5120;
        float4 o0 = {ga[0] + bi[0], ga[1] + bi[1], ga[2] + bi[2], ga[3] + bi[3]};
        float4 o1 = {ga[4] + bi[4], ga[5] + bi[5], ga[6] + bi[6], ga[7] + bi[7]};
        ((float4*)(GATE + (size_t)r * 8))[0] = o0;
        ((float4*)(GATE + (size_t)r * 8))[1] = o1;
      }
    }
  }
  __syncthreads();
}

constexpr int KD = 1024, BK = 64, HALF = 128, HTB = HALF * BK * 2;
__device__ __forceinline__ int lds_byte(int r, int c) {
  int st = (r >> 4) * 2 + (c >> 5), rr = r & 15, cc = c & 31, ob = rr * 64 + cc * 2;
  return st * 1024 + (ob ^ (((ob >> 9) & 1) << 5));
}
__device__ __forceinline__ void stage_rc(int b, int& R, int& C) {
  int st = b / 1024, sb = b % 1024, swz = sb ^ (((sb >> 9) & 1) << 5);
  R = (st >> 1) * 16 + swz / 64;
  C = (st & 1) * 32 + (swz % 64) / 2;
}
__device__ __forceinline__ void tile_map(int L, int nM, int nN, int& pm, int& pn, int WGM_ = 8) {
  int nwg = nM * nN, q = nwg / 8, r = nwg % 8, xcd = L % 8, off = L / 8;
  int wgid = (xcd < r ? xcd * (q + 1) : r * (q + 1) + (xcd - r) * q) + off;
  int nig = WGM_ * nN, gid = wgid / nig, fm = gid * WGM_, gsz = min(nM - fm, WGM_);
  pm = fm + ((wgid % nig) % gsz);
  pn = (wgid % nig) / gsz;
}

__device__ __forceinline__ void gemm_tile(const bf16_t* __restrict__ A, const bf16_t* __restrict__ Bt, int brow, int bcol,
                                          char* shm, f32x4 (&acc)[2][2][4][2], bool primed = false, bool prime_only = false) {
#define SAO(b, h) (((b) * 2 + (h)) * HTB)
#define SBO(b, h) ((4 + (b) * 2 + (h)) * HTB)
#define STAGE(BO, BASE, br, kt)                                                                              \
  do {                                                                                                       \
    const char* _gb = (const char*)(BASE) + ((size_t)(br) * KD + (size_t)(kt) * BK) * 2;                     \
    __builtin_amdgcn_global_load_lds((const unsigned*)(_gb + toff0), (unsigned*)(shm + (BO) + tb0), 16, 0, 0); \
    __builtin_amdgcn_global_load_lds((const unsigned*)(_gb + toff1), (unsigned*)(shm + (BO) + tb1), 16, 0, 0); \
  } while (0)
#define LDA(dst, b, h)                                                                                         \
  _Pragma("unroll") for (int m = 0; m < 4; ++m) _Pragma("unroll") for (int k = 0; k < 2; ++k) dst[m][k] =      \
      *reinterpret_cast<const bf16x8*>(shm + SAO(b, h) + lds_byte(wr * 64 + m * 16 + fr, k * 32 + fq * 8))
#define LDB(dst, b, h)                                                                                         \
  _Pragma("unroll") for (int n = 0; n < 2; ++n) _Pragma("unroll") for (int k = 0; k < 2; ++k) dst[n][k] =      \
      *reinterpret_cast<const bf16x8*>(shm + SBO(b, h) + lds_byte(wc * 32 + n * 16 + fr, k * 32 + fq * 8))
#define MMA(ai, bj, At_, Bt_)                                                                               \
  do {                                                                                                      \
    __builtin_amdgcn_s_setprio(1);                                                                          \
    _Pragma("unroll") for (int m = 0; m < 4; ++m) _Pragma("unroll") for (int n = 0; n < 2; ++n)             \
        _Pragma("unroll") for (int k = 0; k < 2; ++k) acc[ai][bj][m][n] =                                   \
            __builtin_amdgcn_mfma_f32_16x16x32_bf16(Bt_[n][k], At_[m][k], acc[ai][bj][m][n], 0, 0, 0);     \
    __builtin_amdgcn_s_setprio(0);                                                                          \
  } while (0)
#define WAIT_V(n) asm volatile("s_waitcnt vmcnt(" #n ")" ::: "memory")
#define WAIT_L(n) asm volatile("s_waitcnt lgkmcnt(" #n ")" ::: "memory")
#define BAR __builtin_amdgcn_s_barrier()
#define SCHED __builtin_amdgcn_sched_barrier(0)
  const int tidg = otid();
  const int wid = tidg >> 6, lane = tidg & 63, wr = wid >> 2, wc = wid & 3, fr = lane & 15, fq = lane >> 4;
  const int tb0 = tidg * 16, tb1 = tb0 + 8192;
  unsigned toff0, toff1;
  {
    int r_, c_;
    stage_rc(tb0, r_, c_); toff0 = (unsigned)(r_ * KD + c_) * 2u;
    stage_rc(tb1, r_, c_); toff1 = (unsigned)(r_ * KD + c_) * 2u;
  }
  if (prime_only) {
    STAGE(SBO(0, 0), Bt, bcol, 0); STAGE(SAO(0, 0), A, brow, 0);
    STAGE(SBO(0, 1), Bt, bcol + HALF, 0); STAGE(SAO(0, 1), A, brow + HALF, 0);
    STAGE(SBO(1, 0), Bt, bcol, 1); STAGE(SAO(1, 0), A, brow, 1); STAGE(SBO(1, 1), Bt, bcol + HALF, 1);
    return;
  }
#pragma unroll
  for (int a = 0; a < 2; ++a)
#pragma unroll
    for (int b = 0; b < 2; ++b)
#pragma unroll
      for (int m = 0; m < 4; ++m)
#pragma unroll
        for (int n = 0; n < 2; ++n) acc[a][b][m][n] = f32x4{0.f, 0.f, 0.f, 0.f};
  bf16x8 At[4][2], B0[2][2], B1[2][2];
  constexpr int nt = KD / BK;
  if (!primed) {
    __syncthreads();
    STAGE(SBO(0, 0), Bt, bcol, 0); STAGE(SAO(0, 0), A, brow, 0);
    STAGE(SBO(0, 1), Bt, bcol + HALF, 0); STAGE(SAO(0, 1), A, brow + HALF, 0);
    STAGE(SBO(1, 0), Bt, bcol, 1); STAGE(SAO(1, 0), A, brow, 1); STAGE(SBO(1, 1), Bt, bcol + HALF, 1);
  }
  if (wr == 1) BAR;
  WAIT_V(0); BAR;
  BAR;
#pragma unroll 1
  for (int t = 0; t < nt - 2; t += 2) {
    LDB(B0, 0, 0); SCHED; LDA(At, 0, 0); STAGE(SAO(1, 1), A, brow + HALF, t + 1);
    WAIT_L(8); BAR; WAIT_L(0); MMA(0, 0, At, B0); BAR; SCHED;
    LDB(B1, 0, 1); STAGE(SBO(0, 0), Bt, bcol, t + 2);
    BAR; WAIT_L(0); MMA(0, 1, At, B1); BAR;
    LDA(At, 0, 1); STAGE(SAO(0, 0), A, brow, t + 2);
    BAR; WAIT_L(0); MMA(1, 0, At, B0); BAR; SCHED;
    STAGE(SBO(0, 1), Bt, bcol + HALF, t + 2);
    WAIT_V(6); BAR; MMA(1, 1, At, B1); BAR;
    LDB(B0, 1, 0); SCHED; LDA(At, 1, 0); STAGE(SAO(0, 1), A, brow + HALF, t + 2);
    WAIT_L(8); BAR; WAIT_L(0); MMA(0, 0, At, B0); BAR; SCHED;
    LDB(B1, 1, 1); STAGE(SBO(1, 0), Bt, bcol, t + 3);
    BAR; WAIT_L(0); MMA(0, 1, At, B1); BAR;
    LDA(At, 1, 1); STAGE(SAO(1, 0), A, brow, t + 3);
    BAR; WAIT_L(0); MMA(1, 0, At, B0); BAR; SCHED;
    STAGE(SBO(1, 1), Bt, bcol + HALF, t + 3);
    WAIT_V(6); BAR; MMA(1, 1, At, B1); BAR;
  }
  {
    LDB(B0, 0, 0); LDA(At, 0, 0); STAGE(SAO(1, 1), A, brow + HALF, nt - 1);
    BAR; WAIT_L(0); MMA(0, 0, At, B0); BAR;
    LDB(B1, 0, 1); BAR; WAIT_L(0); MMA(0, 1, At, B1); BAR;
    LDA(At, 0, 1); WAIT_V(4); BAR; WAIT_L(0); MMA(1, 0, At, B0); MMA(1, 1, At, B1); BAR;
  }
  {
    LDB(B0, 1, 0); LDA(At, 1, 0); WAIT_V(2); BAR; WAIT_L(0); MMA(0, 0, At, B0); BAR;
    LDB(B1, 1, 1); WAIT_V(0); BAR; WAIT_L(0); MMA(0, 1, At, B1); BAR;
    LDA(At, 1, 1); BAR; WAIT_L(0); MMA(1, 0, At, B0); MMA(1, 1, At, B1); BAR;
  }
  if (wr == 0) BAR;
}
#define EPI_IDX const int tide = otid(), wid = tide >> 6, lane = tide & 63, wr = wid >> 2, wc = wid & 3, fr = lane & 15, fq = lane >> 4;
#define EPI_LOOP                                                                     \
  _Pragma("unroll") for (int ai = 0; ai < 2; ++ai) _Pragma("unroll") for (int bj = 0; bj < 2; ++bj) \
      _Pragma("unroll") for (int m = 0; m < 4; ++m) _Pragma("unroll") for (int n = 0; n < 2; ++n)

__device__ __forceinline__ void mlstm_scalars(const Params& p, int l, int bh, char* smem) {
  const int tid = otid(), lane = tid & 63, wid = tid >> 6;
  float* sred = (float*)smem;
  const float* GATE = (const float*)(p.ws + W_GATE);
  const int b = bh >> 2, h = bh & 3;
  float itv[4], c[4];
#pragma unroll
  for (int r = 0; r < 4; ++r) {
    size_t row = (size_t)b * SEQ + tid * 4 + r;
    itv[r] = GATE[row * 8 + h];
    c[r] = logsig(GATE[row * 8 + 4 + h]);
  }
  c[1] += c[0]; c[2] += c[1]; c[3] += c[2];
  float inc = c[3];
#pragma unroll
  for (int o = 1; o < 64; o <<= 1) { float t = SHU(inc, o); if (lane >= o) inc += t; }
  if (lane == 63) sred[wid] = inc;
  __syncthreads();
  float base = 0.f;
  for (int w = 0; w < wid; ++w) base += sred[w];
  __syncthreads();
  const float excl = base + inc - c[3];
  float g[4], mx[4];
#pragma unroll
  for (int r = 0; r < 4; ++r) { c[r] += excl; g[r] = itv[r] - c[r]; }
  mx[0] = g[0]; mx[1] = fmaxf(mx[0], g[1]); mx[2] = fmaxf(mx[1], g[2]); mx[3] = fmaxf(mx[2], g[3]);
  float minc = mx[3];
#pragma unroll
  for (int o = 1; o < 64; o <<= 1) { float t = SHU(minc, o); if (lane >= o) minc = fmaxf(minc, t); }
  if (lane == 63) sred[wid] = minc;
  __syncthreads();
  float mb = 0.f;
  for (int w = 0; w < wid; ++w) mb = fmaxf(mb, sred[w]);
  float prev = SHU(minc, 1);
  if (lane > 0) mb = fmaxf(mb, prev);
  __syncthreads();
  float* G = (float*)(p.ws + W_G) + (size_t)bh * SEQ;
  float* MX = (float*)(p.ws + W_MX) + (size_t)bh * SEQ;
  float* EM = (float*)(p.ws + W_EM) + (size_t)bh * SEQ;
  float4 og, om, oe;
  float mxv[4], mv[4];
#pragma unroll
  for (int r = 0; r < 4; ++r) { mxv[r] = fmaxf(mb, mx[r]); mv[r] = c[r] + mxv[r]; }
  og = float4{g[0], g[1], g[2], g[3]};
  om = float4{mxv[0], mxv[1], mxv[2], mxv[3]};
  oe = float4{__expf(-mv[0]), __expf(-mv[1]), __expf(-mv[2]), __expf(-mv[3])};
  ((float4*)G)[tid] = og; ((float4*)MX)[tid] = om; ((float4*)EM)[tid] = oe;
  if (tid == 511) p.out[O_MP + (size_t)l * 32 + bh] = mv[3];
}

__device__ __forceinline__ void mlstm_flash(const Params& p, int l, int bh, int qi, char* smem) {
  const int tid = otid(), lane = tid & 63, wid = tid >> 6, fr = lane & 15, fq = lane >> 4, wr = wid >> 1, wc = wid & 1;
  const int b = bh >> 2, h = bh & 3;
  char* sKb = smem;
  char* sVb = smem + 65536;
  bf16_t* sP = (bf16_t*)(smem + 131072);
  float* sRed = (float*)(smem + 131072);
  const bf16_t* P = (const bf16_t*)(p.ws + W_P);
  const float* G = (const float*)(p.ws + W_G) + (size_t)bh * SEQ;
  const float* MX = (const float*)(p.ws + W_MX) + (size_t)bh * SEQ;
  const float* EM = (const float*)(p.ws + W_EM) + (size_t)bh * SEQ;
  const size_t rowbase = (size_t)b * SEQ;
  const int nblk = 2 * qi + 2;
#define FL_ISSUE(jb)                                                                                              \
  do {                                                                                                            \
    const int buf_ = (jb) & 1;                                                                                    \
    const bf16_t* rp0_ = P + (rowbase + (size_t)(jb) * 64) * NPJ + h * 256;                                       \
    _Pragma("unroll") for (int i_ = 0; i_ < 4; ++i_) {                                                            \
      const int r_ = (wid * 4 + i_) * 2 + (lane >> 5), cs_ = lane & 31;                                           \
      const int ck_ = cs_ ^ (r_ & 31), cv_ = cs_ ^ (((r_ & 3) << 1) | (r_ & 8));                                  \
      __builtin_amdgcn_global_load_lds((const unsigned*)(rp0_ + (size_t)r_ * NPJ + C_K + ck_ * 8),                \
                                       (unsigned*)(sKb + buf_ * 32768 + (wid * 4 + i_) * 1024 + lane * 16), 16, 0, 0); \
      __builtin_amdgcn_global_load_lds((const unsigned*)(rp0_ + (size_t)r_ * NPJ + C_V + cv_ * 8),                \
                                       (unsigned*)(sVb + buf_ * 32768 + (wid * 4 + i_) * 1024 + lane * 16), 16, 0, 0); \
    }                                                                                                             \
  } while (0)
  FL_ISSUE(0);
  bf16x8 qf[2][8];
  float mxr[2];
#pragma unroll
  for (int m = 0; m < 2; ++m) {
    const int t = qi * 128 + wr * 32 + m * 16 + fr;
    const bf16_t* qp = P + (rowbase + t) * NPJ + C_Q + h * 256 + fq * 8;
#pragma unroll
    for (int kk = 0; kk < 8; ++kk) qf[m][kk] = *(const bf16x8*)(qp + kk * 32);
    mxr[m] = MX[t];
  }
  f32x4 oacc[2][8];
#pragma unroll
  for (int m = 0; m < 2; ++m)
#pragma unroll
    for (int n = 0; n < 8; ++n) oacc[m][n] = f32x4{0.f, 0.f, 0.f, 0.f};
  float den[2] = {0.f, 0.f};
#pragma unroll 1
  for (int j = 0; j < nblk; ++j) {
    asm volatile("s_waitcnt vmcnt(0)" ::: "memory");
    __syncthreads();
    if (j + 1 < nblk) FL_ISSUE(j + 1);
    const char* sK = sKb + (j & 1) * 32768;
    const char* sV = sVb + (j & 1) * 32768;
    f32x4 sacc[2][2];
#pragma unroll
    for (int m = 0; m < 2; ++m)
#pragma unroll
      for (int n = 0; n < 2; ++n) sacc[m][n] = f32x4{0.f, 0.f, 0.f, 0.f};
#pragma unroll
    for (int kk = 0; kk < 8; ++kk)
#pragma unroll
      for (int n = 0; n < 2; ++n) {
        const int row = wc * 32 + n * 16 + fr, c = kk * 4 + fq;
        bf16x8 kf = *(const bf16x8*)(sK + row * 512 + ((c ^ (row & 31)) << 4));
        sacc[0][n] = mfma16(kf, qf[0][kk], sacc[0][n]);
        sacc[1][n] = mfma16(kf, qf[1][kk], sacc[1][n]);
      }
#pragma unroll
    for (int n = 0; n < 2; ++n) {
      const int s0 = j * 64 + wc * 32 + n * 16 + fq * 4;
      const float4 g4 = *(const float4*)(G + s0);
      const float gs[4] = {g4.x, g4.y, g4.z, g4.w};
#pragma unroll
      for (int m = 0; m < 2; ++m) {
        const int t = qi * 128 + wr * 32 + m * 16 + fr;
        float v[4];
#pragma unroll
        for (int r = 0; r < 4; ++r) {
          float w = (s0 + r <= t) ? __expf(gs[r] - mxr[m]) : 0.f;
          v[r] = sacc[m][n][r] * 0.0625f * w;
          den[m] += v[r];
        }
        uint2 pk; pk.x = pk2(v[0], v[1]); pk.y = pk2(v[2], v[3]);
        *(uint2*)(sP + (wr * 32 + m * 16 + fr) * 72 + wc * 32 + n * 16 + fq * 4) = pk;
      }
    }
    __syncthreads();
#pragma unroll
    for (int kk = 0; kk < 2; ++kk) {
      bf16x8 pf0 = *(const bf16x8*)(sP + (wr * 32 + fr) * 72 + kk * 32 + fq * 8);
      bf16x8 pf1 = *(const bf16x8*)(sP + (wr * 32 + 16 + fr) * 72 + kk * 32 + fq * 8);
      const int srow = kk * 32 + fq * 8 + (fr >> 2);
      const int swz = ((srow & 3) << 1) | (srow & 8);
#pragma unroll
      for (int n2 = 0; n2 < 8; ++n2) {
        const int ch = ((wc * 128 + n2 * 16) >> 3) + ((fr & 3) >> 1);
        const char* va = sV + srow * 512 + ((ch ^ swz) << 4) + (fr & 1) * 8;
        s16x4 a = __builtin_amdgcn_ds_read_tr16_b64_v4i16((LDSP(s16x4))va);
        s16x4 bq = __builtin_amdgcn_ds_read_tr16_b64_v4i16((LDSP(s16x4))(va + 4 * 512));
        bf16x8 vf = {a[0], a[1], a[2], a[3], bq[0], bq[1], bq[2], bq[3]};
        oacc[0][n2] = mfma16(vf, pf0, oacc[0][n2]);
        oacc[1][n2] = mfma16(vf, pf1, oacc[1][n2]);
      }
    }
  }
  __syncthreads();
#undef FL_ISSUE
  float dn[2];
#pragma unroll
  for (int m = 0; m < 2; ++m) {
    float v = den[m];
    v += SHX(v, 16); v += SHX(v, 32);
    if (fq == 0) sRed[wc * 128 + wr * 32 + m * 16 + fr] = v;
  }
  __syncthreads();
#pragma unroll
  for (int m = 0; m < 2; ++m) {
    const int tl = wr * 32 + m * 16 + fr;
    float d = sRed[tl] + sRed[128 + tl];
    dn[m] = 1.f / fmaxf(fabsf(d), EM[qi * 128 + tl]);
  }
  float s1[2] = {0.f, 0.f}, s2[2] = {0.f, 0.f};
#pragma unroll
  for (int m = 0; m < 2; ++m) {
    const size_t row = rowbase + qi * 128 + wr * 32 + m * 16 + fr;
#pragma unroll
    for (int n2 = 0; n2 < 8; ++n2) {
      const int col = h * 256 + wc * 128 + n2 * 16 + fq * 4;
      const uint2 ov = *(const uint2*)(P + row * NPJ + C_O + col);
      const float o[4] = {bflo(ov.x), bfhi(ov.x), bflo(ov.y), bfhi(ov.y)};
#pragma unroll
      for (int r = 0; r < 4; ++r) {
        float hv = oacc[m][n2][r] * dn[m] * sigm(o[r]);
        oacc[m][n2][r] = hv;
        s1[m] += hv; s2[m] += hv * hv;
      }
    }
  }
#pragma unroll
  for (int m = 0; m < 2; ++m) {
    float a = s1[m], q = s2[m];
    a += SHX(a, 16); a += SHX(a, 32);
    q += SHX(q, 16); q += SHX(q, 32);
    if (fq == 0) { sRed[256 + wc * 128 + wr * 32 + m * 16 + fr] = a; sRed[512 + wc * 128 + wr * 32 + m * 16 + fr] = q; }
  }
  __syncthreads();
  bf16_t* Y0 = (bf16_t*)(p.ws + W_Y);
  const float* ng = p.in[I_NORMG] + (size_t)l * D;
#pragma unroll
  for (int m = 0; m < 2; ++m) {
    const int tl = wr * 32 + m * 16 + fr;
    const float mean = (sRed[256 + tl] + sRed[256 + 128 + tl]) * (1.f / 256.f);
    const float var = (sRed[512 + tl] + sRed[512 + 128 + tl]) * (1.f / 256.f) - mean * mean;
    const float rstd = rsqrtf(fmaxf(var, 0.f) + EPS);
    const size_t row = rowbase + qi * 128 + tl;
#pragma unroll
    for (int n2 = 0; n2 < 8; ++n2) {
      const int col = h * 256 + wc * 128 + n2 * 16 + fq * 4;
      const uint2 zv = *(const uint2*)(P + row * NPJ + C_ZA + col);
      const float4 g4 = *(const float4*)(ng + col);
      const float z[4] = {bflo(zv.x), bfhi(zv.x), bflo(zv.y), bfhi(zv.y)};
      const float gg[4] = {g4.x, g4.y, g4.z, g4.w};
      float y[4];
#pragma unroll
      for (int r = 0; r < 4; ++r) y[r] = (oacc[m][n2][r] - mean) * rstd * gg[r] * silu(z[r]);
      uint2 o; o.x = pk2(y[0], y[1]); o.y = pk2(y[2], y[3]);
      *(uint2*)(Y0 + row * D + col) = o;
    }
  }
  __syncthreads();
}

__device__ __forceinline__ void mlstm_final(const Params& p, int l, int bh, int dq, char* smem) {
  const int tid = otid(), lane = tid & 63, wid = tid >> 6, fr = lane & 15, fq = lane >> 4, wr = wid >> 2, wc = wid & 3;
  const int b = bh >> 2, h = bh & 3;
  char* sVb = smem;
  char* sKb = smem + 98304;
  float* sWall = (float*)(smem + 122880);
  float* sW = (float*)(smem + 131072);
  const bf16_t* P = (const bf16_t*)(p.ws + W_P);
  const float* G = (const float*)(p.ws + W_G) + (size_t)bh * SEQ;
  const float mxl = ((const float*)(p.ws + W_MX))[(size_t)bh * SEQ + SEQ - 1];
  const size_t rowbase = (size_t)b * SEQ;
  {
    const float4 g4 = ((const float4*)G)[tid];
    float4 w4 = {__expf(g4.x - mxl) * 0.0625f, __expf(g4.y - mxl) * 0.0625f, __expf(g4.z - mxl) * 0.0625f, __expf(g4.w - mxl) * 0.0625f};
    ((float4*)sWall)[tid] = w4;
  }
#define FN_ISSUE(jb)                                                                                                  \
  do {                                                                                                                \
    const int buf_ = (jb) % 3;                                                                                        \
    const bf16_t* rp0_ = P + (rowbase + (size_t)(jb) * 64) * NPJ + h * 256;                                           \
    _Pragma("unroll") for (int i_ = 0; i_ < 4; ++i_) {                                                                \
      const int r_ = (wid * 4 + i_) * 2 + (lane >> 5), cs_ = lane & 31;                                               \
      const int cv_ = cs_ ^ (((r_ & 3) << 1) | (r_ & 8));                                                             \
      __builtin_amdgcn_global_load_lds((const unsigned*)(rp0_ + (size_t)r_ * NPJ + C_V + cv_ * 8),                    \
                                       (unsigned*)(sVb + buf_ * 32768 + (wid * 4 + i_) * 1024 + lane * 16), 16, 0, 0); \
    }                                                                                                                 \
    {                                                                                                                 \
      const int r_ = wid * 8 + (lane >> 3), cs_ = lane & 7;                                                           \
      const int ck_ = cs_ ^ ((r_ & 3) << 1);                                                                          \
      __builtin_amdgcn_global_load_lds((const unsigned*)(rp0_ + (size_t)r_ * NPJ + C_K + dq * 64 + ck_ * 8),          \
                                       (unsigned*)(sKb + buf_ * 8192 + wid * 1024 + lane * 16), 16, 0, 0);            \
    }                                                                                                                 \
  } while (0)
  asm volatile("s_waitcnt vmcnt(0)" ::: "memory");
  FN_ISSUE(0);
  FN_ISSUE(1);
  f32x4 acc[2][4];
#pragma unroll
  for (int m = 0; m < 2; ++m)
#pragma unroll
    for (int n = 0; n < 4; ++n) acc[m][n] = f32x4{0.f, 0.f, 0.f, 0.f};
  float nacc = 0.f;
#pragma unroll 1
  for (int j = 0; j < 32; ++j) {
    if (j + 1 < 32) asm volatile("s_waitcnt vmcnt(5)" ::: "memory");
    else asm volatile("s_waitcnt vmcnt(0)" ::: "memory");
    __syncthreads();
    if (j + 2 < 32) FN_ISSUE(j + 2);
    const char* sV = sVb + (j % 3) * 32768;
    const char* sK = sKb + (j % 3) * 8192;
#pragma unroll
    for (int kk = 0; kk < 2; ++kk) {
      const int srow = kk * 32 + fq * 8 + (fr >> 2);
      const float4 wa = *(const float4*)(sWall + j * 64 + kk * 32 + fq * 8);
      const float4 wb = *(const float4*)(sWall + j * 64 + kk * 32 + fq * 8 + 4);
      bf16x8 kf[2];
#pragma unroll
      for (int m = 0; m < 2; ++m) {
        const int d0 = wr * 32 + m * 16 + (fr & 3) * 4;
        const char* ka = sK + srow * 128 + ((((d0 >> 3) ^ ((srow & 3) << 1)) & 7) << 4) + ((d0 >> 2) & 1) * 8;
        s16x4 a = __builtin_amdgcn_ds_read_tr16_b64_v4i16((LDSP(s16x4))ka);
        s16x4 bq = __builtin_amdgcn_ds_read_tr16_b64_v4i16((LDSP(s16x4))(ka + 4 * 128));
        const unsigned u0 = pk2(bf2f((bf16_t)a[0]) * wa.x, bf2f((bf16_t)a[1]) * wa.y);
        const unsigned u1 = pk2(bf2f((bf16_t)a[2]) * wa.z, bf2f((bf16_t)a[3]) * wa.w);
        const unsigned u2 = pk2(bf2f((bf16_t)bq[0]) * wb.x, bf2f((bf16_t)bq[1]) * wb.y);
        const unsigned u3 = pk2(bf2f((bf16_t)bq[2]) * wb.z, bf2f((bf16_t)bq[3]) * wb.w);
        kf[m] = bf16x8{(short)(u0 & 0xffff), (short)(u0 >> 16), (short)(u1 & 0xffff), (short)(u1 >> 16),
                       (short)(u2 & 0xffff), (short)(u2 >> 16), (short)(u3 & 0xffff), (short)(u3 >> 16)};
      }
      const int swz = ((srow & 3) << 1) | (srow & 8);
#pragma unroll
      for (int n = 0; n < 4; ++n) {
        const int ch = ((wc * 64 + n * 16) >> 3) + ((fr & 3) >> 1);
        const char* va = sV + srow * 512 + ((ch ^ swz) << 4) + (fr & 1) * 8;
        s16x4 a = __builtin_amdgcn_ds_read_tr16_b64_v4i16((LDSP(s16x4))va);
        s16x4 bq = __builtin_amdgcn_ds_read_tr16_b64_v4i16((LDSP(s16x4))(va + 4 * 512));
        bf16x8 vf = {a[0], a[1], a[2], a[3], bq[0], bq[1], bq[2], bq[3]};
        acc[0][n] = mfma16(vf, kf[0], acc[0][n]);
        acc[1][n] = mfma16(vf, kf[1], acc[1][n]);
      }
    }
    {
      float a = 0.f;
#pragma unroll
      for (int s8 = 0; s8 < 8; ++s8) {
        const int srow = wid * 8 + s8;
        const bf16_t kv = *(const bf16_t*)(sK + srow * 128 + ((((lane >> 3) ^ ((srow & 3) << 1)) & 7) << 4) + (lane & 7) * 2);
        a += bf2f(kv) * sWall[j * 64 + srow];
      }
      nacc += a;
    }
  }
  __syncthreads();
#undef FN_ISSUE
  float* oc = p.out + O_CP + ((size_t)l * 32 + bh) * 65536;
#pragma unroll
  for (int m = 0; m < 2; ++m)
#pragma unroll
    for (int n = 0; n < 4; ++n) {
      const int d = dq * 64 + wr * 32 + m * 16 + fr, e = wc * 64 + n * 16 + fq * 4;
      *(float4*)(oc + (size_t)d * 256 + e) = float4{acc[m][n][0], acc[m][n][1], acc[m][n][2], acc[m][n][3]};
    }
  sW[tid] = nacc;
  __syncthreads();
  if (tid < 64) {
    float a = 0.f;
#pragma unroll
    for (int w8 = 0; w8 < 8; ++w8) a += sW[w8 * 64 + tid];
    p.out[O_NP + ((size_t)l * 32 + bh) * 256 + dq * 64 + tid] = a;
  }
  __syncthreads();
}

__device__ __forceinline__ void mlstm_sample(const Params& p, int l, int b, int h, char* smem) {
  const int tid = otid(), lane = tid & 63, wid = tid >> 6;
  float* sq = (float*)smem;
  float* sk = sq + 1024;
  float* sv = sk + 1024;
  float* sn0 = sv + 1024;
  float* sqk = sn0 + 256;
  float* ssc = sqk + 32;
  float* sst = ssc + 32;
  float* snum = sst + 32;
  const bf16_t* P = (const bf16_t*)(p.ws + W_P);
  const float* GATE = (const float*)(p.ws + W_GATE);
  const size_t R0 = (size_t)NPR + b * 4;
  const size_t sidx = ((size_t)l * 128 + b) * 4 + h;
#pragma unroll
  for (int i = 0; i < 6; ++i) {
    int idx = tid + 512 * i, which = idx >> 10, t = (idx >> 8) & 3, d = idx & 255;
    sq[idx] = bf2f(P[(R0 + t) * NPJ + which * 1024 + h * 256 + d]);
  }
  if (tid < 256) sn0[tid] = p.in[I_SN][sidx * 256 + tid];
  const float m0 = p.in[I_SM][sidx];
  float g[4], cm[4], mm[4];
  {
    float bc = 0.f, run = m0;
#pragma unroll
    for (int t = 0; t < 4; ++t) {
      float itv = GATE[(R0 + t) * 8 + h];
      bc += logsig(GATE[(R0 + t) * 8 + 4 + h]);
      g[t] = itv - bc;
      run = fmaxf(run, g[t]);
      cm[t] = run;
      mm[t] = bc + run;
    }
  }
  __syncthreads();
  {
    const int pp = tid >> 5, li = tid & 31, t = pp >> 2, s = pp & 3;
    float part = 0.f;
#pragma unroll
    for (int d8 = 0; d8 < 8; ++d8) part += sq[t * 256 + li * 8 + d8] * sk[s * 256 + li * 8 + d8];
#pragma unroll
    for (int o = 16; o >= 1; o >>= 1) part += SHX(part, o);
    if (li == 0) sqk[pp] = part * 0.0625f;
    float part2 = 0.f;
    const int t2 = pp & 3;
#pragma unroll
    for (int d8 = 0; d8 < 8; ++d8) part2 += sq[t2 * 256 + li * 8 + d8] * sn0[li * 8 + d8];
#pragma unroll
    for (int o = 16; o >= 1; o >>= 1) part2 += SHX(part2, o);
    if (li == 0 && pp < 4) sqk[16 + pp] = part2;
  }
  __syncthreads();
  float w[4];
#pragma unroll
  for (int s = 0; s < 4; ++s) w[s] = __expf(g[s] - cm[3]) * 0.0625f;
  const float decay = __expf(m0 - cm[3]);
  if (tid == 0) {
#pragma unroll
    for (int t = 0; t < 4; ++t) {
      const float inter = __expf(m0 - cm[t]);
      float dsum = inter * sqk[16 + t];
#pragma unroll
      for (int s = 0; s < 4; ++s) {
        float st = (s <= t) ? sqk[t * 4 + s] * __expf(g[s] - cm[t]) : 0.f;
        ssc[t * 4 + s] = st;
        dsum += st;
      }
      ssc[16 + t] = inter;
      ssc[20 + t] = 1.f / fmaxf(fabsf(dsum), __expf(-mm[t]));
    }
  }
#pragma unroll
  for (int i = 0; i < 2; ++i) {
    int idx = tid + 512 * i;
    sk[idx] *= w[idx >> 8];
  }
  __syncthreads();
  {
    const int e4 = lane * 4, d0 = wid * 32;
    float4 vv[4], np[4];
#pragma unroll
    for (int s = 0; s < 4; ++s) { vv[s] = *(const float4*)(sv + s * 256 + e4); np[s] = float4{0.f, 0.f, 0.f, 0.f}; }
    const float* c0p = p.in[I_SC] + sidx * 65536;
    float* cop = p.out + O_CS + sidx * 65536;
#pragma unroll 1
    for (int dd = 0; dd < 32; dd += 8) {
      float4 c[8];
#pragma unroll
      for (int u = 0; u < 8; ++u) c[u] = *(const float4*)(c0p + (size_t)(d0 + dd + u) * 256 + e4);
#pragma unroll
      for (int u = 0; u < 8; ++u) {
        const int d = d0 + dd + u;
        float4 cn = {decay * c[u].x, decay * c[u].y, decay * c[u].z, decay * c[u].w};
#pragma unroll
        for (int t = 0; t < 4; ++t) {
          const float qv = sq[t * 256 + d], kv = sk[t * 256 + d];
          np[t].x += qv * c[u].x; np[t].y += qv * c[u].y; np[t].z += qv * c[u].z; np[t].w += qv * c[u].w;
          cn.x += kv * vv[t].x; cn.y += kv * vv[t].y; cn.z += kv * vv[t].z; cn.w += kv * vv[t].w;
        }
        *(float4*)(cop + (size_t)d * 256 + e4) = cn;
      }
    }
#pragma unroll
    for (int t = 0; t < 4; ++t) *(float4*)(snum + (wid * 4 + t) * 256 + e4) = np[t];
  }
  __syncthreads();
  {
    const int t = tid >> 7, e2 = (tid & 127) * 2;
    float hv[2];
    const unsigned ov = *(const unsigned*)(P + (R0 + t) * NPJ + C_O + h * 256 + e2);
    const float o2[2] = {bflo(ov), bfhi(ov)};
    const float inter = ssc[16 + t], dnm = ssc[20 + t];
#pragma unroll
    for (int k = 0; k < 2; ++k) {
      const int e = e2 + k;
      float a = 0.f;
#pragma unroll
      for (int w8 = 0; w8 < 8; ++w8) a += snum[(w8 * 4 + t) * 256 + e];
      float x = inter * a;
#pragma unroll
      for (int s = 0; s < 4; ++s) x += ssc[t * 4 + s] * sv[s * 256 + e];
      hv[k] = x * dnm * sigm(o2[k]);
    }
    float a1 = wave_sum(hv[0] + hv[1]), a2 = wave_sum(hv[0] * hv[0] + hv[1] * hv[1]);
    if (lane == 0) { sst[wid * 2] = a1; sst[wid * 2 + 1] = a2; }
    __syncthreads();
    const float mean = (sst[(2 * t) * 2] + sst[(2 * t + 1) * 2]) * (1.f / 256.f);
    const float var = (sst[(2 * t) * 2 + 1] + sst[(2 * t + 1) * 2 + 1]) * (1.f / 256.f) - mean * mean;
    const float rstd = rsqrtf(fmaxf(var, 0.f) + EPS);
    const unsigned zv = *(const unsigned*)(P + (R0 + t) * NPJ + C_ZA + h * 256 + e2);
    const float* ng = p.in[I_NORMG] + (size_t)l * D + h * 256 + e2;
    float y0 = (hv[0] - mean) * rstd * ng[0] * silu(bflo(zv));
    float y1 = (hv[1] - mean) * rstd * ng[1] * silu(bfhi(zv));
    __hip_atomic_store((unsigned*)((bf16_t*)(p.ws + W_Y) + (R0 + t) * D + h * 256 + e2), pk2(y0, y1), __ATOMIC_RELAXED,
                       __HIP_MEMORY_SCOPE_AGENT);
  }
  if (tid < 256) {
    float nn = decay * sn0[tid];
#pragma unroll
    for (int s = 0; s < 4; ++s) nn += sk[s * 256 + tid];
    p.out[O_NS + sidx * 256 + tid] = nn;
  }
  if (tid == 0) p.out[O_MS + sidx] = mm[3];
  __syncthreads();
}

__device__ __forceinline__ void gmlp_prompt(const Params& p, int l, int b, int chunk, int g, char* smem) {
  const int tid = otid(), lane = tid & 63, wid = tid >> 6, fr = lane & 15, fq = lane >> 4, wr = wid >> 2, wc = wid & 3;
  bf16_t* sVn = (bf16_t*)smem;
  bf16_t* sW = (bf16_t*)(smem + 69632);
  float* sMu = (float*)(smem + 69632 + 34816);
  float* sRs = sMu + 128;
  const bf16_t* P = (const bf16_t*)(p.ws + W_P);
  const size_t R0 = (size_t)b * SEQ + chunk * 128;
  if (tid < 128) {
    const float2* st = (const float2*)(p.ws + W_ST) + R0 + tid;
    float a = 0.f, q = 0.f;
#pragma unroll
    for (int k = 0; k < 16; ++k) { const float2 v = st[(size_t)k * NPR]; a += v.x; q += v.y; }
    const float mean = a * (1.f / D);
    sMu[tid] = mean;
    sRs[tid] = rsqrtf(fmaxf(q * (1.f / D) - mean * mean, 0.f) + EPS);
  }
  __syncthreads();
  const float* lg = p.in[I_GLNG] + (size_t)l * D + g * 256;
  const float* lb = p.in[I_GLNB] + (size_t)l * D + g * 256;
#pragma unroll
  for (int i = 0; i < 8; ++i) {
    int c = tid + 512 * i, r = c >> 5, c8 = c & 31;
    float f[8];
    unpack8(*(const uint4*)(P + (R0 + r) * NPJ + C_VB + g * 256 + c8 * 8), f);
    const float mu = sMu[r], rs = sRs[r];
    const float4 g0 = *(const float4*)(lg + c8 * 8), g1 = *(const float4*)(lg + c8 * 8 + 4);
    const float4 b0 = *(const float4*)(lb + c8 * 8), b1 = *(const float4*)(lb + c8 * 8 + 4);
    f[0] = (f[0] - mu) * rs * g0.x + b0.x; f[1] = (f[1] - mu) * rs * g0.y + b0.y;
    f[2] = (f[2] - mu) * rs * g0.z + b0.z; f[3] = (f[3] - mu) * rs * g0.w + b0.w;
    f[4] = (f[4] - mu) * rs * g1.x + b1.x; f[5] = (f[5] - mu) * rs * g1.y + b1.y;
    f[6] = (f[6] - mu) * rs * g1.z + b1.z; f[7] = (f[7] - mu) * rs * g1.w + b1.w;
    *(uint4*)(sVn + r * 272 + c8 * 8) = pack8(f);
  }
  const bf16_t* wm = (const bf16_t*)(p.ws + W_WM) + (size_t)(l * 4 + g) * 16384;
#pragma unroll
  for (int i = 0; i < 4; ++i) {
    int c = tid + 512 * i, r = c >> 4, c8 = c & 15;
    *(uint4*)(sW + r * 136 + c8 * 8) = *(const uint4*)(wm + r * 128 + c8 * 8);
  }
  __syncthreads();
  f32x4 acc[4][4];
#pragma unroll
  for (int m = 0; m < 4; ++m)
#pragma unroll
    for (int n = 0; n < 4; ++n) acc[m][n] = f32x4{0.f, 0.f, 0.f, 0.f};
#pragma unroll
  for (int kk = 0; kk < 4; ++kk) {
    bf16x8 tf[4];
#pragma unroll
    for (int m = 0; m < 4; ++m) tf[m] = *(const bf16x8*)(sW + (wr * 64 + m * 16 + fr) * 136 + kk * 32 + fq * 8);
#pragma unroll
    for (int n = 0; n < 4; ++n) {
      bf16x8 cf = frag_t(sVn, 272, wc * 64 + n * 16, kk * 32, lane);
#pragma unroll
      for (int m = 0; m < 4; ++m) acc[m][n] = mfma16(cf, tf[m], acc[m][n]);
    }
  }
  bf16_t* Y1 = (bf16_t*)(p.ws + W_Y) + (size_t)MT * D;
  const float* bs = p.in[I_GBS] + (size_t)(l * 4 + g) * 128;
#pragma unroll
  for (int m = 0; m < 4; ++m) {
    const int t = wr * 64 + m * 16 + fr;
    const float bsv = bs[t];
    const size_t row = R0 + t;
#pragma unroll
    for (int n = 0; n < 4; ++n) {
      const int col = g * 256 + wc * 64 + n * 16 + fq * 4;
      const uint2 uv = *(const uint2*)(P + row * NPJ + C_UB + col);
      const uint2 zv = *(const uint2*)(P + row * NPJ + C_ZB + col);
      const float u[4] = {bflo(uv.x), bfhi(uv.x), bflo(uv.y), bfhi(uv.y)};
      const float z[4] = {bflo(zv.x), bfhi(zv.x), bflo(zv.y), bfhi(zv.y)};
      float y[4];
#pragma unroll
      for (int r = 0; r < 4; ++r) y[r] = u[r] * (acc[m][n][r] + bsv) * silu(z[r]);
      uint2 o; o.x = pk2(y[0], y[1]); o.y = pk2(y[2], y[3]);
      *(uint2*)(Y1 + row * D + col) = o;
    }
  }
  __syncthreads();
}

__device__ __forceinline__ void gmlp_sample(const Params& p, int l, int b, char* smem) {
  const int tid = otid(), lane = tid & 63, wid = tid >> 6;
  float* svn = (float*)smem;
  const bf16_t* P = (const bf16_t*)(p.ws + W_P);
  const size_t R0 = (size_t)NPR + b * 4;
  if (wid < 4) {
    const int t = wid;
    const bf16_t* rp = P + (R0 + t) * NPJ + C_VB;
    float f[16];
    unpack8(*(const uint4*)(rp + lane * 8), f);
    unpack8(*(const uint4*)(rp + 512 + lane * 8), f + 8);
    float a = 0.f;
#pragma unroll
    for (int e = 0; e < 16; ++e) a += f[e];
    const float mean = wave_sum(a) * (1.f / D);
    float q = 0.f;
#pragma unroll
    for (int e = 0; e < 16; ++e) { f[e] -= mean; q += f[e] * f[e]; }
    const float rs = rsqrtf(wave_sum(q) * (1.f / D) + EPS);
    const float* lg = p.in[I_GLNG] + (size_t)l * D;
    const float* lb = p.in[I_GLNB] + (size_t)l * D;
    float* ov = p.out + O_VS + (((size_t)l * 128 + b) * 4 + t) * D;
#pragma unroll
    for (int hh = 0; hh < 2; ++hh) {
      const int c0 = hh * 512 + lane * 8;
#pragma unroll
      for (int e = 0; e < 8; ++e) f[hh * 8 + e] = f[hh * 8 + e] * rs * lg[c0 + e] + lb[c0 + e];
      *(float4*)(svn + t * 1024 + c0) = float4{f[hh * 8], f[hh * 8 + 1], f[hh * 8 + 2], f[hh * 8 + 3]};
      *(float4*)(svn + t * 1024 + c0 + 4) = float4{f[hh * 8 + 4], f[hh * 8 + 5], f[hh * 8 + 6], f[hh * 8 + 7]};
      *(float4*)(ov + c0) = float4{f[hh * 8], f[hh * 8 + 1], f[hh * 8 + 2], f[hh * 8 + 3]};
      *(float4*)(ov + c0 + 4) = float4{f[hh * 8 + 4], f[hh * 8 + 5], f[hh * 8 + 6], f[hh * 8 + 7]};
    }
  }
  __syncthreads();
  bf16_t* Y1 = (bf16_t*)(p.ws + W_Y) + (size_t)MT * D;
#pragma unroll
  for (int i = 0; i < 8; ++i) {
    const int idx = tid + 512 * i, t = idx >> 10, c = idx & 1023, g = c >> 8;
    const float* wrow = p.in[I_GWS] + ((size_t)(l * 4 + g) * 128 + t) * 128;
    float mixed = p.in[I_GBS][(size_t)(l * 4 + g) * 128 + t];
#pragma unroll
    for (int s = 0; s < 4; ++s)
      if (s <= t) mixed += wrow[s] * svn[s * 1024 + c];
    const float u = bf2f(P[(R0 + t) * NPJ + C_UB + c]), z = bf2f(P[(R0 + t) * NPJ + C_ZB + c]);
    __hip_atomic_store(Y1 + (R0 + t) * D + c, f2bf(u * mixed * silu(z)), __ATOMIC_RELAXED, __HIP_MEMORY_SCOPE_AGENT);
  }
  __syncthreads();
}

__device__ __forceinline__ void lru_gemm_pass(const Params& p, int l, int mat, int cp, const bf16_t* sX, bf16_t* sWt,
                                              f32x4 (&acc)[8][2]) {
  const int tid = otid(), lane = tid & 63, wid = tid >> 6, fr = lane & 15, fq = lane >> 4;
  const bf16_t* src = (const bf16_t*)(p.ws + W_WTL) + (size_t)((l * 2 + mat) * 8 + cp * 2) * 16384;
  __syncthreads();
#pragma unroll
  for (int i = 0; i < 8; ++i) {
    int c = tid + 512 * i, r = c >> 4, c8 = c & 15;
    *(uint4*)(sWt + r * 136 + c8 * 8) = *(const uint4*)(src + r * 128 + c8 * 8);
  }
  __syncthreads();
  const int kb = (wid >> 2) * 128;
#pragma unroll
  for (int m = 0; m < 8; ++m) { acc[m][0] = f32x4{0.f, 0.f, 0.f, 0.f}; acc[m][1] = f32x4{0.f, 0.f, 0.f, 0.f}; }
#pragma unroll
  for (int kk = 0; kk < 4; ++kk) {
    bf16x8 wf0 = *(const bf16x8*)(sWt + (wid * 32 + fr) * 136 + kk * 32 + fq * 8);
    bf16x8 wf1 = *(const bf16x8*)(sWt + (wid * 32 + 16 + fr) * 136 + kk * 32 + fq * 8);
#pragma unroll
    for (int m = 0; m < 8; ++m) {
      bf16x8 xf = *(const bf16x8*)(sX + (m * 16 + fr) * 264 + kb + kk * 32 + fq * 8);
      acc[m][0] = mfma16(xf, wf0, acc[m][0]);
      acc[m][1] = mfma16(xf, wf1, acc[m][1]);
    }
  }
}

__device__ __forceinline__ void lru_tile(const Params& p, int l, int tile, int cp, bool sample, char* smem) {
  const int tid = otid(), lane = tid & 63, wid = tid >> 6, fr = lane & 15, fq = lane >> 4;
  bf16_t* sX = (bf16_t*)smem;
  bf16_t* sWt = (bf16_t*)(smem + 67584);
  const bf16_t* P = (const bf16_t*)(p.ws + W_P);
  {
    const int cg8 = tid & 31, tg = tid >> 5, c = cp * 256 + cg8 * 8;
    float w0[8], w1[8], w2[8], w3[8], bb[8];
    const float* cw = p.in[I_CONVW] + (size_t)l * 4 * D + c;
#pragma unroll
    for (int e = 0; e < 8; ++e) { w0[e] = cw[e]; w1[e] = cw[D + e]; w2[e] = cw[2 * D + e]; w3[e] = cw[3 * D + e]; bb[e] = p.in[I_CONVB][(size_t)l * D + c + e]; }
    if (!sample) {
      const int b = tile >> 4, tt0 = (tile & 15) * 128 + tg * 8;
      const size_t rb = (size_t)b * SEQ;
      float x3[8], x2[8], x1[8], cur[8];
#pragma unroll
      for (int e = 0; e < 8; ++e) { x3[e] = 0.f; x2[e] = 0.f; x1[e] = 0.f; }
      if (tt0 > 0) {
        unpack8(*(const uint4*)(P + (rb + tt0 - 3) * NPJ + C_XC + c), x3);
        unpack8(*(const uint4*)(P + (rb + tt0 - 2) * NPJ + C_XC + c), x2);
        unpack8(*(const uint4*)(P + (rb + tt0 - 1) * NPJ + C_XC + c), x1);
      }
#pragma unroll
      for (int i = 0; i < 8; ++i) {
        unpack8(*(const uint4*)(P + (rb + tt0 + i) * NPJ + C_XC + c), cur);
        float xc[8];
#pragma unroll
        for (int e = 0; e < 8; ++e) xc[e] = bb[e] + w0[e] * x3[e] + w1[e] * x2[e] + w2[e] * x1[e] + w3[e] * cur[e];
        *(uint4*)(sX + (tg * 8 + i) * 264 + cg8 * 8) = pack8(xc);
        if ((tile & 15) == 15 && tg == 15 && i >= 5) {
          float* o = p.out + O_CONVP + (((size_t)l * 8 + b) * 3 + (i - 5)) * D + c;
          *(float4*)o = float4{cur[0], cur[1], cur[2], cur[3]};
          *(float4*)(o + 4) = float4{cur[4], cur[5], cur[6], cur[7]};
        }
#pragma unroll
        for (int e = 0; e < 8; ++e) { x3[e] = x2[e]; x2[e] = x1[e]; x1[e] = cur[e]; }
      }
    } else {
#pragma unroll
      for (int q = 0; q < 2; ++q) {
        const int bbi = tile * 32 + tg * 2 + q;
        const float* cb = p.in[I_SCONV] + ((size_t)l * 128 + bbi) * 3 * D + c;
        float x3[8], x2[8], x1[8], cur[8];
#pragma unroll
        for (int e = 0; e < 8; ++e) { x3[e] = cb[e]; x2[e] = cb[D + e]; x1[e] = cb[2 * D + e]; }
#pragma unroll
        for (int i = 0; i < 4; ++i) {
          unpack8(*(const uint4*)(P + ((size_t)NPR + bbi * 4 + i) * NPJ + C_XC + c), cur);
          float xc[8];
#pragma unroll
          for (int e = 0; e < 8; ++e) xc[e] = bb[e] + w0[e] * x3[e] + w1[e] * x2[e] + w2[e] * x1[e] + w3[e] * cur[e];
          *(uint4*)(sX + (tg * 8 + q * 4 + i) * 264 + cg8 * 8) = pack8(xc);
          if (i >= 1) {
            float* o = p.out + O_CONVS + (((size_t)l * 128 + bbi) * 3 + (i - 1)) * D + c;
            *(float4*)o = float4{cur[0], cur[1], cur[2], cur[3]};
            *(float4*)(o + 4) = float4{cur[4], cur[5], cur[6], cur[7]};
          }
#pragma unroll
          for (int e = 0; e < 8; ++e) { x3[e] = x2[e]; x2[e] = x1[e]; x1[e] = cur[e]; }
        }
      }
    }
  }
  f32x4 racc[8][2], iacc[8][2];
  lru_gemm_pass(p, l, 0, cp, sX, sWt, racc);
  lru_gemm_pass(p, l, 1, cp, sX, sWt, iacc);
  const bool first = (!sample) && ((tile & 15) == 0);
#pragma unroll
  for (int n = 0; n < 2; ++n) {
    const int jl = wid * 32 + n * 16 + fr, c = cp * 256 + jl;
    const float bav = p.in[I_BA][(size_t)l * D + c], bxv = p.in[I_BX][(size_t)l * D + c];
    const float ls8 = 8.f * logsig(p.in[I_LAM][(size_t)l * D + c]);
#pragma unroll
    for (int m = 0; m < 8; ++m) {
      int mo = m * 16 + fq * 4;
      asm volatile("" : "+v"(mo));
#pragma unroll
      for (int r = 0; r < 4; ++r) {
        const int t = mo + r;
        const float rg = sigm(racc[m][n][r] + bav), ig = sigm(iacc[m][n][r] + bxv);
        const float av = __expf(ls8 * rg);
        float mult = __builtin_amdgcn_sqrtf(fmaxf(1.f - av * av, 0.f));
        if (first && t == 0) mult = 1.f;
        racc[m][n][r] = av;
        iacc[m][n][r] = mult * ig * bf2f(sX[t * 264 + jl]);
      }
    }
  }
  if (sample) {
    bf16_t* Y2 = (bf16_t*)(p.ws + W_Y) + (size_t)2 * MT * D;
#pragma unroll
    for (int n = 0; n < 2; ++n) {
      const int c = cp * 256 + wid * 32 + n * 16 + fr;
#pragma unroll
      for (int m = 0; m < 8; ++m) {
        int bbi = tile * 32 + m * 4 + fq;
        asm volatile("" : "+v"(bbi));
        float hh = p.in[I_SH][((size_t)l * 128 + bbi) * D + c];
#pragma unroll
        for (int r = 0; r < 4; ++r) {
          hh = racc[m][n][r] * hh + iacc[m][n][r];
          const size_t row = (size_t)NPR + bbi * 4 + r;
          const float z = bf2f(P[row * NPJ + C_ZC + c]);
          __hip_atomic_store(Y2 + row * D + c, f2bf(hh * silu(z)), __ATOMIC_RELAXED, __HIP_MEMORY_SCOPE_AGENT);
        }
        p.out[O_HS + ((size_t)l * 128 + bbi) * D + c] = hh;
      }
    }
  } else {
    bf16_t* LH = (bf16_t*)(p.ws + W_LH);
    bf16_t* LA = (bf16_t*)(p.ws + W_LA);
    const size_t rb = (size_t)(tile >> 4) * SEQ + (tile & 15) * 128;
#pragma unroll
    for (int n = 0; n < 2; ++n) {
      const int c = cp * 256 + wid * 32 + n * 16 + fr;
      float cA = 1.f, cH = 0.f;
#pragma unroll
      for (int m = 0; m < 8; ++m) {
        int mo = m * 16 + fq * 4;
        asm volatile("" : "+v"(mo));
        float la_[4], lh_[4];
        la_[0] = racc[m][n][0]; lh_[0] = iacc[m][n][0];
#pragma unroll
        for (int r = 1; r < 4; ++r) { la_[r] = la_[r - 1] * racc[m][n][r]; lh_[r] = racc[m][n][r] * lh_[r - 1] + iacc[m][n][r]; }
        float A = la_[3], H = lh_[3];
        float pA = SHU(A, 16), pH = SHU(H, 16);
        if (fq >= 1) { H = A * pH + H; A = A * pA; }
        pA = SHU(A, 32); pH = SHU(H, 32);
        if (fq >= 2) { H = A * pH + H; A = A * pA; }
        float eA = SHU(A, 16), eH = SHU(H, 16);
        if (fq == 0) { eA = 1.f; eH = 0.f; }
        const float tA = shf(A, 48 + fr), tH = shf(H, 48 + fr);
        const float PA = cA * eA, PH = eA * cH + eH;
#pragma unroll
        for (int r = 0; r < 4; ++r) {
          const size_t row = rb + mo + r;
          LA[row * D + c] = f2bf(PA * la_[r]);
          LH[row * D + c] = f2bf(la_[r] * PH + lh_[r]);
        }
        cH = tA * cH + tH;
        cA = cA * tA;
      }
      if (fq == 0) {
        float* LE = (float*)(p.ws + W_LE) + ((size_t)tile * D + c) * 2;
        LE[0] = cA; LE[1] = cH;
      }
    }
  }
  __syncthreads();
}

__device__ __forceinline__ void lru_fix(const Params& p, int l, int tile, int half) {
  const int tid = otid(), c = tid * 2;
  const int b = tile >> 4, seg = tile & 15;
  const float* LE = (const float*)(p.ws + W_LE);
  float H0 = 0.f, H1 = 0.f;
  for (int k = 0; k < seg; ++k) {
    const float4 e = *(const float4*)(LE + ((size_t)(b * 16 + k) * D + c) * 2);
    H0 = e.x * H0 + e.y;
    H1 = e.z * H1 + e.w;
  }
  const bf16_t* P = (const bf16_t*)(p.ws + W_P);
  const bf16_t* LH = (const bf16_t*)(p.ws + W_LH);
  const bf16_t* LA = (const bf16_t*)(p.ws + W_LA);
  bf16_t* Y2 = (bf16_t*)(p.ws + W_Y) + (size_t)2 * MT * D;
  const size_t R0 = (size_t)b * SEQ + seg * 128 + half * 64;
#pragma unroll 8
  for (int rr = 0; rr < 64; ++rr) {
    const size_t row = R0 + rr;
    const unsigned hl = *(const unsigned*)(LH + row * D + c);
    const unsigned al = *(const unsigned*)(LA + row * D + c);
    const unsigned zv = *(const unsigned*)(P + row * NPJ + C_ZC + c);
    const float h0 = bflo(hl) + bflo(al) * H0, h1 = bfhi(hl) + bfhi(al) * H1;
    *(unsigned*)(Y2 + row * D + c) = pk2(h0 * silu(bflo(zv)), h1 * silu(bfhi(zv)));
  }
  if (seg == 15 && half == 1) {
    const float4 e = *(const float4*)(LE + ((size_t)(b * 16 + 15) * D + c) * 2);
    float2 o = {e.x * H0 + e.y, e.z * H1 + e.w};
    *(float2*)(p.out + O_HP + ((size_t)l * 8 + b) * D + c) = o;
  }
}

__device__ __forceinline__ void x4_unit(const Params& p, int l, int pm, int pn, char* smem) {
  float* MF = (float*)(p.ws + W_MF);
  bf16_t* MB = (bf16_t*)(p.ws + W_MB);
  const bf16_t* const P = (const bf16_t*)(p.ws + W_P);
#pragma unroll 1
  for (int br = 0; br < 3; ++br) {
    const bf16_t* A = (const bf16_t*)(p.ws + W_Y) + (size_t)br * MT * D;
    const bf16_t* Bt = (const bf16_t*)(p.ws + W_WTP) + (size_t)(l * 4 + br) * D * D;
    f32x4 acc[2][2][4][2];
    gemm_tile(A, Bt, pm * 256, pn * 256, smem, acc);
    EPI_IDX
    EPI_LOOP {
      const int row = pm * 256 + ai * 128 + wr * 64 + m * 16 + fr, col = pn * 256 + bj * 128 + wc * 32 + n * 16 + fq * 4;
      const uint2 gv = *(const uint2*)(P + (size_t)row * NPJ + C_GA + br * 1024 + col);
      float4 v = {acc[ai][bj][m][n][0] * sigm(bflo(gv.x)), acc[ai][bj][m][n][1] * sigm(bfhi(gv.x)),
                  acc[ai][bj][m][n][2] * sigm(bflo(gv.y)), acc[ai][bj][m][n][3] * sigm(bfhi(gv.y))};
      uint2* mf = (uint2*)((bf16_t*)MF + (size_t)row * D + col);
      if (br == 0) {
        uint2 ob; ob.x = pk2(v.x, v.y); ob.y = pk2(v.z, v.w); *mf = ob;
      } else {
        const uint2 o = *mf;
        v.x += bflo(o.x); v.y += bfhi(o.x); v.z += bflo(o.y); v.w += bfhi(o.y);
        uint2 ob; ob.x = pk2(v.x, v.y); ob.y = pk2(v.z, v.w);
        if (br == 1) *mf = ob;
        else *(uint2*)(MB + (size_t)row * D + col) = ob;
      }
    }
  }
}
__device__ __forceinline__ void x5_unit(const Params& p, int l, int pm, int pn, char* smem) {
  const bf16_t* A = (const bf16_t*)(p.ws + W_MB);
  const bf16_t* Bt = (const bf16_t*)(p.ws + W_WTP) + (size_t)(l * 4 + 3) * D * D;
  float* PRE = (float*)(p.ws + W_PRE);
  const float* XF = (const float*)(p.ws + W_XF);
  f32x4 acc[2][2][4][2];
  gemm_tile(A, Bt, pm * 256, pn * 256, smem, acc);
  EPI_IDX
  EPI_LOOP {
    const int row = pm * 256 + ai * 128 + wr * 64 + m * 16 + fr, col = pn * 256 + bj * 128 + wc * 32 + n * 16 + fq * 4;
    const float* xr = (l == 0) ? (row < NPR ? p.in[I_XP] + (size_t)row * D : p.in[I_XS] + (size_t)(row - NPR) * D)
                               : XF + (size_t)row * D;
    const float4 xv = *(const float4*)(xr + col);
    float4 v = {ALPHA * xv.x + acc[ai][bj][m][n][0], ALPHA * xv.y + acc[ai][bj][m][n][1],
                ALPHA * xv.z + acc[ai][bj][m][n][2], ALPHA * xv.w + acc[ai][bj][m][n][3]};
    *(float4*)(PRE + (size_t)row * D + col) = v;
  }
}
__device__ __forceinline__ void dep_signal(unsigned* ctr) {
  asm volatile("s_waitcnt vmcnt(0)" ::: "memory");
  __syncthreads();
  if (threadIdx.x == 0) {
    __builtin_amdgcn_fence(__ATOMIC_RELEASE, "agent");
    asm volatile("s_waitcnt vmcnt(0)" ::: "memory");
    (void)__hip_atomic_fetch_add(ctr, 1u, __ATOMIC_RELAXED, __HIP_MEMORY_SCOPE_AGENT);
  }
}
__device__ __forceinline__ void dep_signal_wt(unsigned* ctr) {
  asm volatile("s_waitcnt vmcnt(0)" ::: "memory");
  __syncthreads();
  if (threadIdx.x == 0) (void)__hip_atomic_fetch_add(ctr, 1u, __ATOMIC_RELAXED, __HIP_MEMORY_SCOPE_AGENT);
}
__device__ __forceinline__ void dep_wait(unsigned* ctr, unsigned target) {
  if (threadIdx.x == 0) {
    unsigned sp = 0;
    while (__hip_atomic_load(ctr, __ATOMIC_RELAXED, __HIP_MEMORY_SCOPE_AGENT) < target) {
      __builtin_amdgcn_s_sleep(2);
      if (++sp > (1u << 24)) break;
    }
    __builtin_amdgcn_fence(__ATOMIC_ACQUIRE, "agent");
    asm volatile("s_waitcnt vmcnt(0)" ::: "memory");
  }
  __syncthreads();
}

#define XB_TMO 128
#define XB_XCNT(j) (256 + 64 * (j))
#define XB_XSUB(j) (1280 + 64 * (j))
#define XB_XGEN(j) (2304 + 64 * (j))
#define XB_TOP 3328
#define XB_TOPGEN 3392
#define XCD_BAR_WORDS 3456
#define XB_SPIN_CAP (1u << 22)
__device__ __forceinline__ unsigned xb_ld(unsigned* p) { return __hip_atomic_load(p, __ATOMIC_RELAXED, __HIP_MEMORY_SCOPE_AGENT); }
__device__ __forceinline__ unsigned xb_add(unsigned* p, unsigned v) { return __hip_atomic_fetch_add(p, v, __ATOMIC_RELAXED, __HIP_MEMORY_SCOPE_AGENT); }
__device__ __forceinline__ unsigned xb_xcc_id() { return (unsigned)__builtin_amdgcn_s_getreg((3 << 11) | 20) & 0xFu; }
#define XB_SPIN(cond, bar) do { unsigned _sp = 0; while (cond) { __builtin_amdgcn_s_sleep(1); \
    if ((++_sp & 255u) == 0u) { if (xb_ld(&(bar)[XB_TMO])) break; if (_sp > XB_SPIN_CAP) { atomicAdd(&(bar)[XB_TMO], 1u); break; } } } } while (0)
struct XcdBarrier { unsigned* bar; unsigned x; volatile LDSP(unsigned) st; };
__device__ __forceinline__ XcdBarrier xcd_barrier_post(unsigned* bar, volatile LDSP(unsigned) st) {
  XcdBarrier b; b.bar = bar; b.x = xb_xcc_id(); b.st = st;
  if (threadIdx.x == 0) (void)xb_add(&bar[XB_XCNT(b.x)], 1u);
  return b;
}
__device__ __forceinline__ void xcd_barrier_complete(unsigned* bar, unsigned x, unsigned& nloc, unsigned& nx) {
  const unsigned G = gridDim.x * gridDim.y * gridDim.z;
  unsigned sum, cnt, mine, sp = 0u;
  for (;;) {
    sum = 0u; cnt = 0u; mine = 0u;
#pragma unroll
    for (unsigned j = 0; j < 16; ++j) { const unsigned c = xb_ld(&bar[XB_XCNT(j)]); sum += c; cnt += (c > 0u) ? 1u : 0u; mine = (j == x) ? c : mine; }
    if (sum == G) break;
    __builtin_amdgcn_s_sleep(1);
    if ((++sp & 255u) == 0u) { if (xb_ld(&bar[XB_TMO])) break; if (sp > XB_SPIN_CAP) { atomicAdd(&bar[XB_TMO], 1u); break; } }
  }
  nloc = mine > 0u ? mine : 1u; nx = cnt > 0u ? cnt : 1u;
}
__device__ __forceinline__ void xcd_barrier(const XcdBarrier& b) {
  asm volatile("s_waitcnt vmcnt(0)" ::: "memory");
  __syncthreads();
  if (threadIdx.x == 0) {
    unsigned* bar = b.bar;
    __builtin_amdgcn_s_waitcnt(0);
    unsigned nloc = b.st[0], nx = b.st[1];
    if (nloc == 0u) { xcd_barrier_complete(bar, b.x, nloc, nx); b.st[0] = nloc; b.st[1] = nx; }
    const unsigned old = xb_add(&bar[XB_XSUB(b.x)], 1u);
    const unsigned gen = old / nloc;
    if (old + 1u == (gen + 1u) * nloc) {
      __builtin_amdgcn_fence(__ATOMIC_RELEASE, "agent");
      asm volatile("s_waitcnt vmcnt(0)" ::: "memory");
      const unsigned og = xb_add(&bar[XB_TOP], 1u);
      const unsigned tg = og / nx;
      if (og + 1u == (tg + 1u) * nx) xb_add(&bar[XB_TOPGEN], 1u);
      else XB_SPIN(xb_ld(&bar[XB_TOPGEN]) == tg, bar);
      __builtin_amdgcn_fence(__ATOMIC_ACQUIRE, "agent");
      xb_add(&bar[XB_XGEN(b.x)], 1u);
      asm volatile("s_waitcnt vmcnt(0)" ::: "memory");
    } else {
      XB_SPIN(xb_ld(&bar[XB_XGEN(b.x)]) == gen, bar);
      __builtin_amdgcn_fence(__ATOMIC_ACQUIRE, "agent");
      asm volatile("s_waitcnt vmcnt(0)" ::: "memory");
    }
  }
  __syncthreads();
}

__global__ void __launch_bounds__(512) mega(Params p) {
  extern __shared__ __attribute__((aligned(16))) char smem[];
  cg::grid_group grid = cg::this_grid();
  const int G = gridDim.x, bid = blockIdx.x;
  volatile LDSP(unsigned) xst = (volatile LDSP(unsigned))(smem + LDS_TOTAL - 16);
  if (threadIdx.x == 0) { xst[0] = 0u; xst[1] = 0u; xst[2] = 0u; xst[3] = 0u; }
  __syncthreads();
  XcdBarrier xb = xcd_barrier_post((unsigned*)(p.ws + W_BAR), xst);
  phase_convert(p, smem);
  row_pass(p, 0, smem);
  grid.sync();
#pragma unroll 1
  for (int l = 0; l < NL; ++l) {
    for (int it = bid; it < 32; it += G) mlstm_scalars(p, l, it, smem);
    REP(0) {
      const bf16_t* A = (const bf16_t*)(p.ws + W_XB);
      const bf16_t* Bt = (const bf16_t*)(p.ws + W_WTIN) + (size_t)l * NPJ * D;
      const float* bias = p.in[I_BIN] + (size_t)l * INW;
      bf16_t* const P = (bf16_t*)(p.ws + W_P);
      bool primed = false;
#pragma unroll 1
      for (int L = bid; L < 66 * 52; L += G) {
        int pm, pn; tile_map(L, 66, 52, pm, pn, 4);
        f32x4 acc[2][2][4][2];
        gemm_tile(A, Bt, pm * 256, pn * 256, smem, acc, primed);
        EPI_IDX
        float4 bvv[2][2];
#pragma unroll
        for (int bj = 0; bj < 2; ++bj)
#pragma unroll
          for (int n = 0; n < 2; ++n) {
            const int col = pn * 256 + bj * 128 + wc * 32 + n * 16 + fq * 4;
            bvv[bj][n] = *(const float4*)(bias + col + (col >= 5120 ? 8 : 0));
          }
        asm volatile("s_waitcnt vmcnt(0)" ::: "memory");
        primed = (L + G < 66 * 52);
        if (primed) { int pm2, pn2; tile_map(L + G, 66, 52, pm2, pn2, 4); gemm_tile(A, Bt, pm2 * 256, pn2 * 256, smem, acc, false, true); }
        const bool vbt = (pm < 64) && (pn >= 24) && (pn < 28);
        float st1[2][4], st2[2][4];
#pragma unroll
        for (int ai = 0; ai < 2; ++ai)
#pragma unroll
          for (int m = 0; m < 4; ++m) { st1[ai][m] = 0.f; st2[ai][m] = 0.f; }
        EPI_LOOP {
          const int row = pm * 256 + ai * 128 + wr * 64 + m * 16 + fr, col = pn * 256 + bj * 128 + wc * 32 + n * 16 + fq * 4;
          const float4 bv = bvv[bj][n];
          const float v0 = acc[ai][bj][m][n][0] + bv.x, v1 = acc[ai][bj][m][n][1] + bv.y;
          const float v2 = acc[ai][bj][m][n][2] + bv.z, v3 = acc[ai][bj][m][n][3] + bv.w;
          if (vbt) {
            st1[ai][m] += (v0 + v1) + (v2 + v3);
            st2[ai][m] += (v0 * v0 + v1 * v1) + (v2 * v2 + v3 * v3);
          }
          uint2 o;
          o.x = pk2(v0, v1);
          o.y = pk2(v2, v3);
          *(uint2*)(P + (size_t)row * NPJ + col) = o;
        }
        if (vbt) {
          float2* st = (float2*)(p.ws + W_ST) + (size_t)((pn - 24) * 4 + wc) * NPR;
#pragma unroll
          for (int ai = 0; ai < 2; ++ai)
#pragma unroll
            for (int m = 0; m < 4; ++m) {
              float s1 = st1[ai][m], s2 = st2[ai][m];
              s1 += SHX(s1, 16); s1 += SHX(s1, 32);
              s2 += SHX(s2, 16); s2 += SHX(s2, 32);
              if (fq == 0) st[pm * 256 + ai * 128 + wr * 64 + m * 16 + fr] = float2{s1, s2};
            }
        }
      }
    }
    GSYNC;
    {
      constexpr int Q_S = 656, Q_X4 = Q_S + 8, Q_F1 = Q_X4 + 256, Q_X5 = Q_F1 + 8, Q_FN = Q_X5 + 128, Q_F2 = Q_FN + 128, Q_LR = Q_F2 + 512,
                    Q_F3 = Q_LR + 128, Q_G2 = Q_F3 + 512;
      unsigned* qbase = (unsigned*)(p.ws + W_QCT) + l * 64;
      volatile LDSP(int) qslot = (volatile LDSP(int))(smem + LDS_TOTAL - 32);
      if (threadIdx.x == 0) qslot[0] = (int)xb_add(qbase, 1u);
      __syncthreads();
      int it = qslot[0];
#pragma unroll 1
      while (it < Q_G2) {
        __syncthreads();
        int nxt = 0;
        int r = it, fq_ = -1, fbh = 0;
        if (r >= Q_X4 && r < Q_F1) { fq_ = 15 - ((r - Q_X4) >> 5); fbh = (r - Q_X4) & 31; }
        else if (r >= Q_FN && r < Q_F2) { fq_ = 7 - ((r - Q_FN) >> 5); fbh = (r - Q_FN) & 31; }
        else if (r >= Q_LR && r < Q_F3) { fq_ = 3 - ((r - Q_LR) >> 5); fbh = (r - Q_LR) & 31; }
        if (fq_ < 0 && threadIdx.x == 0) nxt = (int)xb_add(qbase, 1u);
        if (fq_ >= 0) { mlstm_flash(p, l, fbh, fq_, smem); if (threadIdx.x == 0) nxt = (int)xb_add(qbase, 1u); }
        else if (r < Q_S) {
          if (r < 512) mlstm_sample(p, l, r >> 2, r & 3, smem);
          else if (r < 640) gmlp_sample(p, l, r - 512, smem);
          else lru_tile(p, l, (r - 640) >> 2, r & 3, true, smem);
          dep_signal_wt(qbase + 16);
        }
        else if (r < Q_X4) { r -= Q_S; dep_wait(qbase + 16, 656u); x4_unit(p, l, 64 + (r >> 2), r & 3, smem); dep_signal(qbase + 32 + 16 * (r >> 2)); }
        else if (r < Q_X5) { r -= Q_F1; dep_wait(qbase + 32 + 16 * (r >> 2), 4u); x5_unit(p, l, 64 + (r >> 2), r & 3, smem); }
        else if (r < Q_FN) { r -= Q_X5; mlstm_final(p, l, r >> 2, r & 3, smem); }
        else if (r < Q_LR) { r -= Q_F2; lru_tile(p, l, r >> 2, r & 3, false, smem); }
        else { r -= Q_F3; gmlp_prompt(p, l, r >> 6, (r >> 2) & 15, r & 3, smem); }
        if (threadIdx.x == 0) qslot[0] = nxt;
        __syncthreads();
        it = qslot[0];
      }
    }
    GSYNC;
    for (int it = bid; it < 256; it += G) lru_fix(p, l, it >> 1, it & 1);
    GSYNC;
#pragma unroll 1
    for (int L = bid; L < 64 * 4; L += G) { int pm, pn; tile_map(L, 64, 4, pm, pn); x4_unit(p, l, pm, pn, smem); }
    GSYNC;
#pragma unroll 1
    for (int L = bid; L < 64 * 4; L += G) { int pm, pn; tile_map(L, 64, 4, pm, pn); x5_unit(p, l, pm, pn, smem); }
    GSYNC;
    row_pass(p, l + 1, smem);
    GSYNC;
  }
}

extern "C" void kernel_launch(void* const* d_in, const int* in_sizes, int n_in, void* d_out, int out_size, void* d_ws,
                              size_t ws_size, hipStream_t stream) {
  constexpr size_t kLds = LDS_TOTAL;
  static int grid_blocks = 0;
  if (!grid_blocks) {
    int dev = 0, cus = 0, per_cu = 0;
    (void)hipGetDevice(&dev);
    (void)hipDeviceGetAttribute(&cus, hipDeviceAttributeMultiprocessorCount, dev);
    (void)hipFuncSetAttribute((const void*)mega, hipFuncAttributeMaxDynamicSharedMemorySize, (int)kLds);
    (void)hipOccupancyMaxActiveBlocksPerMultiprocessor(&per_cu, (const void*)mega, 512, kLds);
    if (per_cu < 1) per_cu = 1;
    grid_blocks = cus * per_cu;
    if (grid_blocks % 8) grid_blocks -= grid_blocks % 8;
    if (ws_size < W_END || n_in != 27 || (size_t)out_size != O_END)
      fprintf(stderr, "kernel_launch: unexpected sizes ws %zu (need %zu) n_in %d out %d (expect %zu)\n", ws_size,
              (size_t)W_END, n_in, out_size, (size_t)O_END);
  }
  (void)hipMemsetAsync((char*)d_ws + W_BAR, 0, W_CTL_END - W_BAR, stream);
  Params p{};
  for (int i = 0; i < 27; ++i) p.in[i] = (const float*)d_in[i];
  p.out = (float*)d_out;
  p.ws = (char*)d_ws;
  void* args[] = {&p};
  hipError_t e = hipLaunchCooperativeKernel((const void*)mega, dim3(grid_blocks), dim3(512), args, kLds, stream);
  if (e != hipSuccess) fprintf(stderr, "cooperative launch failed: %s (grid %d)\n", hipGetErrorString(e), grid_blocks);
}
```

```cpp
#include <hip/hip_runtime.h>
#include <hip/hip_cooperative_groups.h>
#include <cstdio>
#include <cstdint>
namespace cg = cooperative_groups;

typedef unsigned short bf16_t;
typedef short bf16x8 __attribute__((ext_vector_type(8)));
typedef short s16x4 __attribute__((ext_vector_type(4)));
typedef float f32x4 __attribute__((ext_vector_type(4)));
#define LDSP(T) __attribute__((address_space(3))) T*

constexpr int D = 1024, NPR = 16384, NSM = 512, MT = 16896, NL = 4, SEQ = 2048;
constexpr int INW = 13320, NPJ = 13312;
constexpr int C_Q = 0, C_K = 1024, C_V = 2048, C_O = 3072, C_ZA = 4096, C_UB = 5120, C_VB = 6144, C_ZB = 7168,
              C_XC = 8192, C_ZC = 9216, C_GA = 10240;
constexpr float ALPHA = 1.6817928305074292f;
constexpr float EPS = 1e-5f;
constexpr int LDS_TOTAL = 150 * 1024;
#ifndef DUP_PHASE
#define DUP_PHASE -1
#endif
#define GSYNC xcd_barrier(xb)
#define REP(k) for (int rep_ = 0; rep_ < ((DUP_PHASE == (k)) ? 2 : 1); ++rep_)

constexpr size_t W_WTIN = 0;
constexpr size_t W_WTP = W_WTIN + (size_t)NL * NPJ * D * 2;
constexpr size_t W_WTL = W_WTP + (size_t)NL * 4 * D * D * 2;
constexpr size_t W_WM = W_WTL + (size_t)NL * 2 * 8 * 128 * 128 * 2;
constexpr size_t W_XB = W_WM + (size_t)NL * 4 * 128 * 128 * 2;
constexpr size_t W_XF = W_XB + (size_t)MT * D * 2;
constexpr size_t W_GATE = W_XF + (size_t)MT * D * 4;
constexpr size_t W_P = W_GATE + (size_t)MT * 8 * 4;
constexpr size_t W_PRE = W_P + (size_t)MT * NPJ * 2;
constexpr size_t W_MF = W_PRE + (size_t)MT * D * 4;
constexpr size_t W_MB = W_MF + (size_t)MT * D * 4;
constexpr size_t W_Y = W_MB + (size_t)MT * D * 2;
constexpr size_t W_G = W_Y + (size_t)3 * MT * D * 2;
constexpr size_t W_MX = W_G + (size_t)32 * 2048 * 4;
constexpr size_t W_EM = W_MX + (size_t)32 * 2048 * 4;
constexpr size_t W_LH = W_EM + (size_t)32 * 2048 * 4;
constexpr size_t W_LA = W_LH + (size_t)NPR * D * 2;
constexpr size_t W_LE = W_LA + (size_t)NPR * D * 2;
constexpr size_t W_BAR = W_LE + (size_t)8 * 16 * 1024 * 2 * 4;
constexpr size_t W_QCT = W_BAR + 3456 * 4;
constexpr size_t W_CTL_END = W_QCT + 4 * 256;
constexpr size_t W_ST = W_CTL_END;
constexpr size_t W_END = W_ST + (size_t)16 * NPR * 2 * 4;

constexpr size_t O_Y = 0;
constexpr size_t O_CP = (size_t)MT * D;
constexpr size_t O_NP = O_CP + (size_t)NL * 8 * 4 * 256 * 256;
constexpr size_t O_MP = O_NP + (size_t)NL * 8 * 4 * 256;
constexpr size_t O_CONVP = O_MP + (size_t)NL * 8 * 4;
constexpr size_t O_HP = O_CONVP + (size_t)NL * 8 * 3 * 1024;
constexpr size_t O_CS = O_HP + (size_t)NL * 8 * 1024;
constexpr size_t O_NS = O_CS + (size_t)NL * 128 * 4 * 256 * 256;
constexpr size_t O_MS = O_NS + (size_t)NL * 128 * 4 * 256;
constexpr size_t O_CONVS = O_MS + (size_t)NL * 128 * 4;
constexpr size_t O_HS = O_CONVS + (size_t)NL * 128 * 3 * 1024;
constexpr size_t O_VS = O_HS + (size_t)NL * 128 * 1024;
constexpr size_t O_END = O_VS + (size_t)NL * 128 * 4 * 1024;

enum { I_XP = 0, I_XS, I_SC, I_SN, I_SM, I_SCONV, I_SH, I_WIN, I_BIN, I_NORMG, I_GLNG, I_GLNB, I_GWS, I_GBS, I_CONVW,
       I_CONVB, I_WA, I_BA, I_WX, I_BX, I_LAM, I_WPA, I_WPB, I_WPC, I_WOUT, I_LNG, I_LNB };

struct Params {
  const float* in[27];
  float* out;
  char* ws;
};

__device__ __forceinline__ bf16_t f2bf(float f) {
  unsigned u = __float_as_uint(f);
  u += 0x7fffu + ((u >> 16) & 1u);
  return (bf16_t)(u >> 16);
}
__device__ __forceinline__ float bf2f(bf16_t h) { return __uint_as_float(((unsigned)h) << 16); }
__device__ __forceinline__ unsigned pk2(float a, float b) {
  unsigned r;
  asm("v_cvt_pk_bf16_f32 %0, %1, %2" : "=v"(r) : "v"(a), "v"(b));
  return r;
}
__device__ __forceinline__ float bflo(unsigned u) { return __uint_as_float(u << 16); }
__device__ __forceinline__ float bfhi(unsigned u) { return __uint_as_float(u & 0xffff0000u); }
__device__ __forceinline__ float sigm(float x) { return __builtin_amdgcn_rcpf(1.f + __expf(-x)); }
__device__ __forceinline__ float silu(float x) { return x * sigm(x); }
__device__ __forceinline__ float logsig(float x) { return fminf(x, 0.f) - log1pf(__expf(-fabsf(x))); }
__device__ __forceinline__ float shf(float v, int src) {
  return __int_as_float(__builtin_amdgcn_ds_bpermute(src << 2, __float_as_int(v)));
}
#define SHX(v, o) shf((v), lane ^ (o))
#define SHU(v, o) shf((v), (lane >= (o)) ? lane - (o) : lane)
__device__ __forceinline__ float wave_sum_l(float v, int lane) {
#pragma unroll
  for (int o = 1; o < 64; o <<= 1) v += shf(v, lane ^ o);
  return v;
}
#define wave_sum(v) wave_sum_l((v), lane)
__device__ __forceinline__ f32x4 mfma16(bf16x8 a, bf16x8 b, f32x4 c) {
  return __builtin_amdgcn_mfma_f32_16x16x32_bf16(a, b, c, 0, 0, 0);
}
__device__ __forceinline__ bf16x8 frag_t(const bf16_t* T, int stride, int r0, int k0, int lane) {
  const int fr = lane & 15, fq = lane >> 4;
  const bf16_t* q = T + (k0 + fq * 8 + (fr >> 2)) * stride + r0 + (fr & 3) * 4;
  s16x4 a = __builtin_amdgcn_ds_read_tr16_b64_v4i16((LDSP(s16x4))q);
  s16x4 b = __builtin_amdgcn_ds_read_tr16_b64_v4i16((LDSP(s16x4))(q + 4 * stride));
  bf16x8 r = {a[0], a[1], a[2], a[3], b[0], b[1], b[2], b[3]};
  return r;
}
__device__ __forceinline__ void unpack8(uint4 v, float* f) {
  f[0] = bflo(v.x); f[1] = bfhi(v.x); f[2] = bflo(v.y); f[3] = bfhi(v.y);
  f[4] = bflo(v.z); f[5] = bfhi(v.z); f[6] = bflo(v.w); f[7] = bfhi(v.w);
}
__device__ __forceinline__ uint4 pack8(const float* f) {
  uint4 o; o.x = pk2(f[0], f[1]); o.y = pk2(f[2], f[3]); o.z = pk2(f[4], f[5]); o.w = pk2(f[6], f[7]);
  return o;
}

__device__ __forceinline__ int otid() { int t = threadIdx.x; asm volatile("" : "+v"(t)); return t; }

__device__ __forceinline__ void tconv_item(const float* src, int lds_, bf16_t* dst, int ldd, int k0, int n0s, int n0d,
                                           float* scr, int lane) {
#pragma unroll 8
  for (int i = 0; i < 32; ++i) {
    const int kk = 2 * i + (lane >> 5);
    scr[kk * 33 + (lane & 31)] = src[(size_t)(k0 + kk) * lds_ + n0s + (lane & 31)];
  }
  const int c = lane & 7;
#pragma unroll
  for (int j = 0; j < 4; ++j) {
    const int n = (lane >> 3) + 8 * j;
    const float* t = scr + (8 * c) * 33 + n;
    uint4 o;
    o.x = pk2(t[0 * 33], t[1 * 33]); o.y = pk2(t[2 * 33], t[3 * 33]);
    o.z = pk2(t[4 * 33], t[5 * 33]); o.w = pk2(t[6 * 33], t[7 * 33]);
    *(uint4*)(dst + (size_t)(n0d + n) * ldd + k0 + 8 * c) = o;
  }
}

__device__ __forceinline__ void phase_convert(const Params& p, char* smem) {
  const int tid = otid(), lane = tid & 63, wid = tid >> 6;
  float* scr = (float*)smem + wid * (64 * 33);
  constexpr int N_IN = NL * 16 * 416, N_PJ = NL * 4 * 16 * 32, N_LR = NL * 2 * 8 * 8;
  for (int it = blockIdx.x * 8 + wid; it < N_IN + N_PJ + N_LR; it += gridDim.x * 8) {
    int r = it;
    if (r < N_IN) {
      int l = r / (16 * 416), q = r % (16 * 416), kt = q / 416, nt = q % 416;
      int n0d = nt * 32, n0s = n0d + (n0d >= 5120 ? 8 : 0);
      tconv_item(p.in[I_WIN] + (size_t)l * D * INW, INW, (bf16_t*)(p.ws + W_WTIN) + (size_t)l * NPJ * D, D, kt * 64, n0s,
                 n0d, scr, lane);
      continue;
    }
    r -= N_IN;
    if (r < N_PJ) {
      int lm = r >> 9, q = r & 511, kt = q >> 5, nt = q & 31, l = lm >> 2, mat = lm & 3;
      const float* src = p.in[I_WPA + mat] + (size_t)l * D * D;
      tconv_item(src, D, (bf16_t*)(p.ws + W_WTP) + (size_t)lm * D * D, D, kt * 64, nt * 32, nt * 32, scr, lane);
      continue;
    }
    r -= N_PJ;
    {
      int q = r & 7, lmn = r >> 3, n = lmn & 7, mat = (lmn >> 3) & 1, l = lmn >> 4;
      const float* src = p.in[mat ? I_WX : I_WA] + (size_t)(l * 8 + n) * 16384;
      tconv_item(src, 128, (bf16_t*)(p.ws + W_WTL) + (size_t)((l * 2 + mat) * 8 + n) * 16384, 128, (q >> 2) * 64,
                 (q & 3) * 32, (q & 3) * 32, scr, lane);
    }
  }
  __syncthreads();
  bf16_t* wm = (bf16_t*)(p.ws + W_WM);
  const float* gws = p.in[I_GWS];
  for (int idx = blockIdx.x * 512 + otid(); idx < NL * 4 * 128 * 128; idx += gridDim.x * 512) {
    int t = (idx >> 7) & 127, s = idx & 127;
    wm[idx] = f2bf(s <= t ? gws[idx] : 0.f);
  }
}

__device__ __forceinline__ void row_pass(const Params& p, int l, char* smem) {
  const int tid = otid(), lane = tid & 63, wid = tid >> 6;
  float* sWg = (float*)smem;
  if (l < NL) {
    const float* w = p.in[I_WIN] + (size_t)l * D * INW;
    for (int idx = tid; idx < 8192; idx += 512) {
      int j = idx >> 10, k = idx & 1023;
      sWg[idx] = w[(size_t)k * INW + 5120 + j];
    }
  }
  __syncthreads();
  bf16_t* XB = (bf16_t*)(p.ws + W_XB);
  float* XF = (float*)(p.ws + W_XF);
  const float* PRE = (const float*)(p.ws + W_PRE);
  float* GATE = (float*)(p.ws + W_GATE);
  for (int r = blockIdx.x * 8 + wid; r < MT; r += gridDim.x * 8) {
    float4 v[4];
    if (l == 0) {
      const float* src = r < NPR ? p.in[I_XP] + (size_t)r * D : p.in[I_XS] + (size_t)(r - NPR) * D;
#pragma unroll
      for (int i = 0; i < 4; ++i) v[i] = ((const float4*)src)[lane + 64 * i];
    } else {
      const float* src = PRE + (size_t)r * D;
      float s = 0.f;
#pragma unroll
      for (int i = 0; i < 4; ++i) { v[i] = ((const float4*)src)[lane + 64 * i]; s += (v[i].x + v[i].y) + (v[i].z + v[i].w); }
      const float mean = wave_sum(s) * (1.f / D);
      float s2 = 0.f;
#pragma unroll
      for (int i = 0; i < 4; ++i) {
        v[i].x -= mean; v[i].y -= mean; v[i].z -= mean; v[i].w -= mean;
        s2 += (v[i].x * v[i].x + v[i].y * v[i].y) + (v[i].z * v[i].z + v[i].w * v[i].w);
      }
      const float rstd = rsqrtf(wave_sum(s2) * (1.f / D) + EPS);
      const float4* g4 = (const float4*)(p.in[I_LNG] + (size_t)(l - 1) * D);
      const float4* b4 = (const float4*)(p.in[I_LNB] + (size_t)(l - 1) * D);
      float* dst = (l == NL) ? p.out + O_Y + (size_t)r * D : XF + (size_t)r * D;
#pragma unroll
      for (int i = 0; i < 4; ++i) {
        float4 g = g4[lane + 64 * i], b = b4[lane + 64 * i];
        v[i].x = v[i].x * rstd * g.x + b.x; v[i].y = v[i].y * rstd * g.y + b.y;
        v[i].z = v[i].z * rstd * g.z + b.z; v[i].w = v[i].w * rstd * g.w + b.w;
        ((float4*)dst)[lane + 64 * i] = v[i];
      }
    }
    if (l < NL) {
#pragma unroll
      for (int i = 0; i < 4; ++i) {
        uint2 o; o.x = pk2(v[i].x, v[i].y); o.y = pk2(v[i].z, v[i].w);
        ((uint2*)(XB + (size_t)r * D))[lane + 64 * i] = o;
      }
      float ga[8];
#pragma unroll
      for (int j = 0; j < 8; ++j) {
        float a = 0.f;
#pragma unroll
        for (int i = 0; i < 4; ++i) {
          float4 w = ((const float4*)(sWg + j * 1024))[lane + 64 * i];
          a += v[i].x * w.x + v[i].y * w.y + v[i].z * w.z + v[i].w * w.w;
        }
        ga[j] = wave_sum(a);
      }
      if (lane == 0) {
        const float* bi = p.in[I_BIN] + (size_t)l * INW + 5120;
        float4 o0 = {ga[0] + bi[0], ga[1] + bi[1], ga[2] + bi[2], ga[3] + bi[3]};
        float4 o1 = {ga[4] + bi[4], ga[5] + bi[5], ga[6] + bi[6], ga[7] + bi[7]};
        ((float4*)(GATE + (size_t)r * 8))[0] = o0;
        ((float4*)(GATE + (size_t)r * 8))[1] = o1;
      }
    }
  }
  __syncthreads();
}

constexpr int KD = 1024, BK = 64, HALF = 128, HTB = HALF * BK * 2;
__device__ __forceinline__ int lds_byte(int r, int c) {
  int st = (r >> 4) * 2 + (c >> 5), rr = r & 15, cc = c & 31, ob = rr * 64 + cc * 2;
  return st * 1024 + (ob ^ (((ob >> 9) & 1) << 5));
}
__device__ __forceinline__ void stage_rc(int b, int& R, int& C) {
  int st = b / 1024, sb = b % 1024, swz = sb ^ (((sb >> 9) & 1) << 5);
  R = (st >> 1) * 16 + swz / 64;
  C = (st & 1) * 32 + (swz % 64) / 2;
}
__device__ __forceinline__ void tile_map(int L, int nM, int nN, int& pm, int& pn, int WGM_ = 8) {
  int nwg = nM * nN, q = nwg / 8, r = nwg % 8, xcd = L % 8, off = L / 8;
  int wgid = (xcd < r ? xcd * (q + 1) : r * (q + 1) + (xcd - r) * q) + off;
  int nig = WGM_ * nN, gid = wgid / nig, fm = gid * WGM_, gsz = min(nM - fm, WGM_);
  pm = fm + ((wgid % nig) % gsz);
  pn = (wgid % nig) / gsz;
}

__device__ __forceinline__ void gemm_tile(const bf16_t* __restrict__ A, const bf16_t* __restrict__ Bt, int brow, int bcol,
                                          char* shm, f32x4 (&acc)[2][2][4][2], bool primed = false, bool prime_only = false) {
#define SAO(b, h) (((b) * 2 + (h)) * HTB)
#define SBO(b, h) ((4 + (b) * 2 + (h)) * HTB)
#define STAGE(BO, BASE, br, kt)                                                                              \
  do {                                                                                                       \
    const char* _gb = (const char*)(BASE) + ((size_t)(br) * KD + (size_t)(kt) * BK) * 2;                     \
    __builtin_amdgcn_global_load_lds((const unsigned*)(_gb + toff0), (unsigned*)(shm + (BO) + tb0), 16, 0, 0); \
    __builtin_amdgcn_global_load_lds((const unsigned*)(_gb + toff1), (unsigned*)(shm + (BO) + tb1), 16, 0, 0); \
  } while (0)
#define LDA(dst, b, h)                                                                                         \
  _Pragma("unroll") for (int m = 0; m < 4; ++m) _Pragma("unroll") for (int k = 0; k < 2; ++k) dst[m][k] =      \
      *reinterpret_cast<const bf16x8*>(shm + SAO(b, h) + lds_byte(wr * 64 + m * 16 + fr, k * 32 + fq * 8))
#define LDB(dst, b, h)                                                                                         \
  _Pragma("unroll") for (int n = 0; n < 2; ++n) _Pragma("unroll") for (int k = 0; k < 2; ++k) dst[n][k] =      \
      *reinterpret_cast<const bf16x8*>(shm + SBO(b, h) + lds_byte(wc * 32 + n * 16 + fr, k * 32 + fq * 8))
#define MMA(ai, bj, At_, Bt_)                                                                               \
  do {                                                                                                      \
    __builtin_amdgcn_s_setprio(1);                                                                          \
    _Pragma("unroll") for (int m = 0; m < 4; ++m) _Pragma("unroll") for (int n = 0; n < 2; ++n)             \
        _Pragma("unroll") for (int k = 0; k < 2; ++k) acc[ai][bj][m][n] =                                   \
            __builtin_amdgcn_mfma_f32_16x16x32_bf16(Bt_[n][k], At_[m][k], acc[ai][bj][m][n], 0, 0, 0);     \
    __builtin_amdgcn_s_setprio(0);                                                                          \
  } while (0)
#define WAIT_V(n) asm volatile("s_waitcnt vmcnt(" #n ")" ::: "memory")
#define WAIT_L(n) asm volatile("s_waitcnt lgkmcnt(" #n ")" ::: "memory")
#define BAR __builtin_amdgcn_s_barrier()
#define SCHED __builtin_amdgcn_sched_barrier(0)
  const int tidg = otid();
  const int wid = tidg >> 6, lane = tidg & 63, wr = wid >> 2, wc = wid & 3, fr = lane & 15, fq = lane >> 4;
  const int tb0 = tidg * 16, tb1 = tb0 + 8192;
  unsigned toff0, toff1;
  {
    int r_, c_;
    stage_rc(tb0, r_, c_); toff0 = (unsigned)(r_ * KD + c_) * 2u;
    stage_rc(tb1, r_, c_); toff1 = (unsigned)(r_ * KD + c_) * 2u;
  }
  if (prime_only) {
    STAGE(SBO(0, 0), Bt, bcol, 0); STAGE(SAO(0, 0), A, brow, 0);
    STAGE(SBO(0, 1), Bt, bcol + HALF, 0); STAGE(SAO(0, 1), A, brow + HALF, 0);
    STAGE(SBO(1, 0), Bt, bcol, 1); STAGE(SAO(1, 0), A, brow, 1); STAGE(SBO(1, 1), Bt, bcol + HALF, 1);
    return;
  }
#pragma unroll
  for (int a = 0; a < 2; ++a)
#pragma unroll
    for (int b = 0; b < 2; ++b)
#pragma unroll
      for (int m = 0; m < 4; ++m)
#pragma unroll
        for (int n = 0; n < 2; ++n) acc[a][b][m][n] = f32x4{0.f, 0.f, 0.f, 0.f};
  bf16x8 At[4][2], B0[2][2], B1[2][2];
  constexpr int nt = KD / BK;
  if (!primed) {
    __syncthreads();
    STAGE(SBO(0, 0), Bt, bcol, 0); STAGE(SAO(0, 0), A, brow, 0);
    STAGE(SBO(0, 1), Bt, bcol + HALF, 0); STAGE(SAO(0, 1), A, brow + HALF, 0);
    STAGE(SBO(1, 0), Bt, bcol, 1); STAGE(SAO(1, 0), A, brow, 1); STAGE(SBO(1, 1), Bt, bcol + HALF, 1);
  }
  if (wr == 1) BAR;
  WAIT_V(0); BAR;
  BAR;
#pragma unroll 1
  for (int t = 0; t < nt - 2; t += 2) {
    LDB(B0, 0, 0); SCHED; LDA(At, 0, 0); STAGE(SAO(1, 1), A, brow + HALF, t + 1);
    WAIT_L(8); BAR; WAIT_L(0); MMA(0, 0, At, B0); BAR; SCHED;
    LDB(B1, 0, 1); STAGE(SBO(0, 0), Bt, bcol, t + 2);
    BAR; WAIT_L(0); MMA(0, 1, At, B1); BAR;
    LDA(At, 0, 1); STAGE(SAO(0, 0), A, brow, t + 2);
    BAR; WAIT_L(0); MMA(1, 0, At, B0); BAR; SCHED;
    STAGE(SBO(0, 1), Bt, bcol + HALF, t + 2);
    WAIT_V(6); BAR; MMA(1, 1, At, B1); BAR;
    LDB(B0, 1, 0); SCHED; LDA(At, 1, 0); STAGE(SAO(0, 1), A, brow + HALF, t + 2);
    WAIT_L(8); BAR; WAIT_L(0); MMA(0, 0, At, B0); BAR; SCHED;
    LDB(B1, 1, 1); STAGE(SBO(1, 0), Bt, bcol, t + 3);
    BAR; WAIT_L(0); MMA(0, 1, At, B1); BAR;
    LDA(At, 1, 1); STAGE(SAO(1, 0), A, brow, t + 3);
    BAR; WAIT_L(0); MMA(1, 0, At, B0); BAR; SCHED;
    STAGE(SBO(1, 1), Bt, bcol + HALF, t + 3);
    WAIT_V(6); BAR; MMA(1, 1, At, B1); BAR;
  }
  {
    LDB(B0, 0, 0); LDA(At, 0, 0); STAGE(SAO(1, 1), A, brow + HALF, nt - 1);
    BAR; WAIT_L(0); MMA(0, 0, At, B0); BAR;
    LDB(B1, 0, 1); BAR; WAIT_L(0); MMA(0, 1, At, B1); BAR;
    LDA(At, 0, 1); WAIT_V(4); BAR; WAIT_L(0); MMA(1, 0, At, B0); MMA(1, 1, At, B1); BAR;
  }
  {
    LDB(B0, 1, 0); LDA(At, 1, 0); WAIT_V(2); BAR; WAIT_L(0); MMA(0, 0, At, B0); BAR;
    LDB(B1, 1, 1); WAIT_V(0); BAR; WAIT_L(0); MMA(0, 1, At, B1); BAR;
    LDA(At, 1, 1); BAR; WAIT_L(0); MMA(1, 0, At, B0); MMA(1, 1, At, B1); BAR;
  }
  if (wr == 0) BAR;
}
#define EPI_IDX const int tide = otid(), wid = tide >> 6, lane = tide & 63, wr = wid >> 2, wc = wid & 3, fr = lane & 15, fq = lane >> 4;
#define EPI_LOOP                                                                     \
  _Pragma("unroll") for (int ai = 0; ai < 2; ++ai) _Pragma("unroll") for (int bj = 0; bj < 2; ++bj) \
      _Pragma("unroll") for (int m = 0; m < 4; ++m) _Pragma("unroll") for (int n = 0; n < 2; ++n)

__device__ __forceinline__ void mlstm_scalars(const Params& p, int l, int bh, char* smem) {
  const int tid = otid(), lane = tid & 63, wid = tid >> 6;
  float* sred = (float*)smem;
  const float* GATE = (const float*)(p.ws + W_GATE);
  const int b = bh >> 2, h = bh & 3;
  float itv[4], c[4];
#pragma unroll
  for (int r = 0; r < 4; ++r) {
    size_t row = (size_t)b * SEQ + tid * 4 + r;
    itv[r] = GATE[row * 8 + h];
    c[r] = logsig(GATE[row * 8 + 4 + h]);
  }
  c[1] += c[0]; c[2] += c[1]; c[3] += c[2];
  float inc = c[3];
#pragma unroll
  for (int o = 1; o < 64; o <<= 1) { float t = SHU(inc, o); if (lane >= o) inc += t; }
  if (lane == 63) sred[wid] = inc;
  __syncthreads();
  float base = 0.f;
  for (int w = 0; w < wid; ++w) base += sred[w];
  __syncthreads();
  const float excl = base + inc - c[3];
  float g[4], mx[4];
#pragma unroll
  for (int r = 0; r < 4; ++r) { c[r] += excl; g[r] = itv[r] - c[r]; }
  mx[0] = g[0]; mx[1] = fmaxf(mx[0], g[1]); mx[2] = fmaxf(mx[1], g[2]); mx[3] = fmaxf(mx[2], g[3]);
  float minc = mx[3];
#pragma unroll
  for (int o = 1; o < 64; o <<= 1) { float t = SHU(minc, o); if (lane >= o) minc = fmaxf(minc, t); }
  if (lane == 63) sred[wid] = minc;
  __syncthreads();
  float mb = 0.f;
  for (int w = 0; w < wid; ++w) mb = fmaxf(mb, sred[w]);
  float prev = SHU(minc, 1);
  if (lane > 0) mb = fmaxf(mb, prev);
  __syncthreads();
  float* G = (float*)(p.ws + W_G) + (size_t)bh * SEQ;
  float* MX = (float*)(p.ws + W_MX) + (size_t)bh * SEQ;
  float* EM = (float*)(p.ws + W_EM) + (size_t)bh * SEQ;
  float4 og, om, oe;
  float mxv[4], mv[4];
#pragma unroll
  for (int r = 0; r < 4; ++r) { mxv[r] = fmaxf(mb, mx[r]); mv[r] = c[r] + mxv[r]; }
  og = float4{g[0], g[1], g[2], g[3]};
  om = float4{mxv[0], mxv[1], mxv[2], mxv[3]};
  oe = float4{__expf(-mv[0]), __expf(-mv[1]), __expf(-mv[2]), __expf(-mv[3])};
  ((float4*)G)[tid] = og; ((float4*)MX)[tid] = om; ((float4*)EM)[tid] = oe;
  if (tid == 511) p.out[O_MP + (size_t)l * 32 + bh] = mv[3];
}

__device__ __forceinline__ void mlstm_flash(const Params& p, int l, int bh, int qi, char* smem) {
  const int tid = otid(), lane = tid & 63, wid = tid >> 6, fr = lane & 15, fq = lane >> 4, wr = wid >> 1, wc = wid & 1;
  const int b = bh >> 2, h = bh & 3;
  char* sKb = smem;
  char* sVb = smem + 65536;
  bf16_t* sP = (bf16_t*)(smem + 131072);
  float* sRed = (float*)(smem + 131072);
  const bf16_t* P = (const bf16_t*)(p.ws + W_P);
  const float* G = (const float*)(p.ws + W_G) + (size_t)bh * SEQ;
  const float* MX = (const float*)(p.ws + W_MX) + (size_t)bh * SEQ;
  const float* EM = (const float*)(p.ws + W_EM) + (size_t)bh * SEQ;
  const size_t rowbase = (size_t)b * SEQ;
  const int nblk = 2 * qi + 2;
#define FL_ISSUE(jb)                                                                                              \
  do {                                                                                                            \
    const int buf_ = (jb) & 1;                                                                                    \
    const bf16_t* rp0_ = P + (rowbase + (size_t)(jb) * 64) * NPJ + h * 256;                                       \
    _Pragma("unroll") for (int i_ = 0; i_ < 4; ++i_) {                                                            \
      const int r_ = (wid * 4 + i_) * 2 + (lane >> 5), cs_ = lane & 31;                                           \
      const int ck_ = cs_ ^ (r_ & 31), cv_ = cs_ ^ (((r_ & 3) << 1) | (r_ & 8));                                  \
      __builtin_amdgcn_global_load_lds((const unsigned*)(rp0_ + (size_t)r_ * NPJ + C_K + ck_ * 8),                \
                                       (unsigned*)(sKb + buf_ * 32768 + (wid * 4 + i_) * 1024 + lane * 16), 16, 0, 0); \
      __builtin_amdgcn_global_load_lds((const unsigned*)(rp0_ + (size_t)r_ * NPJ + C_V + cv_ * 8),                \
                                       (unsigned*)(sVb + buf_ * 32768 + (wid * 4 + i_) * 1024 + lane * 16), 16, 0, 0); \
    }                                                                                                             \
  } while (0)
  FL_ISSUE(0);
  bf16x8 qf[2][8];
  float mxr[2];
#pragma unroll
  for (int m = 0; m < 2; ++m) {
    const int t = qi * 128 + wr * 32 + m * 16 + fr;
    const bf16_t* qp = P + (rowbase + t) * NPJ + C_Q + h * 256 + fq * 8;
#pragma unroll
    for (int kk = 0; kk < 8; ++kk) qf[m][kk] = *(const bf16x8*)(qp + kk * 32);
    mxr[m] = MX[t];
  }
  f32x4 oacc[2][8];
#pragma unroll
  for (int m = 0; m < 2; ++m)
#pragma unroll
    for (int n = 0; n < 8; ++n) oacc[m][n] = f32x4{0.f, 0.f, 0.f, 0.f};
  float den[2] = {0.f, 0.f};
#pragma unroll 1
  for (int j = 0; j < nblk; ++j) {
    asm volatile("s_waitcnt vmcnt(0)" ::: "memory");
    __syncthreads();
    if (j + 1 < nblk) FL_ISSUE(j + 1);
    const char* sK = sKb + (j & 1) * 32768;
    const char* sV = sVb + (j & 1) * 32768;
    f32x4 sacc[2][2];
#pragma unroll
    for (int m = 0; m < 2; ++m)
#pragma unroll
      for (int n = 0; n < 2; ++n) sacc[m][n] = f32x4{0.f, 0.f, 0.f, 0.f};
#pragma unroll
    for (int kk = 0; kk < 8; ++kk)
#pragma unroll
      for (int n = 0; n < 2; ++n) {
        const int row = wc * 32 + n * 16 + fr, c = kk * 4 + fq;
        bf16x8 kf = *(const bf16x8*)(sK + row * 512 + ((c ^ (row & 31)) << 4));
        sacc[0][n] = mfma16(kf, qf[0][kk], sacc[0][n]);
        sacc[1][n] = mfma16(kf, qf[1][kk], sacc[1][n]);
      }
#pragma unroll
    for (int n = 0; n < 2; ++n) {
      const int s0 = j * 64 + wc * 32 + n * 16 + fq * 4;
      const float4 g4 = *(const float4*)(G + s0);
      const float gs[4] = {g4.x, g4.y, g4.z, g4.w};
#pragma unroll
      for (int m = 0; m < 2; ++m) {
        const int t = qi * 128 + wr * 32 + m * 16 + fr;
        float v[4];
#pragma unroll
        for (int r = 0; r < 4; ++r) {
          float w = (s0 + r <= t) ? __expf(gs[r] - mxr[m]) : 0.f;
          v[r] = sacc[m][n][r] * 0.0625f * w;
          den[m] += v[r];
        }
        uint2 pk; pk.x = pk2(v[0], v[1]); pk.y = pk2(v[2], v[3]);
        *(uint2*)(sP + (wr * 32 + m * 16 + fr) * 72 + wc * 32 + n * 16 + fq * 4) = pk;
      }
    }
    __syncthreads();
#pragma unroll
    for (int kk = 0; kk < 2; ++kk) {
      bf16x8 pf0 = *(const bf16x8*)(sP + (wr * 32 + fr) * 72 + kk * 32 + fq * 8);
      bf16x8 pf1 = *(const bf16x8*)(sP + (wr * 32 + 16 + fr) * 72 + kk * 32 + fq * 8);
      const int srow = kk * 32 + fq * 8 + (fr >> 2);
      const int swz = ((srow & 3) << 1) | (srow & 8);
#pragma unroll
      for (int n2 = 0; n2 < 8; ++n2) {
        const int ch = ((wc * 128 + n2 * 16) >> 3) + ((fr & 3) >> 1);
        const char* va = sV + srow * 512 + ((ch ^ swz) << 4) + (fr & 1) * 8;
        s16x4 a = __builtin_amdgcn_ds_read_tr16_b64_v4i16((LDSP(s16x4))va);
        s16x4 bq = __builtin_amdgcn_ds_read_tr16_b64_v4i16((LDSP(s16x4))(va + 4 * 512));
        bf16x8 vf = {a[0], a[1], a[2], a[3], bq[0], bq[1], bq[2], bq[3]};
        oacc[0][n2] = mfma16(vf, pf0, oacc[0][n2]);
        oacc[1][n2] = mfma16(vf, pf1, oacc[1][n2]);
      }
    }
  }
  __syncthreads();
#undef FL_ISSUE
  float dn[2];
#pragma unroll
  for (int m = 0; m < 2; ++m) {
    float v = den[m];
    v += SHX(v, 16); v += SHX(v, 32);
    if (fq == 0) sRed[wc * 128 + wr * 32 + m * 16 + fr] = v;
  }
  __syncthreads();
#pragma unroll
  for (int m = 0; m < 2; ++m) {
    const int tl = wr * 32 + m * 16 + fr;
    float d = sRed[tl] + sRed[128 + tl];
    dn[m] = 1.f / fmaxf(fabsf(d), EM[qi * 128 + tl]);
  }
  float s1[2] = {0.f, 0.f}, s2[2] = {0.f, 0.f};
#pragma unroll
  for (int m = 0; m < 2; ++m) {
    const size_t row = rowbase + qi * 128 + wr * 32 + m * 16 + fr;
#pragma unroll
    for (int n2 = 0; n2 < 8; ++n2) {
      const int col = h * 256 + wc * 128 + n2 * 16 + fq * 4;
      const uint2 ov = *(const uint2*)(P + row * NPJ + C_O + col);
      const float o[4] = {bflo(ov.x), bfhi(ov.x), bflo(ov.y), bfhi(ov.y)};
#pragma unroll
      for (int r = 0; r < 4; ++r) {
        float hv = oacc[m][n2][r] * dn[m] * sigm(o[r]);
        oacc[m][n2][r] = hv;
        s1[m] += hv; s2[m] += hv * hv;
      }
    }
  }
#pragma unroll
  for (int m = 0; m < 2; ++m) {
    float a = s1[m], q = s2[m];
    a += SHX(a, 16); a += SHX(a, 32);
    q += SHX(q, 16); q += SHX(q, 32);
    if (fq == 0) { sRed[256 + wc * 128 + wr * 32 + m * 16 + fr] = a; sRed[512 + wc * 128 + wr * 32 + m * 16 + fr] = q; }
  }
  __syncthreads();
  bf16_t* Y0 = (bf16_t*)(p.ws + W_Y);
  const float* ng = p.in[I_NORMG] + (size_t)l * D;
#pragma unroll
  for (int m = 0; m < 2; ++m) {
    const int tl = wr * 32 + m * 16 + fr;
    const float mean = (sRed[256 + tl] + sRed[256 + 128 + tl]) * (1.f / 256.f);
    const float var = (sRed[512 + tl] + sRed[512 + 128 + tl]) * (1.f / 256.f) - mean * mean;
    const float rstd = rsqrtf(fmaxf(var, 0.f) + EPS);
    const size_t row = rowbase + qi * 128 + tl;
#pragma unroll
    for (int n2 = 0; n2 < 8; ++n2) {
      const int col = h * 256 + wc * 128 + n2 * 16 + fq * 4;
      const uint2 zv = *(const uint2*)(P + row * NPJ + C_ZA + col);
      const float4 g4 = *(const float4*)(ng + col);
      const float z[4] = {bflo(zv.x), bfhi(zv.x), bflo(zv.y), bfhi(zv.y)};
      const float gg[4] = {g4.x, g4.y, g4.z, g4.w};
      float y[4];
#pragma unroll
      for (int r = 0; r < 4; ++r) y[r] = (oacc[m][n2][r] - mean) * rstd * gg[r] * silu(z[r]);
      uint2 o; o.x = pk2(y[0], y[1]); o.y = pk2(y[2], y[3]);
      *(uint2*)(Y0 + row * D + col) = o;
    }
  }
  __syncthreads();
}

__device__ __forceinline__ void mlstm_final(const Params& p, int l, int bh, int dq, char* smem) {
  const int tid = otid(), lane = tid & 63, wid = tid >> 6, fr = lane & 15, fq = lane >> 4, wr = wid >> 2, wc = wid & 3;
  const int b = bh >> 2, h = bh & 3;
  char* sVb = smem;
  char* sKb = smem + 98304;
  float* sWall = (float*)(smem + 122880);
  float* sW = (float*)(smem + 131072);
  const bf16_t* P = (const bf16_t*)(p.ws + W_P);
  const float* G = (const float*)(p.ws + W_G) + (size_t)bh * SEQ;
  const float mxl = ((const float*)(p.ws + W_MX))[(size_t)bh * SEQ + SEQ - 1];
  const size_t rowbase = (size_t)b * SEQ;
  {
    const float4 g4 = ((const float4*)G)[tid];
    float4 w4 = {__expf(g4.x - mxl) * 0.0625f, __expf(g4.y - mxl) * 0.0625f, __expf(g4.z - mxl) * 0.0625f, __expf(g4.w - mxl) * 0.0625f};
    ((float4*)sWall)[tid] = w4;
  }
#define FN_ISSUE(jb)                                                                                                  \
  do {                                                                                                                \
    const int buf_ = (jb) % 3;                                                                                        \
    const bf16_t* rp0_ = P + (rowbase + (size_t)(jb) * 64) * NPJ + h * 256;                                           \
    _Pragma("unroll") for (int i_ = 0; i_ < 4; ++i_) {                                                                \
      const int r_ = (wid * 4 + i_) * 2 + (lane >> 5), cs_ = lane & 31;                                               \
      const int cv_ = cs_ ^ (((r_ & 3) << 1) | (r_ & 8));                                                             \
      __builtin_amdgcn_global_load_lds((const unsigned*)(rp0_ + (size_t)r_ * NPJ + C_V + cv_ * 8),                    \
                                       (unsigned*)(sVb + buf_ * 32768 + (wid * 4 + i_) * 1024 + lane * 16), 16, 0, 0); \
    }                                                                                                                 \
    {                                                                                                                 \
      const int r_ = wid * 8 + (lane >> 3), cs_ = lane & 7;                                                           \
      const int ck_ = cs_ ^ ((r_ & 3) << 1);                                                                          \
      __builtin_amdgcn_global_load_lds((const unsigned*)(rp0_ + (size_t)r_ * NPJ + C_K + dq * 64 + ck_ * 8),          \
                                       (unsigned*)(sKb + buf_ * 8192 + wid * 1024 + lane * 16), 16, 0, 0);            \
    }                                                                                                                 \
  } while (0)
  asm volatile("s_waitcnt vmcnt(0)" ::: "memory");
  FN_ISSUE(0);
  FN_ISSUE(1);
  f32x4 acc[2][4];
#pragma unroll
  for (int m = 0; m < 2; ++m)
#pragma unroll
    for (int n = 0; n < 4; ++n) acc[m][n] = f32x4{0.f, 0.f, 0.f, 0.f};
  float nacc = 0.f;
#pragma unroll 1
  for (int j = 0; j < 32; ++j) {
    if (j + 1 < 32) asm volatile("s_waitcnt vmcnt(5)" ::: "memory");
    else asm volatile("s_waitcnt vmcnt(0)" ::: "memory");
    __syncthreads();
    if (j + 2 < 32) FN_ISSUE(j + 2);
    const char* sV = sVb + (j % 3) * 32768;
    const char* sK = sKb + (j % 3) * 8192;
#pragma unroll
    for (int kk = 0; kk < 2; ++kk) {
      const int srow = kk * 32 + fq * 8 + (fr >> 2);
      const float4 wa = *(const float4*)(sWall + j * 64 + kk * 32 + fq * 8);
      const float4 wb = *(const float4*)(sWall + j * 64 + kk * 32 + fq * 8 + 4);
      bf16x8 kf[2];
#pragma unroll
      for (int m = 0; m < 2; ++m) {
        const int d0 = wr * 32 + m * 16 + (fr & 3) * 4;
        const char* ka = sK + srow * 128 + ((((d0 >> 3) ^ ((srow & 3) << 1)) & 7) << 4) + ((d0 >> 2) & 1) * 8;
        s16x4 a = __builtin_amdgcn_ds_read_tr16_b64_v4i16((LDSP(s16x4))ka);
        s16x4 bq = __builtin_amdgcn_ds_read_tr16_b64_v4i16((LDSP(s16x4))(ka + 4 * 128));
        const unsigned u0 = pk2(bf2f((bf16_t)a[0]) * wa.x, bf2f((bf16_t)a[1]) * wa.y);
        const unsigned u1 = pk2(bf2f((bf16_t)a[2]) * wa.z, bf2f((bf16_t)a[3]) * wa.w);
        const unsigned u2 = pk2(bf2f((bf16_t)bq[0]) * wb.x, bf2f((bf16_t)bq[1]) * wb.y);
        const unsigned u3 = pk2(bf2f((bf16_t)bq[2]) * wb.z, bf2f((bf16_t)bq[3]) * wb.w);
        kf[m] = bf16x8{(short)(u0 & 0xffff), (short)(u0 >> 16), (short)(u1 & 0xffff), (short)(u1 >> 16),
                       (short)(u2 & 0xffff), (short)(u2 >> 16), (short)(u3 & 0xffff), (short)(u3 >> 16)};
      }
      const int swz = ((srow & 3) << 1) | (srow & 8);
#pragma unroll
      for (int n = 0; n < 4; ++n) {
        const int ch = ((wc * 64 + n * 16) >> 3) + ((fr & 3) >> 1);
        const char* va = sV + srow * 512 + ((ch ^ swz) << 4) + (fr & 1) * 8;
        s16x4 a = __builtin_amdgcn_ds_read_tr16_b64_v4i16((LDSP(s16x4))va);
        s16x4 bq = __builtin_amdgcn_ds_read_tr16_b64_v4i16((LDSP(s16x4))(va + 4 * 512));
        bf16x8 vf = {a[0], a[1], a[2], a[3], bq[0], bq[1], bq[2], bq[3]};
        acc[0][n] = mfma16(vf, kf[0], acc[0][n]);
        acc[1][n] = mfma16(vf, kf[1], acc[1][n]);
      }
    }
    {
      float a = 0.f;
#pragma unroll
      for (int s8 = 0; s8 < 8; ++s8) {
        const int srow = wid * 8 + s8;
        const bf16_t kv = *(const bf16_t*)(sK + srow * 128 + ((((lane >> 3) ^ ((srow & 3) << 1)) & 7) << 4) + (lane & 7) * 2);
        a += bf2f(kv) * sWall[j * 64 + srow];
      }
      nacc += a;
    }
  }
  __syncthreads();
#undef FN_ISSUE
  float* oc = p.out + O_CP + ((size_t)l * 32 + bh) * 65536;
#pragma unroll
  for (int m = 0; m < 2; ++m)
#pragma unroll
    for (int n = 0; n < 4; ++n) {
      const int d = dq * 64 + wr * 32 + m * 16 + fr, e = wc * 64 + n * 16 + fq * 4;
      *(float4*)(oc + (size_t)d * 256 + e) = float4{acc[m][n][0], acc[m][n][1], acc[m][n][2], acc[m][n][3]};
    }
  sW[tid] = nacc;
  __syncthreads();
  if (tid < 64) {
    float a = 0.f;
#pragma unroll
    for (int w8 = 0; w8 < 8; ++w8) a += sW[w8 * 64 + tid];
    p.out[O_NP + ((size_t)l * 32 + bh) * 256 + dq * 64 + tid] = a;
  }
  __syncthreads();
}

__device__ __forceinline__ void mlstm_sample(const Params& p, int l, int b, int h, char* smem) {
  const int tid = otid(), lane = tid & 63, wid = tid >> 6;
  float* sq = (float*)smem;
  float* sk = sq + 1024;
  float* sv = sk + 1024;
  float* sn0 = sv + 1024;
  float* sqk = sn0 + 256;
  float* ssc = sqk + 32;
  float* sst = ssc + 32;
  float* snum = sst + 32;
  const bf16_t* P = (const bf16_t*)(p.ws + W_P);
  const float* GATE = (const float*)(p.ws + W_GATE);
  const size_t R0 = (size_t)NPR + b * 4;
  const size_t sidx = ((size_t)l * 128 + b) * 4 + h;
#pragma unroll
  for (int i = 0; i < 6; ++i) {
    int idx = tid + 512 * i, which = idx >> 10, t = (idx >> 8) & 3, d = idx & 255;
    sq[idx] = bf2f(P[(R0 + t) * NPJ + which * 1024 + h * 256 + d]);
  }
  if (tid < 256) sn0[tid] = p.in[I_SN][sidx * 256 + tid];
  const float m0 = p.in[I_SM][sidx];
  float g[4], cm[4], mm[4];
  {
    float bc = 0.f, run = m0;
#pragma unroll
    for (int t = 0; t < 4; ++t) {
      float itv = GATE[(R0 + t) * 8 + h];
      bc += logsig(GATE[(R0 + t) * 8 + 4 + h]);
      g[t] = itv - bc;
      run = fmaxf(run, g[t]);
      cm[t] = run;
      mm[t] = bc + run;
    }
  }
  __syncthreads();
  {
    const int pp = tid >> 5, li = tid & 31, t = pp >> 2, s = pp & 3;
    float part = 0.f;
#pragma unroll
    for (int d8 = 0; d8 < 8; ++d8) part += sq[t * 256 + li * 8 + d8] * sk[s * 256 + li * 8 + d8];
#pragma unroll
    for (int o = 16; o >= 1; o >>= 1) part += SHX(part, o);
    if (li == 0) sqk[pp] = part * 0.0625f;
    float part2 = 0.f;
    const int t2 = pp & 3;
#pragma unroll
    for (int d8 = 0; d8 < 8; ++d8) part2 += sq[t2 * 256 + li * 8 + d8] * sn0[li * 8 + d8];
#pragma unroll
    for (int o = 16; o >= 1; o >>= 1) part2 += SHX(part2, o);
    if (li == 0 && pp < 4) sqk[16 + pp] = part2;
  }
  __syncthreads();
  float w[4];
#pragma unroll
  for (int s = 0; s < 4; ++s) w[s] = __expf(g[s] - cm[3]) * 0.0625f;
  const float decay = __expf(m0 - cm[3]);
  if (tid == 0) {
#pragma unroll
    for (int t = 0; t < 4; ++t) {
      const float inter = __expf(m0 - cm[t]);
      float dsum = inter * sqk[16 + t];
#pragma unroll
      for (int s = 0; s < 4; ++s) {
        float st = (s <= t) ? sqk[t * 4 + s] * __expf(g[s] - cm[t]) : 0.f;
        ssc[t * 4 + s] = st;
        dsum += st;
      }
      ssc[16 + t] = inter;
      ssc[20 + t] = 1.f / fmaxf(fabsf(dsum), __expf(-mm[t]));
    }
  }
#pragma unroll
  for (int i = 0; i < 2; ++i) {
    int idx = tid + 512 * i;
    sk[idx] *= w[idx >> 8];
  }
  __syncthreads();
  {
    const int e4 = lane * 4, d0 = wid * 32;
    float4 vv[4], np[4];
#pragma unroll
    for (int s = 0; s < 4; ++s) { vv[s] = *(const float4*)(sv + s * 256 + e4); np[s] = float4{0.f, 0.f, 0.f, 0.f}; }
    const float* c0p = p.in[I_SC] + sidx * 65536;
    float* cop = p.out + O_CS + sidx * 65536;
#pragma unroll 1
    for (int dd = 0; dd < 32; dd += 8) {
      float4 c[8];
#pragma unroll
      for (int u = 0; u < 8; ++u) {
        const f32x4 t4 = __builtin_nontemporal_load((const f32x4*)(c0p + (size_t)(d0 + dd + u) * 256 + e4));
        c[u] = float4{t4[0], t4[1], t4[2], t4[3]};
      }
#pragma unroll
      for (int u = 0; u < 8; ++u) {
        const int d = d0 + dd + u;
        float4 cn = {decay * c[u].x, decay * c[u].y, decay * c[u].z, decay * c[u].w};
#pragma unroll
        for (int t = 0; t < 4; ++t) {
          const float qv = sq[t * 256 + d], kv = sk[t * 256 + d];
          np[t].x += qv * c[u].x; np[t].y += qv * c[u].y; np[t].z += qv * c[u].z; np[t].w += qv * c[u].w;
          cn.x += kv * vv[t].x; cn.y += kv * vv[t].y; cn.z += kv * vv[t].z; cn.w += kv * vv[t].w;
        }
        __builtin_nontemporal_store(f32x4{cn.x, cn.y, cn.z, cn.w}, (f32x4*)(cop + (size_t)d * 256 + e4));
      }
    }
#pragma unroll
    for (int t = 0; t < 4; ++t) *(float4*)(snum + (wid * 4 + t) * 256 + e4) = np[t];
  }
  __syncthreads();
  {
    const int t = tid >> 7, e2 = (tid & 127) * 2;
    float hv[2];
    const unsigned ov = *(const unsigned*)(P + (R0 + t) * NPJ + C_O + h * 256 + e2);
    const float o2[2] = {bflo(ov), bfhi(ov)};
    const float inter = ssc[16 + t], dnm = ssc[20 + t];
#pragma unroll
    for (int k = 0; k < 2; ++k) {
      const int e = e2 + k;
      float a = 0.f;
#pragma unroll
      for (int w8 = 0; w8 < 8; ++w8) a += snum[(w8 * 4 + t) * 256 + e];
      float x = inter * a;
#pragma unroll
      for (int s = 0; s < 4; ++s) x += ssc[t * 4 + s] * sv[s * 256 + e];
      hv[k] = x * dnm * sigm(o2[k]);
    }
    float a1 = wave_sum(hv[0] + hv[1]), a2 = wave_sum(hv[0] * hv[0] + hv[1] * hv[1]);
    if (lane == 0) { sst[wid * 2] = a1; sst[wid * 2 + 1] = a2; }
    __syncthreads();
    const float mean = (sst[(2 * t) * 2] + sst[(2 * t + 1) * 2]) * (1.f / 256.f);
    const float var = (sst[(2 * t) * 2 + 1] + sst[(2 * t + 1) * 2 + 1]) * (1.f / 256.f) - mean * mean;
    const float rstd = rsqrtf(fmaxf(var, 0.f) + EPS);
    const unsigned zv = *(const unsigned*)(P + (R0 + t) * NPJ + C_ZA + h * 256 + e2);
    const float* ng = p.in[I_NORMG] + (size_t)l * D + h * 256 + e2;
    float y0 = (hv[0] - mean) * rstd * ng[0] * silu(bflo(zv));
    float y1 = (hv[1] - mean) * rstd * ng[1] * silu(bfhi(zv));
    __hip_atomic_store((unsigned*)((bf16_t*)(p.ws + W_Y) + (R0 + t) * D + h * 256 + e2), pk2(y0, y1), __ATOMIC_RELAXED,
                       __HIP_MEMORY_SCOPE_AGENT);
  }
  if (tid < 256) {
    float nn = decay * sn0[tid];
#pragma unroll
    for (int s = 0; s < 4; ++s) nn += sk[s * 256 + tid];
    p.out[O_NS + sidx * 256 + tid] = nn;
  }
  if (tid == 0) p.out[O_MS + sidx] = mm[3];
  __syncthreads();
}

__device__ __forceinline__ void gmlp_prompt(const Params& p, int l, int b, int chunk, int g, char* smem) {
  const int tid = otid(), lane = tid & 63, wid = tid >> 6, fr = lane & 15, fq = lane >> 4, wr = wid >> 2, wc = wid & 3;
  bf16_t* sVn = (bf16_t*)smem;
  bf16_t* sW = (bf16_t*)(smem + 69632);
  float* sMu = (float*)(smem + 69632 + 34816);
  float* sRs = sMu + 128;
  const bf16_t* P = (const bf16_t*)(p.ws + W_P);
  const size_t R0 = (size_t)b * SEQ + chunk * 128;
  if (tid < 128) {
    const float2* st = (const float2*)(p.ws + W_ST) + R0 + tid;
    float a = 0.f, q = 0.f;
#pragma unroll
    for (int k = 0; k < 16; ++k) { const float2 v = st[(size_t)k * NPR]; a += v.x; q += v.y; }
    const float mean = a * (1.f / D);
    sMu[tid] = mean;
    sRs[tid] = rsqrtf(fmaxf(q * (1.f / D) - mean * mean, 0.f) + EPS);
  }
  __syncthreads();
  const float* lg = p.in[I_GLNG] + (size_t)l * D + g * 256;
  const float* lb = p.in[I_GLNB] + (size_t)l * D + g * 256;
#pragma unroll
  for (int i = 0; i < 8; ++i) {
    int c = tid + 512 * i, r = c >> 5, c8 = c & 31;
    float f[8];
    unpack8(*(const uint4*)(P + (R0 + r) * NPJ + C_VB + g * 256 + c8 * 8), f);
    const float mu = sMu[r], rs = sRs[r];
    const float4 g0 = *(const float4*)(lg + c8 * 8), g1 = *(const float4*)(lg + c8 * 8 + 4);
    const float4 b0 = *(const float4*)(lb + c8 * 8), b1 = *(const float4*)(lb + c8 * 8 + 4);
    f[0] = (f[0] - mu) * rs * g0.x + b0.x; f[1] = (f[1] - mu) * rs * g0.y + b0.y;
    f[2] = (f[2] - mu) * rs * g0.z + b0.z; f[3] = (f[3] - mu) * rs * g0.w + b0.w;
    f[4] = (f[4] - mu) * rs * g1.x + b1.x; f[5] = (f[5] - mu) * rs * g1.y + b1.y;
    f[6] = (f[6] - mu) * rs * g1.z + b1.z; f[7] = (f[7] - mu) * rs * g1.w + b1.w;
    *(uint4*)(sVn + r * 272 + c8 * 8) = pack8(f);
  }
  const bf16_t* wm = (const bf16_t*)(p.ws + W_WM) + (size_t)(l * 4 + g) * 16384;
#pragma unroll
  for (int i = 0; i < 4; ++i) {
    int c = tid + 512 * i, r = c >> 4, c8 = c & 15;
    *(uint4*)(sW + r * 136 + c8 * 8) = *(const uint4*)(wm + r * 128 + c8 * 8);
  }
  __syncthreads();
  f32x4 acc[4][4];
#pragma unroll
  for (int m = 0; m < 4; ++m)
#pragma unroll
    for (int n = 0; n < 4; ++n) acc[m][n] = f32x4{0.f, 0.f, 0.f, 0.f};
#pragma unroll
  for (int kk = 0; kk < 4; ++kk) {
    bf16x8 tf[4];
#pragma unroll
    for (int m = 0; m < 4; ++m) tf[m] = *(const bf16x8*)(sW + (wr * 64 + m * 16 + fr) * 136 + kk * 32 + fq * 8);
#pragma unroll
    for (int n = 0; n < 4; ++n) {
      bf16x8 cf = frag_t(sVn, 272, wc * 64 + n * 16, kk * 32, lane);
#pragma unroll
      for (int m = 0; m < 4; ++m) acc[m][n] = mfma16(cf, tf[m], acc[m][n]);
    }
  }
  bf16_t* Y1 = (bf16_t*)(p.ws + W_Y) + (size_t)MT * D;
  const float* bs = p.in[I_GBS] + (size_t)(l * 4 + g) * 128;
#pragma unroll
  for (int m = 0; m < 4; ++m) {
    const int t = wr * 64 + m * 16 + fr;
    const float bsv = bs[t];
    const size_t row = R0 + t;
#pragma unroll
    for (int n = 0; n < 4; ++n) {
      const int col = g * 256 + wc * 64 + n * 16 + fq * 4;
      const uint2 uv = *(const uint2*)(P + row * NPJ + C_UB + col);
      const uint2 zv = *(const uint2*)(P + row * NPJ + C_ZB + col);
      const float u[4] = {bflo(uv.x), bfhi(uv.x), bflo(uv.y), bfhi(uv.y)};
      const float z[4] = {bflo(zv.x), bfhi(zv.x), bflo(zv.y), bfhi(zv.y)};
      float y[4];
#pragma unroll
      for (int r = 0; r < 4; ++r) y[r] = u[r] * (acc[m][n][r] + bsv) * silu(z[r]);
      uint2 o; o.x = pk2(y[0], y[1]); o.y = pk2(y[2], y[3]);
      *(uint2*)(Y1 + row * D + col) = o;
    }
  }
  __syncthreads();
}

__device__ __forceinline__ void gmlp_sample(const Params& p, int l, int b, char* smem) {
  const int tid = otid(), lane = tid & 63, wid = tid >> 6;
  float* svn = (float*)smem;
  const bf16_t* P = (const bf16_t*)(p.ws + W_P);
  const size_t R0 = (size_t)NPR + b * 4;
  if (wid < 4) {
    const int t = wid;
    const bf16_t* rp = P + (R0 + t) * NPJ + C_VB;
    float f[16];
    unpack8(*(const uint4*)(rp + lane * 8), f);
    unpack8(*(const uint4*)(rp + 512 + lane * 8), f + 8);
    float a = 0.f;
#pragma unroll
    for (int e = 0; e < 16; ++e) a += f[e];
    const float mean = wave_sum(a) * (1.f / D);
    float q = 0.f;
#pragma unroll
    for (int e = 0; e < 16; ++e) { f[e] -= mean; q += f[e] * f[e]; }
    const float rs = rsqrtf(wave_sum(q) * (1.f / D) + EPS);
    const float* lg = p.in[I_GLNG] + (size_t)l * D;
    const float* lb = p.in[I_GLNB] + (size_t)l * D;
    float* ov = p.out + O_VS + (((size_t)l * 128 + b) * 4 + t) * D;
#pragma unroll
    for (int hh = 0; hh < 2; ++hh) {
      const int c0 = hh * 512 + lane * 8;
#pragma unroll
      for (int e = 0; e < 8; ++e) f[hh * 8 + e] = f[hh * 8 + e] * rs * lg[c0 + e] + lb[c0 + e];
      *(float4*)(svn + t * 1024 + c0) = float4{f[hh * 8], f[hh * 8 + 1], f[hh * 8 + 2], f[hh * 8 + 3]};
      *(float4*)(svn + t * 1024 + c0 + 4) = float4{f[hh * 8 + 4], f[hh * 8 + 5], f[hh * 8 + 6], f[hh * 8 + 7]};
      *(float4*)(ov + c0) = float4{f[hh * 8], f[hh * 8 + 1], f[hh * 8 + 2], f[hh * 8 + 3]};
      *(float4*)(ov + c0 + 4) = float4{f[hh * 8 + 4], f[hh * 8 + 5], f[hh * 8 + 6], f[hh * 8 + 7]};
    }
  }
  __syncthreads();
  bf16_t* Y1 = (bf16_t*)(p.ws + W_Y) + (size_t)MT * D;
#pragma unroll
  for (int i = 0; i < 8; ++i) {
    const int idx = tid + 512 * i, t = idx >> 10, c = idx & 1023, g = c >> 8;
    const float* wrow = p.in[I_GWS] + ((size_t)(l * 4 + g) * 128 + t) * 128;
    float mixed = p.in[I_GBS][(size_t)(l * 4 + g) * 128 + t];
#pragma unroll
    for (int s = 0; s < 4; ++s)
      if (s <= t) mixed += wrow[s] * svn[s * 1024 + c];
    const float u = bf2f(P[(R0 + t) * NPJ + C_UB + c]), z = bf2f(P[(R0 + t) * NPJ + C_ZB + c]);
    __hip_atomic_store(Y1 + (R0 + t) * D + c, f2bf(u * mixed * silu(z)), __ATOMIC_RELAXED, __HIP_MEMORY_SCOPE_AGENT);
  }
  __syncthreads();
}

__device__ __forceinline__ void lru_gemm_pass(const Params& p, int l, int mat, int cp, const bf16_t* sX, bf16_t* sWt,
                                              f32x4 (&acc)[8][2]) {
  const int tid = otid(), lane = tid & 63, wid = tid >> 6, fr = lane & 15, fq = lane >> 4;
  const bf16_t* src = (const bf16_t*)(p.ws + W_WTL) + (size_t)((l * 2 + mat) * 8 + cp * 2) * 16384;
  __syncthreads();
#pragma unroll
  for (int i = 0; i < 8; ++i) {
    int c = tid + 512 * i, r = c >> 4, c8 = c & 15;
    *(uint4*)(sWt + r * 136 + c8 * 8) = *(const uint4*)(src + r * 128 + c8 * 8);
  }
  __syncthreads();
  const int kb = (wid >> 2) * 128;
#pragma unroll
  for (int m = 0; m < 8; ++m) { acc[m][0] = f32x4{0.f, 0.f, 0.f, 0.f}; acc[m][1] = f32x4{0.f, 0.f, 0.f, 0.f}; }
#pragma unroll
  for (int kk = 0; kk < 4; ++kk) {
    bf16x8 wf0 = *(const bf16x8*)(sWt + (wid * 32 + fr) * 136 + kk * 32 + fq * 8);
    bf16x8 wf1 = *(const bf16x8*)(sWt + (wid * 32 + 16 + fr) * 136 + kk * 32 + fq * 8);
#pragma unroll
    for (int m = 0; m < 8; ++m) {
      bf16x8 xf = *(const bf16x8*)(sX + (m * 16 + fr) * 264 + kb + kk * 32 + fq * 8);
      acc[m][0] = mfma16(xf, wf0, acc[m][0]);
      acc[m][1] = mfma16(xf, wf1, acc[m][1]);
    }
  }
}

__device__ __forceinline__ void lru_tile(const Params& p, int l, int tile, int cp, bool sample, char* smem) {
  const int tid = otid(), lane = tid & 63, wid = tid >> 6, fr = lane & 15, fq = lane >> 4;
  bf16_t* sX = (bf16_t*)smem;
  bf16_t* sWt = (bf16_t*)(smem + 67584);
  const bf16_t* P = (const bf16_t*)(p.ws + W_P);
  {
    const int cg8 = tid & 31, tg = tid >> 5, c = cp * 256 + cg8 * 8;
    float w0[8], w1[8], w2[8], w3[8], bb[8];
    const float* cw = p.in[I_CONVW] + (size_t)l * 4 * D + c;
#pragma unroll
    for (int e = 0; e < 8; ++e) { w0[e] = cw[e]; w1[e] = cw[D + e]; w2[e] = cw[2 * D + e]; w3[e] = cw[3 * D + e]; bb[e] = p.in[I_CONVB][(size_t)l * D + c + e]; }
    if (!sample) {
      const int b = tile >> 4, tt0 = (tile & 15) * 128 + tg * 8;
      const size_t rb = (size_t)b * SEQ;
      float x3[8], x2[8], x1[8], cur[8];
#pragma unroll
      for (int e = 0; e < 8; ++e) { x3[e] = 0.f; x2[e] = 0.f; x1[e] = 0.f; }
      if (tt0 > 0) {
        unpack8(*(const uint4*)(P + (rb + tt0 - 3) * NPJ + C_XC + c), x3);
        unpack8(*(const uint4*)(P + (rb + tt0 - 2) * NPJ + C_XC + c), x2);
        unpack8(*(const uint4*)(P + (rb + tt0 - 1) * NPJ + C_XC + c), x1);
      }
#pragma unroll
      for (int i = 0; i < 8; ++i) {
        unpack8(*(const uint4*)(P + (rb + tt0 + i) * NPJ + C_XC + c), cur);
        float xc[8];
#pragma unroll
        for (int e = 0; e < 8; ++e) xc[e] = bb[e] + w0[e] * x3[e] + w1[e] * x2[e] + w2[e] * x1[e] + w3[e] * cur[e];
        *(uint4*)(sX + (tg * 8 + i) * 264 + cg8 * 8) = pack8(xc);
        if ((tile & 15) == 15 && tg == 15 && i >= 5) {
          float* o = p.out + O_CONVP + (((size_t)l * 8 + b) * 3 + (i - 5)) * D + c;
          *(float4*)o = float4{cur[0], cur[1], cur[2], cur[3]};
          *(float4*)(o + 4) = float4{cur[4], cur[5], cur[6], cur[7]};
        }
#pragma unroll
        for (int e = 0; e < 8; ++e) { x3[e] = x2[e]; x2[e] = x1[e]; x1[e] = cur[e]; }
      }
    } else {
#pragma unroll
      for (int q = 0; q < 2; ++q) {
        const int bbi = tile * 32 + tg * 2 + q;
        const float* cb = p.in[I_SCONV] + ((size_t)l * 128 + bbi) * 3 * D + c;
        float x3[8], x2[8], x1[8], cur[8];
#pragma unroll
        for (int e = 0; e < 8; ++e) { x3[e] = cb[e]; x2[e] = cb[D + e]; x1[e] = cb[2 * D + e]; }
#pragma unroll
        for (int i = 0; i < 4; ++i) {
          unpack8(*(const uint4*)(P + ((size_t)NPR + bbi * 4 + i) * NPJ + C_XC + c), cur);
          float xc[8];
#pragma unroll
          for (int e = 0; e < 8; ++e) xc[e] = bb[e] + w0[e] * x3[e] + w1[e] * x2[e] + w2[e] * x1[e] + w3[e] * cur[e];
          *(uint4*)(sX + (tg * 8 + q * 4 + i) * 264 + cg8 * 8) = pack8(xc);
          if (i >= 1) {
            float* o = p.out + O_CONVS + (((size_t)l * 128 + bbi) * 3 + (i - 1)) * D + c;
            *(float4*)o = float4{cur[0], cur[1], cur[2], cur[3]};
            *(float4*)(o + 4) = float4{cur[4], cur[5], cur[6], cur[7]};
          }
#pragma unroll
          for (int e = 0; e < 8; ++e) { x3[e] = x2[e]; x2[e] = x1[e]; x1[e] = cur[e]; }
        }
      }
    }
  }
  f32x4 racc[8][2], iacc[8][2];
  lru_gemm_pass(p, l, 0, cp, sX, sWt, racc);
  lru_gemm_pass(p, l, 1, cp, sX, sWt, iacc);
  const bool first = (!sample) && ((tile & 15) == 0);
#pragma unroll
  for (int n = 0; n < 2; ++n) {
    const int jl = wid * 32 + n * 16 + fr, c = cp * 256 + jl;
    const float bav = p.in[I_BA][(size_t)l * D + c], bxv = p.in[I_BX][(size_t)l * D + c];
    const float ls8 = 8.f * logsig(p.in[I_LAM][(size_t)l * D + c]);
#pragma unroll
    for (int m = 0; m < 8; ++m) {
      int mo = m * 16 + fq * 4;
      asm volatile("" : "+v"(mo));
#pragma unroll
      for (int r = 0; r < 4; ++r) {
        const int t = mo + r;
        const float rg = sigm(racc[m][n][r] + bav), ig = sigm(iacc[m][n][r] + bxv);
        const float av = __expf(ls8 * rg);
        float mult = __builtin_amdgcn_sqrtf(fmaxf(1.f - av * av, 0.f));
        if (first && t == 0) mult = 1.f;
        racc[m][n][r] = av;
        iacc[m][n][r] = mult * ig * bf2f(sX[t * 264 + jl]);
      }
    }
  }
  if (sample) {
    bf16_t* Y2 = (bf16_t*)(p.ws + W_Y) + (size_t)2 * MT * D;
#pragma unroll
    for (int n = 0; n < 2; ++n) {
      const int c = cp * 256 + wid * 32 + n * 16 + fr;
#pragma unroll
      for (int m = 0; m < 8; ++m) {
        int bbi = tile * 32 + m * 4 + fq;
        asm volatile("" : "+v"(bbi));
        float hh = p.in[I_SH][((size_t)l * 128 + bbi) * D + c];
#pragma unroll
        for (int r = 0; r < 4; ++r) {
          hh = racc[m][n][r] * hh + iacc[m][n][r];
          const size_t row = (size_t)NPR + bbi * 4 + r;
          const float z = bf2f(P[row * NPJ + C_ZC + c]);
          __hip_atomic_store(Y2 + row * D + c, f2bf(hh * silu(z)), __ATOMIC_RELAXED, __HIP_MEMORY_SCOPE_AGENT);
        }
        p.out[O_HS + ((size_t)l * 128 + bbi) * D + c] = hh;
      }
    }
  } else {
    bf16_t* LH = (bf16_t*)(p.ws + W_LH);
    bf16_t* LA = (bf16_t*)(p.ws + W_LA);
    const size_t rb = (size_t)(tile >> 4) * SEQ + (tile & 15) * 128;
#pragma unroll
    for (int n = 0; n < 2; ++n) {
      const int c = cp * 256 + wid * 32 + n * 16 + fr;
      float cA = 1.f, cH = 0.f;
#pragma unroll
      for (int m = 0; m < 8; ++m) {
        int mo = m * 16 + fq * 4;
        asm volatile("" : "+v"(mo));
        float la_[4], lh_[4];
        la_[0] = racc[m][n][0]; lh_[0] = iacc[m][n][0];
#pragma unroll
        for (int r = 1; r < 4; ++r) { la_[r] = la_[r - 1] * racc[m][n][r]; lh_[r] = racc[m][n][r] * lh_[r - 1] + iacc[m][n][r]; }
        float A = la_[3], H = lh_[3];
        float pA = SHU(A, 16), pH = SHU(H, 16);
        if (fq >= 1) { H = A * pH + H; A = A * pA; }
        pA = SHU(A, 32); pH = SHU(H, 32);
        if (fq >= 2) { H = A * pH + H; A = A * pA; }
        float eA = SHU(A, 16), eH = SHU(H, 16);
        if (fq == 0) { eA = 1.f; eH = 0.f; }
        const float tA = shf(A, 48 + fr), tH = shf(H, 48 + fr);
        const float PA = cA * eA, PH = eA * cH + eH;
#pragma unroll
        for (int r = 0; r < 4; ++r) {
          const size_t row = rb + mo + r;
          LA[row * D + c] = f2bf(PA * la_[r]);
          LH[row * D + c] = f2bf(la_[r] * PH + lh_[r]);
        }
        cH = tA * cH + tH;
        cA = cA * tA;
      }
      if (fq == 0) {
        float* LE = (float*)(p.ws + W_LE) + ((size_t)tile * D + c) * 2;
        LE[0] = cA; LE[1] = cH;
      }
    }
  }
  __syncthreads();
}

__device__ __forceinline__ void lru_fix(const Params& p, int l, int tile, int half) {
  const int tid = otid(), c = tid * 2;
  const int b = tile >> 4, seg = tile & 15;
  const float* LE = (const float*)(p.ws + W_LE);
  float H0 = 0.f, H1 = 0.f;
  for (int k = 0; k < seg; ++k) {
    const float4 e = *(const float4*)(LE + ((size_t)(b * 16 + k) * D + c) * 2);
    H0 = e.x * H0 + e.y;
    H1 = e.z * H1 + e.w;
  }
  const bf16_t* P = (const bf16_t*)(p.ws + W_P);
  const bf16_t* LH = (const bf16_t*)(p.ws + W_LH);
  const bf16_t* LA = (const bf16_t*)(p.ws + W_LA);
  bf16_t* Y2 = (bf16_t*)(p.ws + W_Y) + (size_t)2 * MT * D;
  const size_t R0 = (size_t)b * SEQ + seg * 128 + half * 64;
#pragma unroll 8
  for (int rr = 0; rr < 64; ++rr) {
    const size_t row = R0 + rr;
    const unsigned hl = *(const unsigned*)(LH + row * D + c);
    const unsigned al = *(const unsigned*)(LA + row * D + c);
    const unsigned zv = *(const unsigned*)(P + row * NPJ + C_ZC + c);
    const float h0 = bflo(hl) + bflo(al) * H0, h1 = bfhi(hl) + bfhi(al) * H1;
    *(unsigned*)(Y2 + row * D + c) = pk2(h0 * silu(bflo(zv)), h1 * silu(bfhi(zv)));
  }
  if (seg == 15 && half == 1) {
    const float4 e = *(const float4*)(LE + ((size_t)(b * 16 + 15) * D + c) * 2);
    float2 o = {e.x * H0 + e.y, e.z * H1 + e.w};
    *(float2*)(p.out + O_HP + ((size_t)l * 8 + b) * D + c) = o;
  }
}

__device__ __forceinline__ void x4_unit(const Params& p, int l, int pm, int pn, char* smem) {
  float* MF = (float*)(p.ws + W_MF);
  bf16_t* MB = (bf16_t*)(p.ws + W_MB);
  const bf16_t* const P = (const bf16_t*)(p.ws + W_P);
#pragma unroll 1
  for (int br = 0; br < 3; ++br) {
    const bf16_t* A = (const bf16_t*)(p.ws + W_Y) + (size_t)br * MT * D;
    const bf16_t* Bt = (const bf16_t*)(p.ws + W_WTP) + (size_t)(l * 4 + br) * D * D;
    f32x4 acc[2][2][4][2];
    gemm_tile(A, Bt, pm * 256, pn * 256, smem, acc);
    EPI_IDX
    EPI_LOOP {
      const int row = pm * 256 + ai * 128 + wr * 64 + m * 16 + fr, col = pn * 256 + bj * 128 + wc * 32 + n * 16 + fq * 4;
      const uint2 gv = *(const uint2*)(P + (size_t)row * NPJ + C_GA + br * 1024 + col);
      float4 v = {acc[ai][bj][m][n][0] * sigm(bflo(gv.x)), acc[ai][bj][m][n][1] * sigm(bfhi(gv.x)),
                  acc[ai][bj][m][n][2] * sigm(bflo(gv.y)), acc[ai][bj][m][n][3] * sigm(bfhi(gv.y))};
      uint2* mf = (uint2*)((bf16_t*)MF + (size_t)row * D + col);
      if (br == 0) {
        uint2 ob; ob.x = pk2(v.x, v.y); ob.y = pk2(v.z, v.w); *mf = ob;
      } else {
        const uint2 o = *mf;
        v.x += bflo(o.x); v.y += bfhi(o.x); v.z += bflo(o.y); v.w += bfhi(o.y);
        uint2 ob; ob.x = pk2(v.x, v.y); ob.y = pk2(v.z, v.w);
        if (br == 1) *mf = ob;
        else *(uint2*)(MB + (size_t)row * D + col) = ob;
      }
    }
  }
}
__device__ __forceinline__ void x5_unit(const Params& p, int l, int pm, int pn, char* smem) {
  const bf16_t* A = (const bf16_t*)(p.ws + W_MB);
  const bf16_t* Bt = (const bf16_t*)(p.ws + W_WTP) + (size_t)(l * 4 + 3) * D * D;
  float* PRE = (float*)(p.ws + W_PRE);
  const float* XF = (const float*)(p.ws + W_XF);
  f32x4 acc[2][2][4][2];
  gemm_tile(A, Bt, pm * 256, pn * 256, smem, acc);
  EPI_IDX
  EPI_LOOP {
    const int row = pm * 256 + ai * 128 + wr * 64 + m * 16 + fr, col = pn * 256 + bj * 128 + wc * 32 + n * 16 + fq * 4;
    const float* xr = (l == 0) ? (row < NPR ? p.in[I_XP] + (size_t)row * D : p.in[I_XS] + (size_t)(row - NPR) * D)
                               : XF + (size_t)row * D;
    const float4 xv = *(const float4*)(xr + col);
    float4 v = {ALPHA * xv.x + acc[ai][bj][m][n][0], ALPHA * xv.y + acc[ai][bj][m][n][1],
                ALPHA * xv.z + acc[ai][bj][m][n][2], ALPHA * xv.w + acc[ai][bj][m][n][3]};
    *(float4*)(PRE + (size_t)row * D + col) = v;
  }
}
__device__ __forceinline__ void dep_signal(unsigned* ctr) {
  asm volatile("s_waitcnt vmcnt(0)" ::: "memory");
  __syncthreads();
  if (threadIdx.x == 0) {
    __builtin_amdgcn_fence(__ATOMIC_RELEASE, "agent");
    asm volatile("s_waitcnt vmcnt(0)" ::: "memory");
    (void)__hip_atomic_fetch_add(ctr, 1u, __ATOMIC_RELAXED, __HIP_MEMORY_SCOPE_AGENT);
  }
}
__device__ __forceinline__ void dep_signal_wt(unsigned* ctr) {
  asm volatile("s_waitcnt vmcnt(0)" ::: "memory");
  __syncthreads();
  if (threadIdx.x == 0) (void)__hip_atomic_fetch_add(ctr, 1u, __ATOMIC_RELAXED, __HIP_MEMORY_SCOPE_AGENT);
}
__device__ __forceinline__ void dep_wait(unsigned* ctr, unsigned target) {
  if (threadIdx.x == 0) {
    unsigned sp = 0;
    while (__hip_atomic_load(ctr, __ATOMIC_RELAXED, __HIP_MEMORY_SCOPE_AGENT) < target) {
      __builtin_amdgcn_s_sleep(2);
      if (++sp > (1u << 24)) break;
    }
    __builtin_amdgcn_fence(__ATOMIC_ACQUIRE, "agent");
    asm volatile("s_waitcnt vmcnt(0)" ::: "memory");
  }
  __syncthreads();
}

#define XB_TMO 128
#define XB_XCNT(j) (256 + 64 * (j))
#define XB_XSUB(j) (1280 + 64 * (j))
#define XB_XGEN(j) (2304 + 64 * (j))
#define XB_TOP 3328
#define XB_TOPGEN 3392
#define XCD_BAR_WORDS 3456
#define XB_SPIN_CAP (1u << 22)
__device__ __forceinline__ unsigned xb_ld(unsigned* p) { return __hip_atomic_load(p, __ATOMIC_RELAXED, __HIP_MEMORY_SCOPE_AGENT); }
__device__ __forceinline__ unsigned xb_add(unsigned* p, unsigned v) { return __hip_atomic_fetch_add(p, v, __ATOMIC_RELAXED, __HIP_MEMORY_SCOPE_AGENT); }
__device__ __forceinline__ unsigned xb_xcc_id() { return (unsigned)__builtin_amdgcn_s_getreg((3 << 11) | 20) & 0xFu; }
#define XB_SPIN(cond, bar) do { unsigned _sp = 0; while (cond) { __builtin_amdgcn_s_sleep(1); \
    if ((++_sp & 255u) == 0u) { if (xb_ld(&(bar)[XB_TMO])) break; if (_sp > XB_SPIN_CAP) { atomicAdd(&(bar)[XB_TMO], 1u); break; } } } } while (0)
struct XcdBarrier { unsigned* bar; unsigned x; volatile LDSP(unsigned) st; };
__device__ __forceinline__ XcdBarrier xcd_barrier_post(unsigned* bar, volatile LDSP(unsigned) st) {
  XcdBarrier b; b.bar = bar; b.x = xb_xcc_id(); b.st = st;
  if (threadIdx.x == 0) (void)xb_add(&bar[XB_XCNT(b.x)], 1u);
  return b;
}
__device__ __forceinline__ void xcd_barrier_complete(unsigned* bar, unsigned x, unsigned& nloc, unsigned& nx) {
  const unsigned G = gridDim.x * gridDim.y * gridDim.z;
  unsigned sum, cnt, mine, sp = 0u;
  for (;;) {
    sum = 0u; cnt = 0u; mine = 0u;
#pragma unroll
    for (unsigned j = 0; j < 16; ++j) { const unsigned c = xb_ld(&bar[XB_XCNT(j)]); sum += c; cnt += (c > 0u) ? 1u : 0u; mine = (j == x) ? c : mine; }
    if (sum == G) break;
    __builtin_amdgcn_s_sleep(1);
    if ((++sp & 255u) == 0u) { if (xb_ld(&bar[XB_TMO])) break; if (sp > XB_SPIN_CAP) { atomicAdd(&bar[XB_TMO], 1u); break; } }
  }
  nloc = mine > 0u ? mine : 1u; nx = cnt > 0u ? cnt : 1u;
}
__device__ __forceinline__ void xcd_barrier(const XcdBarrier& b) {
  asm volatile("s_waitcnt vmcnt(0)" ::: "memory");
  __syncthreads();
  if (threadIdx.x == 0) {
    unsigned* bar = b.bar;
    __builtin_amdgcn_s_waitcnt(0);
    unsigned nloc = b.st[0], nx = b.st[1];
    if (nloc == 0u) { xcd_barrier_complete(bar, b.x, nloc, nx); b.st[0] = nloc; b.st[1] = nx; }
    const unsigned old = xb_add(&bar[XB_XSUB(b.x)], 1u);
    const unsigned gen = old / nloc;
    if (old + 1u == (gen + 1u) * nloc) {
      __builtin_amdgcn_fence(__ATOMIC_RELEASE, "agent");
      asm volatile("s_waitcnt vmcnt(0)" ::: "memory");
      const unsigned og = xb_add(&bar[XB_TOP], 1u);
      const unsigned tg = og / nx;
      if (og + 1u == (tg + 1u) * nx) xb_add(&bar[XB_TOPGEN], 1u);
      else XB_SPIN(xb_ld(&bar[XB_TOPGEN]) == tg, bar);
      __builtin_amdgcn_fence(__ATOMIC_ACQUIRE, "agent");
      xb_add(&bar[XB_XGEN(b.x)], 1u);
      asm volatile("s_waitcnt vmcnt(0)" ::: "memory");
    } else {
      XB_SPIN(xb_ld(&bar[XB_XGEN(b.x)]) == gen, bar);
      __builtin_amdgcn_fence(__ATOMIC_ACQUIRE, "agent");
      asm volatile("s_waitcnt vmcnt(0)" ::: "memory");
    }
  }
  __syncthreads();
}

__global__ void __launch_bounds__(512) mega(Params p) {
  extern __shared__ __attribute__((aligned(16))) char smem[];
  cg::grid_group grid = cg::this_grid();
  const int G = gridDim.x, bid = blockIdx.x;
  volatile LDSP(unsigned) xst = (volatile LDSP(unsigned))(smem + LDS_TOTAL - 16);
  if (threadIdx.x == 0) { xst[0] = 0u; xst[1] = 0u; xst[2] = 0u; xst[3] = 0u; }
  __syncthreads();
  XcdBarrier xb = xcd_barrier_post((unsigned*)(p.ws + W_BAR), xst);
  phase_convert(p, smem);
  row_pass(p, 0, smem);
  grid.sync();
#pragma unroll 1
  for (int l = 0; l < NL; ++l) {
    for (int it = bid; it < 32; it += G) mlstm_scalars(p, l, it, smem);
    REP(0) {
      const bf16_t* A = (const bf16_t*)(p.ws + W_XB);
      const bf16_t* Bt = (const bf16_t*)(p.ws + W_WTIN) + (size_t)l * NPJ * D;
      const float* bias = p.in[I_BIN] + (size_t)l * INW;
      bf16_t* const P = (bf16_t*)(p.ws + W_P);
      bool primed = false;
#pragma unroll 1
      for (int L = bid; L < 66 * 52; L += G) {
        int pm, pn; tile_map(L, 66, 52, pm, pn, 4);
        f32x4 acc[2][2][4][2];
        gemm_tile(A, Bt, pm * 256, pn * 256, smem, acc, primed);
        EPI_IDX
        float4 bvv[2][2];
#pragma unroll
        for (int bj = 0; bj < 2; ++bj)
#pragma unroll
          for (int n = 0; n < 2; ++n) {
            const int col = pn * 256 + bj * 128 + wc * 32 + n * 16 + fq * 4;
            bvv[bj][n] = *(const float4*)(bias + col + (col >= 5120 ? 8 : 0));
          }
        asm volatile("s_waitcnt vmcnt(0)" ::: "memory");
        primed = (L + G < 66 * 52);
        if (primed) { int pm2, pn2; tile_map(L + G, 66, 52, pm2, pn2, 4); gemm_tile(A, Bt, pm2 * 256, pn2 * 256, smem, acc, false, true); }
        const bool vbt = (pm < 64) && (pn >= 24) && (pn < 28);
        float st1[2][4], st2[2][4];
#pragma unroll
        for (int ai = 0; ai < 2; ++ai)
#pragma unroll
          for (int m = 0; m < 4; ++m) { st1[ai][m] = 0.f; st2[ai][m] = 0.f; }
        EPI_LOOP {
          const int row = pm * 256 + ai * 128 + wr * 64 + m * 16 + fr, col = pn * 256 + bj * 128 + wc * 32 + n * 16 + fq * 4;
          const float4 bv = bvv[bj][n];
          const float v0 = acc[ai][bj][m][n][0] + bv.x, v1 = acc[ai][bj][m][n][1] + bv.y;
          const float v2 = acc[ai][bj][m][n][2] + bv.z, v3 = acc[ai][bj][m][n][3] + bv.w;
          if (vbt) {
            st1[ai][m] += (v0 + v1) + (v2 + v3);
            st2[ai][m] += (v0 * v0 + v1 * v1) + (v2 * v2 + v3 * v3);
          }
          uint2 o;
          o.x = pk2(v0, v1);
          o.y = pk2(v2, v3);
          *(uint2*)(P + (size_t)row * NPJ + col) = o;
        }
        if (vbt) {
          float2* st = (float2*)(p.ws + W_ST) + (size_t)((pn - 24) * 4 + wc) * NPR;
#pragma unroll
          for (int ai = 0; ai < 2; ++ai)
#pragma unroll
            for (int m = 0; m < 4; ++m) {
              float s1 = st1[ai][m], s2 = st2[ai][m];
              s1 += SHX(s1, 16); s1 += SHX(s1, 32);
              s2 += SHX(s2, 16); s2 += SHX(s2, 32);
              if (fq == 0) st[pm * 256 + ai * 128 + wr * 64 + m * 16 + fr] = float2{s1, s2};
            }
        }
      }
    }
    GSYNC;
    {
      constexpr int Q_S = 656, Q_X4 = Q_S + 8, Q_F1 = Q_X4 + 256, Q_X5 = Q_F1 + 8, Q_FN = Q_X5 + 128, Q_F2 = Q_FN + 128, Q_LR = Q_F2 + 512,
                    Q_F3 = Q_LR + 128, Q_G2 = Q_F3 + 512;
      unsigned* qbase = (unsigned*)(p.ws + W_QCT) + l * 64;
      volatile LDSP(int) qslot = (volatile LDSP(int))(smem + LDS_TOTAL - 32);
      if (threadIdx.x == 0) qslot[0] = (int)xb_add(qbase, 1u);
      __syncthreads();
      int it = qslot[0];
#pragma unroll 1
      while (it < Q_G2) {
        __syncthreads();
        int nxt = 0;
        int r = it, fq_ = -1, fbh = 0;
        if (r >= Q_X4 && r < Q_F1) { fq_ = 15 - ((r - Q_X4) >> 5); fbh = (r - Q_X4) & 31; }
        else if (r >= Q_FN && r < Q_F2) { fq_ = 7 - ((r - Q_FN) >> 5); fbh = (r - Q_FN) & 31; }
        else if (r >= Q_LR && r < Q_F3) { fq_ = 3 - ((r - Q_LR) >> 5); fbh = (r - Q_LR) & 31; }
        if (fq_ < 0 && threadIdx.x == 0) nxt = (int)xb_add(qbase, 1u);
        if (fq_ >= 0) { mlstm_flash(p, l, fbh, fq_, smem); if (threadIdx.x == 0) nxt = (int)xb_add(qbase, 1u); }
        else if (r < Q_S) {
          if (r < 512) mlstm_sample(p, l, r >> 2, r & 3, smem);
          else if (r < 640) gmlp_sample(p, l, r - 512, smem);
          else lru_tile(p, l, (r - 640) >> 2, r & 3, true, smem);
          dep_signal_wt(qbase + 16);
        }
        else if (r < Q_X4) { r -= Q_S; dep_wait(qbase + 16, 656u); x4_unit(p, l, 64 + (r >> 2), r & 3, smem); dep_signal(qbase + 32 + 16 * (r >> 2)); }
        else if (r < Q_X5) { r -= Q_F1; dep_wait(qbase + 32 + 16 * (r >> 2), 4u); x5_unit(p, l, 64 + (r >> 2), r & 3, smem); }
        else if (r < Q_FN) { r -= Q_X5; mlstm_final(p, l, r >> 2, r & 3, smem); }
        else if (r < Q_LR) { r -= Q_F2; lru_tile(p, l, r >> 2, r & 3, false, smem); }
        else { r -= Q_F3; gmlp_prompt(p, l, r >> 6, (r >> 2) & 15, r & 3, smem); }
        if (threadIdx.x == 0) qslot[0] = nxt;
        __syncthreads();
        it = qslot[0];
      }
    }
    GSYNC;
    for (int it = bid; it < 256; it += G) lru_fix(p, l, it >> 1, it & 1);
    GSYNC;
#pragma unroll 1
    for (int L = bid; L < 64 * 4; L += G) { int pm, pn; tile_map(L, 64, 4, pm, pn); x4_unit(p, l, pm, pn, smem); }
    GSYNC;
#pragma unroll 1
    for (int L = bid; L < 64 * 4; L += G) { int pm, pn; tile_map(L, 64, 4, pm, pn); x5_unit(p, l, pm, pn, smem); }
    GSYNC;
    row_pass(p, l + 1, smem);
    GSYNC;
  }
}

extern "C" void kernel_launch(void* const* d_in, const int* in_sizes, int n_in, void* d_out, int out_size, void* d_ws,
                              size_t ws_size, hipStream_t stream) {
  constexpr size_t kLds = LDS_TOTAL;
  static int grid_blocks = 0;
  if (!grid_blocks) {
    int dev = 0, cus = 0, per_cu = 0;
    (void)hipGetDevice(&dev);
    (void)hipDeviceGetAttribute(&cus, hipDeviceAttributeMultiprocessorCount, dev);
    (void)hipFuncSetAttribute((const void*)mega, hipFuncAttributeMaxDynamicSharedMemorySize, (int)kLds);
    (void)hipOccupancyMaxActiveBlocksPerMultiprocessor(&per_cu, (const void*)mega, 512, kLds);
    if (per_cu < 1) per_cu = 1;
    grid_blocks = cus * per_cu;
    if (grid_blocks % 8) grid_blocks -= grid_blocks % 8;
    if (ws_size < W_END || n_in != 27 || (size_t)out_size != O_END)
      fprintf(stderr, "kernel_launch: unexpected sizes ws %zu (need %zu) n_in %d out %d (expect %zu)\n", ws_size,
              (size_t)W_END, n_in, out_size, (size_t)O_END);
  }
  (void)hipMemsetAsync((char*)d_ws + W_BAR, 0, W_CTL_END - W_BAR, stream);
  Params p{};
  for (int i = 0; i < 27; ++i) p.in[i] = (const float*)d_in[i];
  p.out = (float*)d_out;
  p.ws = (char*)d_ws;
  void* args[] = {&p};
  hipError_t e = hipLaunchCooperativeKernel((const void*)mega, dim3(grid_blocks), dim3(512), args, kLds, stream);
  if (e != hipSuccess) fprintf(stderr, "cooperative launch failed: %s (grid %d)\n", hipGetErrorString(e), grid_blocks);
}
```

```cpp
#include <hip/hip_runtime.h>
#include <hip/hip_cooperative_groups.h>
#include <cstdio>
#include <cstdint>
namespace cg = cooperative_groups;

typedef unsigned short bf16_t;
typedef short bf16x8 __attribute__((ext_vector_type(8)));
typedef short s16x4 __attribute__((ext_vector_type(4)));
typedef float f32x4 __attribute__((ext_vector_type(4)));
#define LDSP(T) __attribute__((address_space(3))) T*

constexpr int D = 1024, NPR = 16384, NSM = 512, MT = 16896, NL = 4, SEQ = 2048;
constexpr int INW = 13320, NPJ = 13312;
constexpr int C_Q = 0, C_K = 1024, C_V = 2048, C_O = 3072, C_ZA = 4096, C_UB = 5120, C_VB = 6144, C_ZB = 7168,
              C_XC = 8192, C_ZC = 9216, C_GA = 10240;
constexpr float ALPHA = 1.6817928305074292f;
constexpr float EPS = 1e-5f;
constexpr int LDS_TOTAL = 150 * 1024;
#ifndef DUP_PHASE
#define DUP_PHASE -1
#endif
#define GSYNC xcd_barrier(xb)
#define REP(k) for (int rep_ = 0; rep_ < ((DUP_PHASE == (k)) ? 2 : 1); ++rep_)

constexpr size_t W_WTIN = 0;
constexpr size_t W_WTP = W_WTIN + (size_t)NL * NPJ * D * 2;
constexpr size_t W_WTL = W_WTP + (size_t)NL * 4 * D * D * 2;
constexpr size_t W_WM = W_WTL + (size_t)NL * 2 * 8 * 128 * 128 * 2;
constexpr size_t W_XB = W_WM + (size_t)NL * 4 * 128 * 128 * 2;
constexpr size_t W_XF = W_XB + (size_t)MT * D * 2;
constexpr size_t W_GATE = W_XF + (size_t)MT * D * 4;
constexpr size_t W_P = W_GATE + (size_t)MT * 8 * 4;
constexpr size_t W_PRE = W_P + (size_t)MT * NPJ * 2;
constexpr size_t W_MF = W_PRE + (size_t)MT * D * 4;
constexpr size_t W_MB = W_MF + (size_t)MT * D * 4;
constexpr size_t W_Y = W_MB + (size_t)MT * D * 2;
constexpr size_t W_G = W_Y + (size_t)3 * MT * D * 2;
constexpr size_t W_MX = W_G + (size_t)32 * 2048 * 4;
constexpr size_t W_EM = W_MX + (size_t)32 * 2048 * 4;
constexpr size_t W_LH = W_EM + (size_t)32 * 2048 * 4;
constexpr size_t W_LA = W_LH + (size_t)NPR * D * 2;
constexpr size_t W_LE = W_LA + (size_t)NPR * D * 2;
constexpr size_t W_BAR = W_LE + (size_t)8 * 16 * 1024 * 2 * 4;
constexpr size_t W_QCT = W_BAR + 3456 * 4;
constexpr size_t W_CTL_END = W_QCT + 4 * 256;
constexpr size_t W_ST = W_CTL_END;
constexpr size_t W_END = W_ST + (size_t)16 * NPR * 2 * 4;

constexpr size_t O_Y = 0;
constexpr size_t O_CP = (size_t)MT * D;
constexpr size_t O_NP = O_CP + (size_t)NL * 8 * 4 * 256 * 256;
constexpr size_t O_MP = O_NP + (size_t)NL * 8 * 4 * 256;
constexpr size_t O_CONVP = O_MP + (size_t)NL * 8 * 4;
constexpr size_t O_HP = O_CONVP + (size_t)NL * 8 * 3 * 1024;
constexpr size_t O_CS = O_HP + (size_t)NL * 8 * 1024;
constexpr size_t O_NS = O_CS + (size_t)NL * 128 * 4 * 256 * 256;
constexpr size_t O_MS = O_NS + (size_t)NL * 128 * 4 * 256;
constexpr size_t O_CONVS = O_MS + (size_t)NL * 128 * 4;
constexpr size_t O_HS = O_CONVS + (size_t)NL * 128 * 3 * 1024;
constexpr size_t O_VS = O_HS + (size_t)NL * 128 * 1024;
constexpr size_t O_END = O_VS + (size_t)NL * 128 * 4 * 1024;

enum { I_XP = 0, I_XS, I_SC, I_SN, I_SM, I_SCONV, I_SH, I_WIN, I_BIN, I_NORMG, I_GLNG, I_GLNB, I_GWS, I_GBS, I_CONVW,
       I_CONVB, I_WA, I_BA, I_WX, I_BX, I_LAM, I_WPA, I_WPB, I_WPC, I_WOUT, I_LNG, I_LNB };

struct Params {
  const float* in[27];
  float* out;
  char* ws;
};

__device__ __forceinline__ bf16_t f2bf(float f) {
  unsigned u = __float_as_uint(f);
  u += 0x7fffu + ((u >> 16) & 1u);
  return (bf16_t)(u >> 16);
}
__device__ __forceinline__ float bf2f(bf16_t h) { return __uint_as_float(((unsigned)h) << 16); }
__device__ __forceinline__ unsigned pk2(float a, float b) {
  unsigned r;
  asm("v_cvt_pk_bf16_f32 %0, %1, %2" : "=v"(r) : "v"(a), "v"(b));
  return r;
}
__device__ __forceinline__ float bflo(unsigned u) { return __uint_as_float(u << 16); }
__device__ __forceinline__ float bfhi(unsigned u) { return __uint_as_float(u & 0xffff0000u); }
__device__ __forceinline__ float sigm(float x) { return __builtin_amdgcn_rcpf(1.f + __expf(-x)); }
__device__ __forceinline__ float silu(float x) { return x * sigm(x); }
__device__ __forceinline__ float logsig(float x) { return fminf(x, 0.f) - log1pf(__expf(-fabsf(x))); }
__device__ __forceinline__ float shf(float v, int src) {
  return __int_as_float(__builtin_amdgcn_ds_bpermute(src << 2, __float_as_int(v)));
}
#define SHX(v, o) shf((v), lane ^ (o))
#define SHU(v, o) shf((v), (lane >= (o)) ? lane - (o) : lane)
__device__ __forceinline__ float wave_sum_l(float v, int lane) {
#pragma unroll
  for (int o = 1; o < 64; o <<= 1) v += shf(v, lane ^ o);
  return v;
}
#define wave_sum(v) wave_sum_l((v), lane)
__device__ __forceinline__ f32x4 mfma16(bf16x8 a, bf16x8 b, f32x4 c) {
  return __builtin_amdgcn_mfma_f32_16x16x32_bf16(a, b, c, 0, 0, 0);
}
__device__ __forceinline__ bf16x8 frag_t(const bf16_t* T, int stride, int r0, int k0, int lane) {
  const int fr = lane & 15, fq = lane >> 4;
  const bf16_t* q = T + (k0 + fq * 8 + (fr >> 2)) * stride + r0 + (fr & 3) * 4;
  s16x4 a = __builtin_amdgcn_ds_read_tr16_b64_v4i16((LDSP(s16x4))q);
  s16x4 b = __builtin_amdgcn_ds_read_tr16_b64_v4i16((LDSP(s16x4))(q + 4 * stride));
  bf16x8 r = {a[0], a[1], a[2], a[3], b[0], b[1], b[2], b[3]};
  return r;
}
__device__ __forceinline__ void unpack8(uint4 v, float* f) {
  f[0] = bflo(v.x); f[1] = bfhi(v.x); f[2] = bflo(v.y); f[3] = bfhi(v.y);
  f[4] = bflo(v.z); f[5] = bfhi(v.z); f[6] = bflo(v.w); f[7] = bfhi(v.w);
}
__device__ __forceinline__ uint4 pack8(const float* f) {
  uint4 o; o.x = pk2(f[0], f[1]); o.y = pk2(f[2], f[3]); o.z = pk2(f[4], f[5]); o.w = pk2(f[6], f[7]);
  return o;
}


typedef unsigned u32x4_t __attribute__((ext_vector_type(4)));
typedef unsigned u32x2_t __attribute__((ext_vector_type(2)));
__device__ __forceinline__ uint4 ldnt16(const void* p) { u32x4_t v = __builtin_nontemporal_load((const u32x4_t*)p); return make_uint4(v[0], v[1], v[2], v[3]); }
__device__ __forceinline__ uint2 ldnt8(const void* p) { u32x2_t v = __builtin_nontemporal_load((const u32x2_t*)p); return make_uint2(v[0], v[1]); }
__device__ __forceinline__ unsigned ldnt4(const void* p) { return __builtin_nontemporal_load((const unsigned*)p); }
__device__ __forceinline__ float4 ldnt16f(const void* p) { f32x4 v = __builtin_nontemporal_load((const f32x4*)p); return float4{v[0], v[1], v[2], v[3]}; }
__device__ __forceinline__ void stnt16f(void* p, float4 v) { __builtin_nontemporal_store(f32x4{v.x, v.y, v.z, v.w}, (f32x4*)p); }

__device__ __forceinline__ int otid() { int t = threadIdx.x; asm volatile("" : "+v"(t)); return t; }

__device__ __forceinline__ void tconv_item(const float* src, int lds_, bf16_t* dst, int ldd, int k0, int n0s, int n0d,
                                           float* scr, int lane) {
#pragma unroll 8
  for (int i = 0; i < 32; ++i) {
    const int kk = 2 * i + (lane >> 5);
    scr[kk * 33 + (lane & 31)] = __builtin_nontemporal_load(src + (size_t)(k0 + kk) * lds_ + n0s + (lane & 31));
  }
  const int c = lane & 7;
#pragma unroll
  for (int j = 0; j < 4; ++j) {
    const int n = (lane >> 3) + 8 * j;
    const float* t = scr + (8 * c) * 33 + n;
    uint4 o;
    o.x = pk2(t[0 * 33], t[1 * 33]); o.y = pk2(t[2 * 33], t[3 * 33]);
    o.z = pk2(t[4 * 33], t[5 * 33]); o.w = pk2(t[6 * 33], t[7 * 33]);
    *(uint4*)(dst + (size_t)(n0d + n) * ldd + k0 + 8 * c) = o;
  }
}

__device__ __forceinline__ void phase_convert(const Params& p, char* smem) {
  const int tid = otid(), lane = tid & 63, wid = tid >> 6;
  float* scr = (float*)smem + wid * (64 * 33);
  constexpr int N_IN = NL * 16 * 416, N_PJ = NL * 4 * 16 * 32, N_LR = NL * 2 * 8 * 8;
  for (int it = blockIdx.x * 8 + wid; it < N_IN + N_PJ + N_LR; it += gridDim.x * 8) {
    int r = it;
    if (r < N_IN) {
      int l = r / (16 * 416), q = r % (16 * 416), kt = q / 416, nt = q % 416;
      int n0d = nt * 32, n0s = n0d + (n0d >= 5120 ? 8 : 0);
      tconv_item(p.in[I_WIN] + (size_t)l * D * INW, INW, (bf16_t*)(p.ws + W_WTIN) + (size_t)l * NPJ * D, D, kt * 64, n0s,
                 n0d, scr, lane);
      continue;
    }
    r -= N_IN;
    if (r < N_PJ) {
      int lm = r >> 9, q = r & 511, kt = q >> 5, nt = q & 31, l = lm >> 2, mat = lm & 3;
      const float* src = p.in[I_WPA + mat] + (size_t)l * D * D;
      tconv_item(src, D, (bf16_t*)(p.ws + W_WTP) + (size_t)lm * D * D, D, kt * 64, nt * 32, nt * 32, scr, lane);
      continue;
    }
    r -= N_PJ;
    {
      int q = r & 7, lmn = r >> 3, n = lmn & 7, mat = (lmn >> 3) & 1, l = lmn >> 4;
      const float* src = p.in[mat ? I_WX : I_WA] + (size_t)(l * 8 + n) * 16384;
      tconv_item(src, 128, (bf16_t*)(p.ws + W_WTL) + (size_t)((l * 2 + mat) * 8 + n) * 16384, 128, (q >> 2) * 64,
                 (q & 3) * 32, (q & 3) * 32, scr, lane);
    }
  }
  __syncthreads();
  bf16_t* wm = (bf16_t*)(p.ws + W_WM);
  const float* gws = p.in[I_GWS];
  for (int idx = blockIdx.x * 512 + otid(); idx < NL * 4 * 128 * 128; idx += gridDim.x * 512) {
    int t = (idx >> 7) & 127, s = idx & 127;
    wm[idx] = f2bf(s <= t ? gws[idx] : 0.f);
  }
}

__device__ __forceinline__ void row_pass(const Params& p, int l, char* smem) {
  const int tid = otid(), lane = tid & 63, wid = tid >> 6;
  float* sWg = (float*)smem;
  if (l < NL) {
    const float* w = p.in[I_WIN] + (size_t)l * D * INW;
    for (int idx = tid; idx < 8192; idx += 512) {
      int j = idx >> 10, k = idx & 1023;
      sWg[idx] = w[(size_t)k * INW + 5120 + j];
    }
  }
  __syncthreads();
  bf16_t* XB = (bf16_t*)(p.ws + W_XB);
  float* XF = (float*)(p.ws + W_XF);
  const float* PRE = (const float*)(p.ws + W_PRE);
  float* GATE = (float*)(p.ws + W_GATE);
  for (int r = blockIdx.x * 8 + wid; r < MT; r += gridDim.x * 8) {
    float4 v[4];
    if (l == 0) {
      const float* src = r < NPR ? p.in[I_XP] + (size_t)r * D : p.in[I_XS] + (size_t)(r - NPR) * D;
#pragma unroll
      for (int i = 0; i < 4; ++i) v[i] = ldnt16f((const float4*)src + lane + 64 * i);
    } else {
      const float* src = PRE + (size_t)r * D;
      float s = 0.f;
#pragma unroll
      for (int i = 0; i < 4; ++i) { v[i] = ((const float4*)src)[lane + 64 * i]; s += (v[i].x + v[i].y) + (v[i].z + v[i].w); }
      const float mean = wave_sum(s) * (1.f / D);
      float s2 = 0.f;
#pragma unroll
      for (int i = 0; i < 4; ++i) {
        v[i].x -= mean; v[i].y -= mean; v[i].z -= mean; v[i].w -= mean;
        s2 += (v[i].x * v[i].x + v[i].y * v[i].y) + (v[i].z * v[i].z + v[i].w * v[i].w);
      }
      const float rstd = rsqrtf(wave_sum(s2) * (1.f / D) + EPS);
      const float4* g4 = (const float4*)(p.in[I_LNG] + (size_t)(l - 1) * D);
      const float4* b4 = (const float4*)(p.in[I_LNB] + (size_t)(l - 1) * D);
      float* dst = (l == NL) ? p.out + O_Y + (size_t)r * D : XF + (size_t)r * D;
#pragma unroll
      for (int i = 0; i < 4; ++i) {
        float4 g = g4[lane + 64 * i], b = b4[lane + 64 * i];
        v[i].x = v[i].x * rstd * g.x + b.x; v[i].y = v[i].y * rstd * g.y + b.y;
        v[i].z = v[i].z * rstd * g.z + b.z; v[i].w = v[i].w * rstd * g.w + b.w;
        stnt16f((float4*)dst + lane + 64 * i, v[i]);
      }
    }
    if (l < NL) {
#pragma unroll
      for (int i = 0; i < 4; ++i) {
        uint2 o; o.x = pk2(v[i].x, v[i].y); o.y = pk2(v[i].z, v[i].w);
        ((uint2*)(XB + (size_t)r * D))[lane + 64 * i] = o;
      }
      float ga[8];
#pragma unroll
      for (int j = 0; j < 8; ++j) {
        float a = 0.f;
#pragma unroll
        for (int i = 0; i < 4; ++i) {
          float4 w = ((const float4*)(sWg + j * 1024))[lane + 64 * i];
          a += v[i].x * w.x + v[i].y * w.y + v[i].z * w.z + v[i].w * w.w;
        }
        ga[j] = wave_sum(a);
      }
      if (lane == 0) {
        const float* bi = p.in[I_BIN] + (size_t)l * INW + 5120;
        float4 o0 = {ga[0] + bi[0], ga[1] + bi[1], ga[2] + bi[2], ga[3] + bi[3]};
        float4 o1 = {ga[4] + bi[4], ga[5] + bi[5], ga[6] + bi[6], ga[7] + bi[7]};
        ((float4*)(GATE + (size_t)r * 8))[0] = o0;
        ((float4*)(GATE + (size_t)r * 8))[1] = o1;
      }
    }
  }
  __syncthreads();
}

constexpr int KD = 1024, BK = 64, HALF = 128, HTB = HALF * BK * 2;
__device__ __forceinline__ int lds_byte(int r, int c) {
  int st = (r >> 4) * 2 + (c >> 5), rr = r & 15, cc = c & 31, ob = rr * 64 + cc * 2;
  return st * 1024 + (ob ^ (((ob >> 9) & 1) << 5));
}
__device__ __forceinline__ void stage_rc(int b, int& R, int& C) {
  int st = b / 1024, sb = b % 1024, swz = sb ^ (((sb >> 9) & 1) << 5);
  R = (st >> 1) * 16 + swz / 64;
  C = (st & 1) * 32 + (swz % 64) / 2;
}
__device__ __forceinline__ void tile_map(int L, int nM, int nN, int& pm, int& pn, int WGM_ = 8) {
  int nwg = nM * nN, q = nwg / 8, r = nwg % 8, xcd = L % 8, off = L / 8;
  int wgid = (xcd < r ? xcd * (q + 1) : r * (q + 1) + (xcd - r) * q) + off;
  int nig = WGM_ * nN, gid = wgid / nig, fm = gid * WGM_, gsz = min(nM - fm, WGM_);
  pm = fm + ((wgid % nig) % gsz);
  pn = (wgid % nig) / gsz;
}

__device__ __forceinline__ void gemm_tile(const bf16_t* __restrict__ A, const bf16_t* __restrict__ Bt, int brow, int bcol,
                                          char* shm, f32x4 (&acc)[2][2][4][2], bool primed = false, bool prime_only = false) {
#define SAO(b, h) (((b) * 2 + (h)) * HTB)
#define SBO(b, h) ((4 + (b) * 2 + (h)) * HTB)
#define STAGE(BO, BASE, br, kt)                                                                              \
  do {                                                                                                       \
    const char* _gb = (const char*)(BASE) + ((size_t)(br) * KD + (size_t)(kt) * BK) * 2;                     \
    __builtin_amdgcn_global_load_lds((const unsigned*)(_gb + toff0), (unsigned*)(shm + (BO) + tb0), 16, 0, 0); \
    __builtin_amdgcn_global_load_lds((const unsigned*)(_gb + toff1), (unsigned*)(shm + (BO) + tb1), 16, 0, 0); \
  } while (0)
#define LDA(dst, b, h)                                                                                         \
  _Pragma("unroll") for (int m = 0; m < 4; ++m) _Pragma("unroll") for (int k = 0; k < 2; ++k) dst[m][k] =      \
      *reinterpret_cast<const bf16x8*>(shm + SAO(b, h) + lds_byte(wr * 64 + m * 16 + fr, k * 32 + fq * 8))
#define LDB(dst, b, h)                                                                                         \
  _Pragma("unroll") for (int n = 0; n < 2; ++n) _Pragma("unroll") for (int k = 0; k < 2; ++k) dst[n][k] =      \
      *reinterpret_cast<const bf16x8*>(shm + SBO(b, h) + lds_byte(wc * 32 + n * 16 + fr, k * 32 + fq * 8))
#define MMA(ai, bj, At_, Bt_)                                                                               \
  do {                                                                                                      \
    __builtin_amdgcn_s_setprio(1);                                                                          \
    _Pragma("unroll") for (int m = 0; m < 4; ++m) _Pragma("unroll") for (int n = 0; n < 2; ++n)             \
        _Pragma("unroll") for (int k = 0; k < 2; ++k) acc[ai][bj][m][n] =                                   \
            __builtin_amdgcn_mfma_f32_16x16x32_bf16(Bt_[n][k], At_[m][k], acc[ai][bj][m][n], 0, 0, 0);     \
    __builtin_amdgcn_s_setprio(0);                                                                          \
  } while (0)
#define WAIT_V(n) asm volatile("s_waitcnt vmcnt(" #n ")" ::: "memory")
#define WAIT_L(n) asm volatile("s_waitcnt lgkmcnt(" #n ")" ::: "memory")
#define BAR __builtin_amdgcn_s_barrier()
#define SCHED __builtin_amdgcn_sched_barrier(0)
  const int tidg = otid();
  const int wid = tidg >> 6, lane = tidg & 63, wr = wid >> 2, wc = wid & 3, fr = lane & 15, fq = lane >> 4;
  const int tb0 = tidg * 16, tb1 = tb0 + 8192;
  unsigned toff0, toff1;
  {
    int r_, c_;
    stage_rc(tb0, r_, c_); toff0 = (unsigned)(r_ * KD + c_) * 2u;
    stage_rc(tb1, r_, c_); toff1 = (unsigned)(r_ * KD + c_) * 2u;
  }
  if (prime_only) {
    STAGE(SBO(0, 0), Bt, bcol, 0); STAGE(SAO(0, 0), A, brow, 0);
    STAGE(SBO(0, 1), Bt, bcol + HALF, 0); STAGE(SAO(0, 1), A, brow + HALF, 0);
    STAGE(SBO(1, 0), Bt, bcol, 1); STAGE(SAO(1, 0), A, brow, 1); STAGE(SBO(1, 1), Bt, bcol + HALF, 1);
    return;
  }
#pragma unroll
  for (int a = 0; a < 2; ++a)
#pragma unroll
    for (int b = 0; b < 2; ++b)
#pragma unroll
      for (int m = 0; m < 4; ++m)
#pragma unroll
        for (int n = 0; n < 2; ++n) acc[a][b][m][n] = f32x4{0.f, 0.f, 0.f, 0.f};
  bf16x8 At[4][2], B0[2][2], B1[2][2];
  constexpr int nt = KD / BK;
  if (!primed) {
    __syncthreads();
    STAGE(SBO(0, 0), Bt, bcol, 0); STAGE(SAO(0, 0), A, brow, 0);
    STAGE(SBO(0, 1), Bt, bcol + HALF, 0); STAGE(SAO(0, 1), A, brow + HALF, 0);
    STAGE(SBO(1, 0), Bt, bcol, 1); STAGE(SAO(1, 0), A, brow, 1); STAGE(SBO(1, 1), Bt, bcol + HALF, 1);
  }
  if (wr == 1) BAR;
  WAIT_V(0); BAR;
  BAR;
#pragma unroll 1
  for (int t = 0; t < nt - 2; t += 2) {
    LDB(B0, 0, 0); SCHED; LDA(At, 0, 0); STAGE(SAO(1, 1), A, brow + HALF, t + 1);
    WAIT_L(8); BAR; WAIT_L(0); MMA(0, 0, At, B0); BAR; SCHED;
    LDB(B1, 0, 1); STAGE(SBO(0, 0), Bt, bcol, t + 2);
    BAR; WAIT_L(0); MMA(0, 1, At, B1); BAR;
    LDA(At, 0, 1); STAGE(SAO(0, 0), A, brow, t + 2);
    BAR; WAIT_L(0); MMA(1, 0, At, B0); BAR; SCHED;
    STAGE(SBO(0, 1), Bt, bcol + HALF, t + 2);
    WAIT_V(6); BAR; MMA(1, 1, At, B1); BAR;
    LDB(B0, 1, 0); SCHED; LDA(At, 1, 0); STAGE(SAO(0, 1), A, brow + HALF, t + 2);
    WAIT_L(8); BAR; WAIT_L(0); MMA(0, 0, At, B0); BAR; SCHED;
    LDB(B1, 1, 1); STAGE(SBO(1, 0), Bt, bcol, t + 3);
    BAR; WAIT_L(0); MMA(0, 1, At, B1); BAR;
    LDA(At, 1, 1); STAGE(SAO(1, 0), A, brow, t + 3);
    BAR; WAIT_L(0); MMA(1, 0, At, B0); BAR; SCHED;
    STAGE(SBO(1, 1), Bt, bcol + HALF, t + 3);
    WAIT_V(6); BAR; MMA(1, 1, At, B1); BAR;
  }
  {
    LDB(B0, 0, 0); LDA(At, 0, 0); STAGE(SAO(1, 1), A, brow + HALF, nt - 1);
    BAR; WAIT_L(0); MMA(0, 0, At, B0); BAR;
    LDB(B1, 0, 1); BAR; WAIT_L(0); MMA(0, 1, At, B1); BAR;
    LDA(At, 0, 1); WAIT_V(4); BAR; WAIT_L(0); MMA(1, 0, At, B0); MMA(1, 1, At, B1); BAR;
  }
  {
    LDB(B0, 1, 0); LDA(At, 1, 0); WAIT_V(2); BAR; WAIT_L(0); MMA(0, 0, At, B0); BAR;
    LDB(B1, 1, 1); WAIT_V(0); BAR; WAIT_L(0); MMA(0, 1, At, B1); BAR;
    LDA(At, 1, 1); BAR; WAIT_L(0); MMA(1, 0, At, B0); MMA(1, 1, At, B1); BAR;
  }
  if (wr == 0) BAR;
}
#define EPI_IDX const int tide = otid(), wid = tide >> 6, lane = tide & 63, wr = wid >> 2, wc = wid & 3, fr = lane & 15, fq = lane >> 4;
#define EPI_LOOP                                                                     \
  _Pragma("unroll") for (int ai = 0; ai < 2; ++ai) _Pragma("unroll") for (int bj = 0; bj < 2; ++bj) \
      _Pragma("unroll") for (int m = 0; m < 4; ++m) _Pragma("unroll") for (int n = 0; n < 2; ++n)

__device__ __forceinline__ void mlstm_scalars(const Params& p, int l, int bh, char* smem) {
  const int tid = otid(), lane = tid & 63, wid = tid >> 6;
  float* sred = (float*)smem;
  const float* GATE = (const float*)(p.ws + W_GATE);
  const int b = bh >> 2, h = bh & 3;
  float itv[4], c[4];
#pragma unroll
  for (int r = 0; r < 4; ++r) {
    size_t row = (size_t)b * SEQ + tid * 4 + r;
    itv[r] = GATE[row * 8 + h];
    c[r] = logsig(GATE[row * 8 + 4 + h]);
  }
  c[1] += c[0]; c[2] += c[1]; c[3] += c[2];
  float inc = c[3];
#pragma unroll
  for (int o = 1; o < 64; o <<= 1) { float t = SHU(inc, o); if (lane >= o) inc += t; }
  if (lane == 63) sred[wid] = inc;
  __syncthreads();
  float base = 0.f;
  for (int w = 0; w < wid; ++w) base += sred[w];
  __syncthreads();
  const float excl = base + inc - c[3];
  float g[4], mx[4];
#pragma unroll
  for (int r = 0; r < 4; ++r) { c[r] += excl; g[r] = itv[r] - c[r]; }
  mx[0] = g[0]; mx[1] = fmaxf(mx[0], g[1]); mx[2] = fmaxf(mx[1], g[2]); mx[3] = fmaxf(mx[2], g[3]);
  float minc = mx[3];
#pragma unroll
  for (int o = 1; o < 64; o <<= 1) { float t = SHU(minc, o); if (lane >= o) minc = fmaxf(minc, t); }
  if (lane == 63) sred[wid] = minc;
  __syncthreads();
  float mb = 0.f;
  for (int w = 0; w < wid; ++w) mb = fmaxf(mb, sred[w]);
  float prev = SHU(minc, 1);
  if (lane > 0) mb = fmaxf(mb, prev);
  __syncthreads();
  float* G = (float*)(p.ws + W_G) + (size_t)bh * SEQ;
  float* MX = (float*)(p.ws + W_MX) + (size_t)bh * SEQ;
  float* EM = (float*)(p.ws + W_EM) + (size_t)bh * SEQ;
  float4 og, om, oe;
  float mxv[4], mv[4];
#pragma unroll
  for (int r = 0; r < 4; ++r) { mxv[r] = fmaxf(mb, mx[r]); mv[r] = c[r] + mxv[r]; }
  og = float4{g[0], g[1], g[2], g[3]};
  om = float4{mxv[0], mxv[1], mxv[2], mxv[3]};
  oe = float4{__expf(-mv[0]), __expf(-mv[1]), __expf(-mv[2]), __expf(-mv[3])};
  ((float4*)G)[tid] = og; ((float4*)MX)[tid] = om; ((float4*)EM)[tid] = oe;
  if (tid == 511) p.out[O_MP + (size_t)l * 32 + bh] = mv[3];
}

__device__ __forceinline__ void mlstm_flash(const Params& p, int l, int bh, int qi, char* smem) {
  const int tid = otid(), lane = tid & 63, wid = tid >> 6, fr = lane & 15, fq = lane >> 4, wr = wid >> 1, wc = wid & 1;
  const int b = bh >> 2, h = bh & 3;
  char* sKb = smem;
  char* sVb = smem + 65536;
  bf16_t* sP = (bf16_t*)(smem + 131072);
  float* sRed = (float*)(smem + 131072);
  const bf16_t* P = (const bf16_t*)(p.ws + W_P);
  const float* G = (const float*)(p.ws + W_G) + (size_t)bh * SEQ;
  const float* MX = (const float*)(p.ws + W_MX) + (size_t)bh * SEQ;
  const float* EM = (const float*)(p.ws + W_EM) + (size_t)bh * SEQ;
  const size_t rowbase = (size_t)b * SEQ;
  const int nblk = 2 * qi + 2;
#define FL_ISSUE(jb)                                                                                              \
  do {                                                                                                            \
    const int buf_ = (jb) & 1;                                                                                    \
    const bf16_t* rp0_ = P + (rowbase + (size_t)(jb) * 64) * NPJ + h * 256;                                       \
    _Pragma("unroll") for (int i_ = 0; i_ < 4; ++i_) {                                                            \
      const int r_ = (wid * 4 + i_) * 2 + (lane >> 5), cs_ = lane & 31;                                           \
      const int ck_ = cs_ ^ (r_ & 31), cv_ = cs_ ^ (((r_ & 3) << 1) | (r_ & 8));                                  \
      __builtin_amdgcn_global_load_lds((const unsigned*)(rp0_ + (size_t)r_ * NPJ + C_K + ck_ * 8),                \
                                       (unsigned*)(sKb + buf_ * 32768 + (wid * 4 + i_) * 1024 + lane * 16), 16, 0, 0); \
      __builtin_amdgcn_global_load_lds((const unsigned*)(rp0_ + (size_t)r_ * NPJ + C_V + cv_ * 8),                \
                                       (unsigned*)(sVb + buf_ * 32768 + (wid * 4 + i_) * 1024 + lane * 16), 16, 0, 0); \
    }                                                                                                             \
  } while (0)
  FL_ISSUE(0);
  bf16x8 qf[2][8];
  float mxr[2];
#pragma unroll
  for (int m = 0; m < 2; ++m) {
    const int t = qi * 128 + wr * 32 + m * 16 + fr;
    const bf16_t* qp = P + (rowbase + t) * NPJ + C_Q + h * 256 + fq * 8;
#pragma unroll
    for (int kk = 0; kk < 8; ++kk) qf[m][kk] = __builtin_nontemporal_load((const bf16x8*)(qp + kk * 32));
    mxr[m] = MX[t];
  }
  f32x4 oacc[2][8];
#pragma unroll
  for (int m = 0; m < 2; ++m)
#pragma unroll
    for (int n = 0; n < 8; ++n) oacc[m][n] = f32x4{0.f, 0.f, 0.f, 0.f};
  float den[2] = {0.f, 0.f};
#pragma unroll 1
  for (int j = 0; j < nblk; ++j) {
    asm volatile("s_waitcnt vmcnt(0)" ::: "memory");
    __syncthreads();
    if (j + 1 < nblk) FL_ISSUE(j + 1);
    const char* sK = sKb + (j & 1) * 32768;
    const char* sV = sVb + (j & 1) * 32768;
    f32x4 sacc[2][2];
#pragma unroll
    for (int m = 0; m < 2; ++m)
#pragma unroll
      for (int n = 0; n < 2; ++n) sacc[m][n] = f32x4{0.f, 0.f, 0.f, 0.f};
#pragma unroll
    for (int kk = 0; kk < 8; ++kk)
#pragma unroll
      for (int n = 0; n < 2; ++n) {
        const int row = wc * 32 + n * 16 + fr, c = kk * 4 + fq;
        bf16x8 kf = *(const bf16x8*)(sK + row * 512 + ((c ^ (row & 31)) << 4));
        sacc[0][n] = mfma16(kf, qf[0][kk], sacc[0][n]);
        sacc[1][n] = mfma16(kf, qf[1][kk], sacc[1][n]);
      }
#pragma unroll
    for (int n = 0; n < 2; ++n) {
      const int s0 = j * 64 + wc * 32 + n * 16 + fq * 4;
      const float4 g4 = *(const float4*)(G + s0);
      const float gs[4] = {g4.x, g4.y, g4.z, g4.w};
#pragma unroll
      for (int m = 0; m < 2; ++m) {
        const int t = qi * 128 + wr * 32 + m * 16 + fr;
        float v[4];
#pragma unroll
        for (int r = 0; r < 4; ++r) {
          float w = (s0 + r <= t) ? __expf(gs[r] - mxr[m]) : 0.f;
          v[r] = sacc[m][n][r] * 0.0625f * w;
          den[m] += v[r];
        }
        uint2 pk; pk.x = pk2(v[0], v[1]); pk.y = pk2(v[2], v[3]);
        *(uint2*)(sP + (wr * 32 + m * 16 + fr) * 72 + wc * 32 + n * 16 + fq * 4) = pk;
      }
    }
    __syncthreads();
#pragma unroll
    for (int kk = 0; kk < 2; ++kk) {
      bf16x8 pf0 = *(const bf16x8*)(sP + (wr * 32 + fr) * 72 + kk * 32 + fq * 8);
      bf16x8 pf1 = *(const bf16x8*)(sP + (wr * 32 + 16 + fr) * 72 + kk * 32 + fq * 8);
      const int srow = kk * 32 + fq * 8 + (fr >> 2);
      const int swz = ((srow & 3) << 1) | (srow & 8);
#pragma unroll
      for (int n2 = 0; n2 < 8; ++n2) {
        const int ch = ((wc * 128 + n2 * 16) >> 3) + ((fr & 3) >> 1);
        const char* va = sV + srow * 512 + ((ch ^ swz) << 4) + (fr & 1) * 8;
        s16x4 a = __builtin_amdgcn_ds_read_tr16_b64_v4i16((LDSP(s16x4))va);
        s16x4 bq = __builtin_amdgcn_ds_read_tr16_b64_v4i16((LDSP(s16x4))(va + 4 * 512));
        bf16x8 vf = {a[0], a[1], a[2], a[3], bq[0], bq[1], bq[2], bq[3]};
        oacc[0][n2] = mfma16(vf, pf0, oacc[0][n2]);
        oacc[1][n2] = mfma16(vf, pf1, oacc[1][n2]);
      }
    }
  }
  __syncthreads();
#undef FL_ISSUE
  float dn[2];
#pragma unroll
  for (int m = 0; m < 2; ++m) {
    float v = den[m];
    v += SHX(v, 16); v += SHX(v, 32);
    if (fq == 0) sRed[wc * 128 + wr * 32 + m * 16 + fr] = v;
  }
  __syncthreads();
#pragma unroll
  for (int m = 0; m < 2; ++m) {
    const int tl = wr * 32 + m * 16 + fr;
    float d = sRed[tl] + sRed[128 + tl];
    dn[m] = 1.f / fmaxf(fabsf(d), EM[qi * 128 + tl]);
  }
  float s1[2] = {0.f, 0.f}, s2[2] = {0.f, 0.f};
#pragma unroll
  for (int m = 0; m < 2; ++m) {
    const size_t row = rowbase + qi * 128 + wr * 32 + m * 16 + fr;
#pragma unroll
    for (int n2 = 0; n2 < 8; ++n2) {
      const int col = h * 256 + wc * 128 + n2 * 16 + fq * 4;
      const uint2 ov = *(const uint2*)(P + row * NPJ + C_O + col);
      const float o[4] = {bflo(ov.x), bfhi(ov.x), bflo(ov.y), bfhi(ov.y)};
#pragma unroll
      for (int r = 0; r < 4; ++r) {
        float hv = oacc[m][n2][r] * dn[m] * sigm(o[r]);
        oacc[m][n2][r] = hv;
        s1[m] += hv; s2[m] += hv * hv;
      }
    }
  }
#pragma unroll
  for (int m = 0; m < 2; ++m) {
    float a = s1[m], q = s2[m];
    a += SHX(a, 16); a += SHX(a, 32);
    q += SHX(q, 16); q += SHX(q, 32);
    if (fq == 0) { sRed[256 + wc * 128 + wr * 32 + m * 16 + fr] = a; sRed[512 + wc * 128 + wr * 32 + m * 16 + fr] = q; }
  }
  __syncthreads();
  bf16_t* Y0 = (bf16_t*)(p.ws + W_Y);
  const float* ng = p.in[I_NORMG] + (size_t)l * D;
#pragma unroll
  for (int m = 0; m < 2; ++m) {
    const int tl = wr * 32 + m * 16 + fr;
    const float mean = (sRed[256 + tl] + sRed[256 + 128 + tl]) * (1.f / 256.f);
    const float var = (sRed[512 + tl] + sRed[512 + 128 + tl]) * (1.f / 256.f) - mean * mean;
    const float rstd = rsqrtf(fmaxf(var, 0.f) + EPS);
    const size_t row = rowbase + qi * 128 + tl;
#pragma unroll
    for (int n2 = 0; n2 < 8; ++n2) {
      const int col = h * 256 + wc * 128 + n2 * 16 + fq * 4;
      const uint2 zv = *(const uint2*)(P + row * NPJ + C_ZA + col);
      const float4 g4 = *(const float4*)(ng + col);
      const float z[4] = {bflo(zv.x), bfhi(zv.x), bflo(zv.y), bfhi(zv.y)};
      const float gg[4] = {g4.x, g4.y, g4.z, g4.w};
      float y[4];
#pragma unroll
      for (int r = 0; r < 4; ++r) y[r] = (oacc[m][n2][r] - mean) * rstd * gg[r] * silu(z[r]);
      uint2 o; o.x = pk2(y[0], y[1]); o.y = pk2(y[2], y[3]);
      *(uint2*)(Y0 + row * D + col) = o;
    }
  }
  __syncthreads();
}

__device__ __forceinline__ void mlstm_final(const Params& p, int l, int bh, int dq, char* smem) {
  const int tid = otid(), lane = tid & 63, wid = tid >> 6, fr = lane & 15, fq = lane >> 4, wr = wid >> 2, wc = wid & 3;
  const int b = bh >> 2, h = bh & 3;
  char* sVb = smem;
  char* sKb = smem + 98304;
  float* sWall = (float*)(smem + 122880);
  float* sW = (float*)(smem + 131072);
  const bf16_t* P = (const bf16_t*)(p.ws + W_P);
  const float* G = (const float*)(p.ws + W_G) + (size_t)bh * SEQ;
  const float mxl = ((const float*)(p.ws + W_MX))[(size_t)bh * SEQ + SEQ - 1];
  const size_t rowbase = (size_t)b * SEQ;
  {
    const float4 g4 = ((const float4*)G)[tid];
    float4 w4 = {__expf(g4.x - mxl) * 0.0625f, __expf(g4.y - mxl) * 0.0625f, __expf(g4.z - mxl) * 0.0625f, __expf(g4.w - mxl) * 0.0625f};
    ((float4*)sWall)[tid] = w4;
  }
#define FN_ISSUE(jb)                                                                                                  \
  do {                                                                                                                \
    const int buf_ = (jb) % 3;                                                                                        \
    const bf16_t* rp0_ = P + (rowbase + (size_t)(jb) * 64) * NPJ + h * 256;                                           \
    _Pragma("unroll") for (int i_ = 0; i_ < 4; ++i_) {                                                                \
      const int r_ = (wid * 4 + i_) * 2 + (lane >> 5), cs_ = lane & 31;                                               \
      const int cv_ = cs_ ^ (((r_ & 3) << 1) | (r_ & 8));                                                             \
      __builtin_amdgcn_global_load_lds((const unsigned*)(rp0_ + (size_t)r_ * NPJ + C_V + cv_ * 8),                    \
                                       (unsigned*)(sVb + buf_ * 32768 + (wid * 4 + i_) * 1024 + lane * 16), 16, 0, 0); \
    }                                                                                                                 \
    {                                                                                                                 \
      const int r_ = wid * 8 + (lane >> 3), cs_ = lane & 7;                                                           \
      const int ck_ = cs_ ^ ((r_ & 3) << 1);                                                                          \
      __builtin_amdgcn_global_load_lds((const unsigned*)(rp0_ + (size_t)r_ * NPJ + C_K + dq * 64 + ck_ * 8),          \
                                       (unsigned*)(sKb + buf_ * 8192 + wid * 1024 + lane * 16), 16, 0, 0);            \
    }                                                                                                                 \
  } while (0)
  asm volatile("s_waitcnt vmcnt(0)" ::: "memory");
  FN_ISSUE(0);
  FN_ISSUE(1);
  f32x4 acc[2][4];
#pragma unroll
  for (int m = 0; m < 2; ++m)
#pragma unroll
    for (int n = 0; n < 4; ++n) acc[m][n] = f32x4{0.f, 0.f, 0.f, 0.f};
  float nacc = 0.f;
#pragma unroll 1
  for (int j = 0; j < 32; ++j) {
    if (j + 1 < 32) asm volatile("s_waitcnt vmcnt(5)" ::: "memory");
    else asm volatile("s_waitcnt vmcnt(0)" ::: "memory");
    __syncthreads();
    if (j + 2 < 32) FN_ISSUE(j + 2);
    const char* sV = sVb + (j % 3) * 32768;
    const char* sK = sKb + (j % 3) * 8192;
#pragma unroll
    for (int kk = 0; kk < 2; ++kk) {
      const int srow = kk * 32 + fq * 8 + (fr >> 2);
      const float4 wa = *(const float4*)(sWall + j * 64 + kk * 32 + fq * 8);
      const float4 wb = *(const float4*)(sWall + j * 64 + kk * 32 + fq * 8 + 4);
      bf16x8 kf[2];
#pragma unroll
      for (int m = 0; m < 2; ++m) {
        const int d0 = wr * 32 + m * 16 + (fr & 3) * 4;
        const char* ka = sK + srow * 128 + ((((d0 >> 3) ^ ((srow & 3) << 1)) & 7) << 4) + ((d0 >> 2) & 1) * 8;
        s16x4 a = __builtin_amdgcn_ds_read_tr16_b64_v4i16((LDSP(s16x4))ka);
        s16x4 bq = __builtin_amdgcn_ds_read_tr16_b64_v4i16((LDSP(s16x4))(ka + 4 * 128));
        const unsigned u0 = pk2(bf2f((bf16_t)a[0]) * wa.x, bf2f((bf16_t)a[1]) * wa.y);
        const unsigned u1 = pk2(bf2f((bf16_t)a[2]) * wa.z, bf2f((bf16_t)a[3]) * wa.w);
        const unsigned u2 = pk2(bf2f((bf16_t)bq[0]) * wb.x, bf2f((bf16_t)bq[1]) * wb.y);
        const unsigned u3 = pk2(bf2f((bf16_t)bq[2]) * wb.z, bf2f((bf16_t)bq[3]) * wb.w);
        kf[m] = bf16x8{(short)(u0 & 0xffff), (short)(u0 >> 16), (short)(u1 & 0xffff), (short)(u1 >> 16),
                       (short)(u2 & 0xffff), (short)(u2 >> 16), (short)(u3 & 0xffff), (short)(u3 >> 16)};
      }
      const int swz = ((srow & 3) << 1) | (srow & 8);
#pragma unroll
      for (int n = 0; n < 4; ++n) {
        const int ch = ((wc * 64 + n * 16) >> 3) + ((fr & 3) >> 1);
        const char* va = sV + srow * 512 + ((ch ^ swz) << 4) + (fr & 1) * 8;
        s16x4 a = __builtin_amdgcn_ds_read_tr16_b64_v4i16((LDSP(s16x4))va);
        s16x4 bq = __builtin_amdgcn_ds_read_tr16_b64_v4i16((LDSP(s16x4))(va + 4 * 512));
        bf16x8 vf = {a[0], a[1], a[2], a[3], bq[0], bq[1], bq[2], bq[3]};
        acc[0][n] = mfma16(vf, kf[0], acc[0][n]);
        acc[1][n] = mfma16(vf, kf[1], acc[1][n]);
      }
    }
    {
      float a = 0.f;
#pragma unroll
      for (int s8 = 0; s8 < 8; ++s8) {
        const int srow = wid * 8 + s8;
        const bf16_t kv = *(const bf16_t*)(sK + srow * 128 + ((((lane >> 3) ^ ((srow & 3) << 1)) & 7) << 4) + (lane & 7) * 2);
        a += bf2f(kv) * sWall[j * 64 + srow];
      }
      nacc += a;
    }
  }
  __syncthreads();
#undef FN_ISSUE
  float* oc = p.out + O_CP + ((size_t)l * 32 + bh) * 65536;
#pragma unroll
  for (int m = 0; m < 2; ++m)
#pragma unroll
    for (int n = 0; n < 4; ++n) {
      const int d = dq * 64 + wr * 32 + m * 16 + fr, e = wc * 64 + n * 16 + fq * 4;
      *(float4*)(oc + (size_t)d * 256 + e) = float4{acc[m][n][0], acc[m][n][1], acc[m][n][2], acc[m][n][3]};
    }
  sW[tid] = nacc;
  __syncthreads();
  if (tid < 64) {
    float a = 0.f;
#pragma unroll
    for (int w8 = 0; w8 < 8; ++w8) a += sW[w8 * 64 + tid];
    p.out[O_NP + ((size_t)l * 32 + bh) * 256 + dq * 64 + tid] = a;
  }
  __syncthreads();
}

__device__ __forceinline__ void mlstm_sample(const Params& p, int l, int b, int h, char* smem) {
  const int tid = otid(), lane = tid & 63, wid = tid >> 6;
  float* sq = (float*)smem;
  float* sk = sq + 1024;
  float* sv = sk + 1024;
  float* sn0 = sv + 1024;
  float* sqk = sn0 + 256;
  float* ssc = sqk + 32;
  float* sst = ssc + 32;
  float* snum = sst + 32;
  const bf16_t* P = (const bf16_t*)(p.ws + W_P);
  const float* GATE = (const float*)(p.ws + W_GATE);
  const size_t R0 = (size_t)NPR + b * 4;
  const size_t sidx = ((size_t)l * 128 + b) * 4 + h;
#pragma unroll
  for (int i = 0; i < 6; ++i) {
    int idx = tid + 512 * i, which = idx >> 10, t = (idx >> 8) & 3, d = idx & 255;
    sq[idx] = bf2f(P[(R0 + t) * NPJ + which * 1024 + h * 256 + d]);
  }
  if (tid < 256) sn0[tid] = p.in[I_SN][sidx * 256 + tid];
  const float m0 = p.in[I_SM][sidx];
  float g[4], cm[4], mm[4];
  {
    float bc = 0.f, run = m0;
#pragma unroll
    for (int t = 0; t < 4; ++t) {
      float itv = GATE[(R0 + t) * 8 + h];
      bc += logsig(GATE[(R0 + t) * 8 + 4 + h]);
      g[t] = itv - bc;
      run = fmaxf(run, g[t]);
      cm[t] = run;
      mm[t] = bc + run;
    }
  }
  __syncthreads();
  {
    const int pp = tid >> 5, li = tid & 31, t = pp >> 2, s = pp & 3;
    float part = 0.f;
#pragma unroll
    for (int d8 = 0; d8 < 8; ++d8) part += sq[t * 256 + li * 8 + d8] * sk[s * 256 + li * 8 + d8];
#pragma unroll
    for (int o = 16; o >= 1; o >>= 1) part += SHX(part, o);
    if (li == 0) sqk[pp] = part * 0.0625f;
    float part2 = 0.f;
    const int t2 = pp & 3;
#pragma unroll
    for (int d8 = 0; d8 < 8; ++d8) part2 += sq[t2 * 256 + li * 8 + d8] * sn0[li * 8 + d8];
#pragma unroll
    for (int o = 16; o >= 1; o >>= 1) part2 += SHX(part2, o);
    if (li == 0 && pp < 4) sqk[16 + pp] = part2;
  }
  __syncthreads();
  float w[4];
#pragma unroll
  for (int s = 0; s < 4; ++s) w[s] = __expf(g[s] - cm[3]) * 0.0625f;
  const float decay = __expf(m0 - cm[3]);
  if (tid == 0) {
#pragma unroll
    for (int t = 0; t < 4; ++t) {
      const float inter = __expf(m0 - cm[t]);
      float dsum = inter * sqk[16 + t];
#pragma unroll
      for (int s = 0; s < 4; ++s) {
        float st = (s <= t) ? sqk[t * 4 + s] * __expf(g[s] - cm[t]) : 0.f;
        ssc[t * 4 + s] = st;
        dsum += st;
      }
      ssc[16 + t] = inter;
      ssc[20 + t] = 1.f / fmaxf(fabsf(dsum), __expf(-mm[t]));
    }
  }
#pragma unroll
  for (int i = 0; i < 2; ++i) {
    int idx = tid + 512 * i;
    sk[idx] *= w[idx >> 8];
  }
  __syncthreads();
  {
    const int e4 = lane * 4, d0 = wid * 32;
    float4 vv[4], np[4];
#pragma unroll
    for (int s = 0; s < 4; ++s) { vv[s] = *(const float4*)(sv + s * 256 + e4); np[s] = float4{0.f, 0.f, 0.f, 0.f}; }
    const float* c0p = p.in[I_SC] + sidx * 65536;
    float* cop = p.out + O_CS + sidx * 65536;
#pragma unroll 1
    for (int dd = 0; dd < 32; dd += 8) {
      float4 c[8];
#pragma unroll
      for (int u = 0; u < 8; ++u) {
        const f32x4 t4 = __builtin_nontemporal_load((const f32x4*)(c0p + (size_t)(d0 + dd + u) * 256 + e4));
        c[u] = float4{t4[0], t4[1], t4[2], t4[3]};
      }
#pragma unroll
      for (int u = 0; u < 8; ++u) {
        const int d = d0 + dd + u;
        float4 cn = {decay * c[u].x, decay * c[u].y, decay * c[u].z, decay * c[u].w};
#pragma unroll
        for (int t = 0; t < 4; ++t) {
          const float qv = sq[t * 256 + d], kv = sk[t * 256 + d];
          np[t].x += qv * c[u].x; np[t].y += qv * c[u].y; np[t].z += qv * c[u].z; np[t].w += qv * c[u].w;
          cn.x += kv * vv[t].x; cn.y += kv * vv[t].y; cn.z += kv * vv[t].z; cn.w += kv * vv[t].w;
        }
        __builtin_nontemporal_store(f32x4{cn.x, cn.y, cn.z, cn.w}, (f32x4*)(cop + (size_t)d * 256 + e4));
      }
    }
#pragma unroll
    for (int t = 0; t < 4; ++t) *(float4*)(snum + (wid * 4 + t) * 256 + e4) = np[t];
  }
  __syncthreads();
  {
    const int t = tid >> 7, e2 = (tid & 127) * 2;
    float hv[2];
    const unsigned ov = *(const unsigned*)(P + (R0 + t) * NPJ + C_O + h * 256 + e2);
    const float o2[2] = {bflo(ov), bfhi(ov)};
    const float inter = ssc[16 + t], dnm = ssc[20 + t];
#pragma unroll
    for (int k = 0; k < 2; ++k) {
      const int e = e2 + k;
      float a = 0.f;
#pragma unroll
      for (int w8 = 0; w8 < 8; ++w8) a += snum[(w8 * 4 + t) * 256 + e];
      float x = inter * a;
#pragma unroll
      for (int s = 0; s < 4; ++s) x += ssc[t * 4 + s] * sv[s * 256 + e];
      hv[k] = x * dnm * sigm(o2[k]);
    }
    float a1 = wave_sum(hv[0] + hv[1]), a2 = wave_sum(hv[0] * hv[0] + hv[1] * hv[1]);
    if (lane == 0) { sst[wid * 2] = a1; sst[wid * 2 + 1] = a2; }
    __syncthreads();
    const float mean = (sst[(2 * t) * 2] + sst[(2 * t + 1) * 2]) * (1.f / 256.f);
    const float var = (sst[(2 * t) * 2 + 1] + sst[(2 * t + 1) * 2 + 1]) * (1.f / 256.f) - mean * mean;
    const float rstd = rsqrtf(fmaxf(var, 0.f) + EPS);
    const unsigned zv = *(const unsigned*)(P + (R0 + t) * NPJ + C_ZA + h * 256 + e2);
    const float* ng = p.in[I_NORMG] + (size_t)l * D + h * 256 + e2;
    float y0 = (hv[0] - mean) * rstd * ng[0] * silu(bflo(zv));
    float y1 = (hv[1] - mean) * rstd * ng[1] * silu(bfhi(zv));
    __hip_atomic_store((unsigned*)((bf16_t*)(p.ws + W_Y) + (R0 + t) * D + h * 256 + e2), pk2(y0, y1), __ATOMIC_RELAXED,
                       __HIP_MEMORY_SCOPE_AGENT);
  }
  if (tid < 256) {
    float nn = decay * sn0[tid];
#pragma unroll
    for (int s = 0; s < 4; ++s) nn += sk[s * 256 + tid];
    p.out[O_NS + sidx * 256 + tid] = nn;
  }
  if (tid == 0) p.out[O_MS + sidx] = mm[3];
  __syncthreads();
}

__device__ __forceinline__ void gmlp_prompt(const Params& p, int l, int b, int chunk, int g, char* smem) {
  const int tid = otid(), lane = tid & 63, wid = tid >> 6, fr = lane & 15, fq = lane >> 4, wr = wid >> 2, wc = wid & 3;
  bf16_t* sVn = (bf16_t*)smem;
  bf16_t* sW = (bf16_t*)(smem + 69632);
  float* sMu = (float*)(smem + 69632 + 34816);
  float* sRs = sMu + 128;
  const bf16_t* P = (const bf16_t*)(p.ws + W_P);
  const size_t R0 = (size_t)b * SEQ + chunk * 128;
  if (tid < 128) {
    const float2* st = (const float2*)(p.ws + W_ST) + R0 + tid;
    float a = 0.f, q = 0.f;
#pragma unroll
    for (int k = 0; k < 16; ++k) { const float2 v = st[(size_t)k * NPR]; a += v.x; q += v.y; }
    const float mean = a * (1.f / D);
    sMu[tid] = mean;
    sRs[tid] = rsqrtf(fmaxf(q * (1.f / D) - mean * mean, 0.f) + EPS);
  }
  __syncthreads();
  const float* lg = p.in[I_GLNG] + (size_t)l * D + g * 256;
  const float* lb = p.in[I_GLNB] + (size_t)l * D + g * 256;
#pragma unroll
  for (int i = 0; i < 8; ++i) {
    int c = tid + 512 * i, r = c >> 5, c8 = c & 31;
    float f[8];
    unpack8(ldnt16(P + (R0 + r) * NPJ + C_VB + g * 256 + c8 * 8), f);
    const float mu = sMu[r], rs = sRs[r];
    const float4 g0 = *(const float4*)(lg + c8 * 8), g1 = *(const float4*)(lg + c8 * 8 + 4);
    const float4 b0 = *(const float4*)(lb + c8 * 8), b1 = *(const float4*)(lb + c8 * 8 + 4);
    f[0] = (f[0] - mu) * rs * g0.x + b0.x; f[1] = (f[1] - mu) * rs * g0.y + b0.y;
    f[2] = (f[2] - mu) * rs * g0.z + b0.z; f[3] = (f[3] - mu) * rs * g0.w + b0.w;
    f[4] = (f[4] - mu) * rs * g1.x + b1.x; f[5] = (f[5] - mu) * rs * g1.y + b1.y;
    f[6] = (f[6] - mu) * rs * g1.z + b1.z; f[7] = (f[7] - mu) * rs * g1.w + b1.w;
    *(uint4*)(sVn + r * 272 + c8 * 8) = pack8(f);
  }
  const bf16_t* wm = (const bf16_t*)(p.ws + W_WM) + (size_t)(l * 4 + g) * 16384;
#pragma unroll
  for (int i = 0; i < 4; ++i) {
    int c = tid + 512 * i, r = c >> 4, c8 = c & 15;
    *(uint4*)(sW + r * 136 + c8 * 8) = *(const uint4*)(wm + r * 128 + c8 * 8);
  }
  __syncthreads();
  f32x4 acc[4][4];
#pragma unroll
  for (int m = 0; m < 4; ++m)
#pragma unroll
    for (int n = 0; n < 4; ++n) acc[m][n] = f32x4{0.f, 0.f, 0.f, 0.f};
#pragma unroll
  for (int kk = 0; kk < 4; ++kk) {
    bf16x8 tf[4];
#pragma unroll
    for (int m = 0; m < 4; ++m) tf[m] = *(const bf16x8*)(sW + (wr * 64 + m * 16 + fr) * 136 + kk * 32 + fq * 8);
#pragma unroll
    for (int n = 0; n < 4; ++n) {
      bf16x8 cf = frag_t(sVn, 272, wc * 64 + n * 16, kk * 32, lane);
#pragma unroll
      for (int m = 0; m < 4; ++m) acc[m][n] = mfma16(cf, tf[m], acc[m][n]);
    }
  }
  bf16_t* Y1 = (bf16_t*)(p.ws + W_Y) + (size_t)MT * D;
  const float* bs = p.in[I_GBS] + (size_t)(l * 4 + g) * 128;
#pragma unroll
  for (int m = 0; m < 4; ++m) {
    const int t = wr * 64 + m * 16 + fr;
    const float bsv = bs[t];
    const size_t row = R0 + t;
#pragma unroll
    for (int n = 0; n < 4; ++n) {
      const int col = g * 256 + wc * 64 + n * 16 + fq * 4;
      const uint2 uv = *(const uint2*)(P + row * NPJ + C_UB + col);
      const uint2 zv = *(const uint2*)(P + row * NPJ + C_ZB + col);
      const float u[4] = {bflo(uv.x), bfhi(uv.x), bflo(uv.y), bfhi(uv.y)};
      const float z[4] = {bflo(zv.x), bfhi(zv.x), bflo(zv.y), bfhi(zv.y)};
      float y[4];
#pragma unroll
      for (int r = 0; r < 4; ++r) y[r] = u[r] * (acc[m][n][r] + bsv) * silu(z[r]);
      uint2 o; o.x = pk2(y[0], y[1]); o.y = pk2(y[2], y[3]);
      *(uint2*)(Y1 + row * D + col) = o;
    }
  }
  __syncthreads();
}

__device__ __forceinline__ void gmlp_sample(const Params& p, int l, int b, char* smem) {
  const int tid = otid(), lane = tid & 63, wid = tid >> 6;
  float* svn = (float*)smem;
  const bf16_t* P = (const bf16_t*)(p.ws + W_P);
  const size_t R0 = (size_t)NPR + b * 4;
  if (wid < 4) {
    const int t = wid;
    const bf16_t* rp = P + (R0 + t) * NPJ + C_VB;
    float f[16];
    unpack8(*(const uint4*)(rp + lane * 8), f);
    unpack8(*(const uint4*)(rp + 512 + lane * 8), f + 8);
    float a = 0.f;
#pragma unroll
    for (int e = 0; e < 16; ++e) a += f[e];
    const float mean = wave_sum(a) * (1.f / D);
    float q = 0.f;
#pragma unroll
    for (int e = 0; e < 16; ++e) { f[e] -= mean; q += f[e] * f[e]; }
    const float rs = rsqrtf(wave_sum(q) * (1.f / D) + EPS);
    const float* lg = p.in[I_GLNG] + (size_t)l * D;
    const float* lb = p.in[I_GLNB] + (size_t)l * D;
    float* ov = p.out + O_VS + (((size_t)l * 128 + b) * 4 + t) * D;
#pragma unroll
    for (int hh = 0; hh < 2; ++hh) {
      const int c0 = hh * 512 + lane * 8;
#pragma unroll
      for (int e = 0; e < 8; ++e) f[hh * 8 + e] = f[hh * 8 + e] * rs * lg[c0 + e] + lb[c0 + e];
      *(float4*)(svn + t * 1024 + c0) = float4{f[hh * 8], f[hh * 8 + 1], f[hh * 8 + 2], f[hh * 8 + 3]};
      *(float4*)(svn + t * 1024 + c0 + 4) = float4{f[hh * 8 + 4], f[hh * 8 + 5], f[hh * 8 + 6], f[hh * 8 + 7]};
      *(float4*)(ov + c0) = float4{f[hh * 8], f[hh * 8 + 1], f[hh * 8 + 2], f[hh * 8 + 3]};
      *(float4*)(ov + c0 + 4) = float4{f[hh * 8 + 4], f[hh * 8 + 5], f[hh * 8 + 6], f[hh * 8 + 7]};
    }
  }
  __syncthreads();
  bf16_t* Y1 = (bf16_t*)(p.ws + W_Y) + (size_t)MT * D;
#pragma unroll
  for (int i = 0; i < 8; ++i) {
    const int idx = tid + 512 * i, t = idx >> 10, c = idx & 1023, g = c >> 8;
    const float* wrow = p.in[I_GWS] + ((size_t)(l * 4 + g) * 128 + t) * 128;
    float mixed = p.in[I_GBS][(size_t)(l * 4 + g) * 128 + t];
#pragma unroll
    for (int s = 0; s < 4; ++s)
      if (s <= t) mixed += wrow[s] * svn[s * 1024 + c];
    const float u = bf2f(P[(R0 + t) * NPJ + C_UB + c]), z = bf2f(P[(R0 + t) * NPJ + C_ZB + c]);
    __hip_atomic_store(Y1 + (R0 + t) * D + c, f2bf(u * mixed * silu(z)), __ATOMIC_RELAXED, __HIP_MEMORY_SCOPE_AGENT);
  }
  __syncthreads();
}

__device__ __forceinline__ void lru_gemm_pass(const Params& p, int l, int mat, int cp, const bf16_t* sX, bf16_t* sWt,
                                              f32x4 (&acc)[8][2]) {
  const int tid = otid(), lane = tid & 63, wid = tid >> 6, fr = lane & 15, fq = lane >> 4;
  const bf16_t* src = (const bf16_t*)(p.ws + W_WTL) + (size_t)((l * 2 + mat) * 8 + cp * 2) * 16384;
  __syncthreads();
#pragma unroll
  for (int i = 0; i < 8; ++i) {
    int c = tid + 512 * i, r = c >> 4, c8 = c & 15;
    *(uint4*)(sWt + r * 136 + c8 * 8) = *(const uint4*)(src + r * 128 + c8 * 8);
  }
  __syncthreads();
  const int kb = (wid >> 2) * 128;
#pragma unroll
  for (int m = 0; m < 8; ++m) { acc[m][0] = f32x4{0.f, 0.f, 0.f, 0.f}; acc[m][1] = f32x4{0.f, 0.f, 0.f, 0.f}; }
#pragma unroll
  for (int kk = 0; kk < 4; ++kk) {
    bf16x8 wf0 = *(const bf16x8*)(sWt + (wid * 32 + fr) * 136 + kk * 32 + fq * 8);
    bf16x8 wf1 = *(const bf16x8*)(sWt + (wid * 32 + 16 + fr) * 136 + kk * 32 + fq * 8);
#pragma unroll
    for (int m = 0; m < 8; ++m) {
      bf16x8 xf = *(const bf16x8*)(sX + (m * 16 + fr) * 264 + kb + kk * 32 + fq * 8);
      acc[m][0] = mfma16(xf, wf0, acc[m][0]);
      acc[m][1] = mfma16(xf, wf1, acc[m][1]);
    }
  }
}

__device__ __forceinline__ void lru_tile(const Params& p, int l, int tile, int cp, bool sample, char* smem) {
  const int tid = otid(), lane = tid & 63, wid = tid >> 6, fr = lane & 15, fq = lane >> 4;
  bf16_t* sX = (bf16_t*)smem;
  bf16_t* sWt = (bf16_t*)(smem + 67584);
  const bf16_t* P = (const bf16_t*)(p.ws + W_P);
  {
    const int cg8 = tid & 31, tg = tid >> 5, c = cp * 256 + cg8 * 8;
    float w0[8], w1[8], w2[8], w3[8], bb[8];
    const float* cw = p.in[I_CONVW] + (size_t)l * 4 * D + c;
#pragma unroll
    for (int e = 0; e < 8; ++e) { w0[e] = cw[e]; w1[e] = cw[D + e]; w2[e] = cw[2 * D + e]; w3[e] = cw[3 * D + e]; bb[e] = p.in[I_CONVB][(size_t)l * D + c + e]; }
    if (!sample) {
      const int b = tile >> 4, tt0 = (tile & 15) * 128 + tg * 8;
      const size_t rb = (size_t)b * SEQ;
      float x3[8], x2[8], x1[8], cur[8];
#pragma unroll
      for (int e = 0; e < 8; ++e) { x3[e] = 0.f; x2[e] = 0.f; x1[e] = 0.f; }
      if (tt0 > 0) {
        unpack8(*(const uint4*)(P + (rb + tt0 - 3) * NPJ + C_XC + c), x3);
        unpack8(*(const uint4*)(P + (rb + tt0 - 2) * NPJ + C_XC + c), x2);
        unpack8(*(const uint4*)(P + (rb + tt0 - 1) * NPJ + C_XC + c), x1);
      }
#pragma unroll
      for (int i = 0; i < 8; ++i) {
        unpack8(ldnt16(P + (rb + tt0 + i) * NPJ + C_XC + c), cur);
        float xc[8];
#pragma unroll
        for (int e = 0; e < 8; ++e) xc[e] = bb[e] + w0[e] * x3[e] + w1[e] * x2[e] + w2[e] * x1[e] + w3[e] * cur[e];
        *(uint4*)(sX + (tg * 8 + i) * 264 + cg8 * 8) = pack8(xc);
        if ((tile & 15) == 15 && tg == 15 && i >= 5) {
          float* o = p.out + O_CONVP + (((size_t)l * 8 + b) * 3 + (i - 5)) * D + c;
          *(float4*)o = float4{cur[0], cur[1], cur[2], cur[3]};
          *(float4*)(o + 4) = float4{cur[4], cur[5], cur[6], cur[7]};
        }
#pragma unroll
        for (int e = 0; e < 8; ++e) { x3[e] = x2[e]; x2[e] = x1[e]; x1[e] = cur[e]; }
      }
    } else {
#pragma unroll
      for (int q = 0; q < 2; ++q) {
        const int bbi = tile * 32 + tg * 2 + q;
        const float* cb = p.in[I_SCONV] + ((size_t)l * 128 + bbi) * 3 * D + c;
        float x3[8], x2[8], x1[8], cur[8];
#pragma unroll
        for (int e = 0; e < 8; ++e) { x3[e] = cb[e]; x2[e] = cb[D + e]; x1[e] = cb[2 * D + e]; }
#pragma unroll
        for (int i = 0; i < 4; ++i) {
          unpack8(*(const uint4*)(P + ((size_t)NPR + bbi * 4 + i) * NPJ + C_XC + c), cur);
          float xc[8];
#pragma unroll
          for (int e = 0; e < 8; ++e) xc[e] = bb[e] + w0[e] * x3[e] + w1[e] * x2[e] + w2[e] * x1[e] + w3[e] * cur[e];
          *(uint4*)(sX + (tg * 8 + q * 4 + i) * 264 + cg8 * 8) = pack8(xc);
          if (i >= 1) {
            float* o = p.out + O_CONVS + (((size_t)l * 128 + bbi) * 3 + (i - 1)) * D + c;
            *(float4*)o = float4{cur[0], cur[1], cur[2], cur[3]};
            *(float4*)(o + 4) = float4{cur[4], cur[5], cur[6], cur[7]};
          }
#pragma unroll
          for (int e = 0; e < 8; ++e) { x3[e] = x2[e]; x2[e] = x1[e]; x1[e] = cur[e]; }
        }
      }
    }
  }
  f32x4 racc[8][2], iacc[8][2];
  lru_gemm_pass(p, l, 0, cp, sX, sWt, racc);
  lru_gemm_pass(p, l, 1, cp, sX, sWt, iacc);
  const bool first = (!sample) && ((tile & 15) == 0);
#pragma unroll
  for (int n = 0; n < 2; ++n) {
    const int jl = wid * 32 + n * 16 + fr, c = cp * 256 + jl;
    const float bav = p.in[I_BA][(size_t)l * D + c], bxv = p.in[I_BX][(size_t)l * D + c];
    const float ls8 = 8.f * logsig(p.in[I_LAM][(size_t)l * D + c]);
#pragma unroll
    for (int m = 0; m < 8; ++m) {
      int mo = m * 16 + fq * 4;
      asm volatile("" : "+v"(mo));
#pragma unroll
      for (int r = 0; r < 4; ++r) {
        const int t = mo + r;
        const float rg = sigm(racc[m][n][r] + bav), ig = sigm(iacc[m][n][r] + bxv);
        const float av = __expf(ls8 * rg);
        float mult = __builtin_amdgcn_sqrtf(fmaxf(1.f - av * av, 0.f));
        if (first && t == 0) mult = 1.f;
        racc[m][n][r] = av;
        iacc[m][n][r] = mult * ig * bf2f(sX[t * 264 + jl]);
      }
    }
  }
  if (sample) {
    bf16_t* Y2 = (bf16_t*)(p.ws + W_Y) + (size_t)2 * MT * D;
#pragma unroll
    for (int n = 0; n < 2; ++n) {
      const int c = cp * 256 + wid * 32 + n * 16 + fr;
#pragma unroll
      for (int m = 0; m < 8; ++m) {
        int bbi = tile * 32 + m * 4 + fq;
        asm volatile("" : "+v"(bbi));
        float hh = p.in[I_SH][((size_t)l * 128 + bbi) * D + c];
#pragma unroll
        for (int r = 0; r < 4; ++r) {
          hh = racc[m][n][r] * hh + iacc[m][n][r];
          const size_t row = (size_t)NPR + bbi * 4 + r;
          const float z = bf2f(P[row * NPJ + C_ZC + c]);
          __hip_atomic_store(Y2 + row * D + c, f2bf(hh * silu(z)), __ATOMIC_RELAXED, __HIP_MEMORY_SCOPE_AGENT);
        }
        p.out[O_HS + ((size_t)l * 128 + bbi) * D + c] = hh;
      }
    }
  } else {
    bf16_t* LH = (bf16_t*)(p.ws + W_LH);
    bf16_t* LA = (bf16_t*)(p.ws + W_LA);
    const size_t rb = (size_t)(tile >> 4) * SEQ + (tile & 15) * 128;
#pragma unroll
    for (int n = 0; n < 2; ++n) {
      const int c = cp * 256 + wid * 32 + n * 16 + fr;
      float cA = 1.f, cH = 0.f;
#pragma unroll
      for (int m = 0; m < 8; ++m) {
        int mo = m * 16 + fq * 4;
        asm volatile("" : "+v"(mo));
        float la_[4], lh_[4];
        la_[0] = racc[m][n][0]; lh_[0] = iacc[m][n][0];
#pragma unroll
        for (int r = 1; r < 4; ++r) { la_[r] = la_[r - 1] * racc[m][n][r]; lh_[r] = racc[m][n][r] * lh_[r - 1] + iacc[m][n][r]; }
        float A = la_[3], H = lh_[3];
        float pA = SHU(A, 16), pH = SHU(H, 16);
        if (fq >= 1) { H = A * pH + H; A = A * pA; }
        pA = SHU(A, 32); pH = SHU(H, 32);
        if (fq >= 2) { H = A * pH + H; A = A * pA; }
        float eA = SHU(A, 16), eH = SHU(H, 16);
        if (fq == 0) { eA = 1.f; eH = 0.f; }
        const float tA = shf(A, 48 + fr), tH = shf(H, 48 + fr);
        const float PA = cA * eA, PH = eA * cH + eH;
#pragma unroll
        for (int r = 0; r < 4; ++r) {
          const size_t row = rb + mo + r;
          LA[row * D + c] = f2bf(PA * la_[r]);
          LH[row * D + c] = f2bf(la_[r] * PH + lh_[r]);
        }
        cH = tA * cH + tH;
        cA = cA * tA;
      }
      if (fq == 0) {
        float* LE = (float*)(p.ws + W_LE) + ((size_t)tile * D + c) * 2;
        LE[0] = cA; LE[1] = cH;
      }
    }
  }
  __syncthreads();
}

__device__ __forceinline__ void lru_fix(const Params& p, int l, int tile, int half) {
  const int tid = otid(), c = tid * 2;
  const int b = tile >> 4, seg = tile & 15;
  const float* LE = (const float*)(p.ws + W_LE);
  float H0 = 0.f, H1 = 0.f;
  for (int k = 0; k < seg; ++k) {
    const float4 e = *(const float4*)(LE + ((size_t)(b * 16 + k) * D + c) * 2);
    H0 = e.x * H0 + e.y;
    H1 = e.z * H1 + e.w;
  }
  const bf16_t* P = (const bf16_t*)(p.ws + W_P);
  const bf16_t* LH = (const bf16_t*)(p.ws + W_LH);
  const bf16_t* LA = (const bf16_t*)(p.ws + W_LA);
  bf16_t* Y2 = (bf16_t*)(p.ws + W_Y) + (size_t)2 * MT * D;
  const size_t R0 = (size_t)b * SEQ + seg * 128 + half * 64;
#pragma unroll 8
  for (int rr = 0; rr < 64; ++rr) {
    const size_t row = R0 + rr;
    const unsigned hl = ldnt4(LH + row * D + c);
    const unsigned al = ldnt4(LA + row * D + c);
    const unsigned zv = ldnt4(P + row * NPJ + C_ZC + c);
    const float h0 = bflo(hl) + bflo(al) * H0, h1 = bfhi(hl) + bfhi(al) * H1;
    *(unsigned*)(Y2 + row * D + c) = pk2(h0 * silu(bflo(zv)), h1 * silu(bfhi(zv)));
  }
  if (seg == 15 && half == 1) {
    const float4 e = *(const float4*)(LE + ((size_t)(b * 16 + 15) * D + c) * 2);
    float2 o = {e.x * H0 + e.y, e.z * H1 + e.w};
    *(float2*)(p.out + O_HP + ((size_t)l * 8 + b) * D + c) = o;
  }
}

__device__ __forceinline__ void x4_unit(const Params& p, int l, int pm, int pn, char* smem) {
  float* MF = (float*)(p.ws + W_MF);
  bf16_t* MB = (bf16_t*)(p.ws + W_MB);
  const bf16_t* const P = (const bf16_t*)(p.ws + W_P);
#pragma unroll 1
  for (int br = 0; br < 3; ++br) {
    const bf16_t* A = (const bf16_t*)(p.ws + W_Y) + (size_t)br * MT * D;
    const bf16_t* Bt = (const bf16_t*)(p.ws + W_WTP) + (size_t)(l * 4 + br) * D * D;
    f32x4 acc[2][2][4][2];
    gemm_tile(A, Bt, pm * 256, pn * 256, smem, acc);
    EPI_IDX
    EPI_LOOP {
      const int row = pm * 256 + ai * 128 + wr * 64 + m * 16 + fr, col = pn * 256 + bj * 128 + wc * 32 + n * 16 + fq * 4;
      const uint2 gv = *(const uint2*)(P + (size_t)row * NPJ + C_GA + br * 1024 + col);
      float4 v = {acc[ai][bj][m][n][0] * sigm(bflo(gv.x)), acc[ai][bj][m][n][1] * sigm(bfhi(gv.x)),
                  acc[ai][bj][m][n][2] * sigm(bflo(gv.y)), acc[ai][bj][m][n][3] * sigm(bfhi(gv.y))};
      uint2* mf = (uint2*)((bf16_t*)MF + (size_t)row * D + col);
      if (br == 0) {
        uint2 ob; ob.x = pk2(v.x, v.y); ob.y = pk2(v.z, v.w); *mf = ob;
      } else {
        const uint2 o = *mf;
        v.x += bflo(o.x); v.y += bfhi(o.x); v.z += bflo(o.y); v.w += bfhi(o.y);
        uint2 ob; ob.x = pk2(v.x, v.y); ob.y = pk2(v.z, v.w);
        if (br == 1) *mf = ob;
        else *(uint2*)(MB + (size_t)row * D + col) = ob;
      }
    }
  }
}
__device__ __forceinline__ void x5_unit(const Params& p, int l, int pm, int pn, char* smem) {
  const bf16_t* A = (const bf16_t*)(p.ws + W_MB);
  const bf16_t* Bt = (const bf16_t*)(p.ws + W_WTP) + (size_t)(l * 4 + 3) * D * D;
  float* PRE = (float*)(p.ws + W_PRE);
  const float* XF = (const float*)(p.ws + W_XF);
  f32x4 acc[2][2][4][2];
  gemm_tile(A, Bt, pm * 256, pn * 256, smem, acc);
  EPI_IDX
  EPI_LOOP {
    const int row = pm * 256 + ai * 128 + wr * 64 + m * 16 + fr, col = pn * 256 + bj * 128 + wc * 32 + n * 16 + fq * 4;
    const float* xr = (l == 0) ? (row < NPR ? p.in[I_XP] + (size_t)row * D : p.in[I_XS] + (size_t)(row - NPR) * D)
                               : XF + (size_t)row * D;
    const float4 xv = *(const float4*)(xr + col);
    float4 v = {ALPHA * xv.x + acc[ai][bj][m][n][0], ALPHA * xv.y + acc[ai][bj][m][n][1],
                ALPHA * xv.z + acc[ai][bj][m][n][2], ALPHA * xv.w + acc[ai][bj][m][n][3]};
    *(float4*)(PRE + (size_t)row * D + col) = v;
  }
}
__device__ __forceinline__ void dep_signal(unsigned* ctr) {
  asm volatile("s_waitcnt vmcnt(0)" ::: "memory");
  __syncthreads();
  if (threadIdx.x == 0) {
    __builtin_amdgcn_fence(__ATOMIC_RELEASE, "agent");
    asm volatile("s_waitcnt vmcnt(0)" ::: "memory");
    (void)__hip_atomic_fetch_add(ctr, 1u, __ATOMIC_RELAXED, __HIP_MEMORY_SCOPE_AGENT);
  }
}
__device__ __forceinline__ void dep_signal_wt(unsigned* ctr) {
  asm volatile("s_waitcnt vmcnt(0)" ::: "memory");
  __syncthreads();
  if (threadIdx.x == 0) (void)__hip_atomic_fetch_add(ctr, 1u, __ATOMIC_RELAXED, __HIP_MEMORY_SCOPE_AGENT);
}
__device__ __forceinline__ void dep_wait(unsigned* ctr, unsigned target) {
  if (threadIdx.x == 0) {
    unsigned sp = 0;
    while (__hip_atomic_load(ctr, __ATOMIC_RELAXED, __HIP_MEMORY_SCOPE_AGENT) < target) {
      __builtin_amdgcn_s_sleep(2);
      if (++sp > (1u << 24)) break;
    }
    __builtin_amdgcn_fence(__ATOMIC_ACQUIRE, "agent");
    asm volatile("s_waitcnt vmcnt(0)" ::: "memory");
  }
  __syncthreads();
}

#define XB_TMO 128
#define XB_XCNT(j) (256 + 64 * (j))
#define XB_XSUB(j) (1280 + 64 * (j))
#define XB_XGEN(j) (2304 + 64 * (j))
#define XB_TOP 3328
#define XB_TOPGEN 3392
#define XCD_BAR_WORDS 3456
#define XB_SPIN_CAP (1u << 22)
__device__ __forceinline__ unsigned xb_ld(unsigned* p) { return __hip_atomic_load(p, __ATOMIC_RELAXED, __HIP_MEMORY_SCOPE_AGENT); }
__device__ __forceinline__ unsigned xb_add(unsigned* p, unsigned v) { return __hip_atomic_fetch_add(p, v, __ATOMIC_RELAXED, __HIP_MEMORY_SCOPE_AGENT); }
__device__ __forceinline__ unsigned xb_xcc_id() { return (unsigned)__builtin_amdgcn_s_getreg((3 << 11) | 20) & 0xFu; }
#define XB_SPIN(cond, bar) do { unsigned _sp = 0; while (cond) { __builtin_amdgcn_s_sleep(1); \
    if ((++_sp & 255u) == 0u) { if (xb_ld(&(bar)[XB_TMO])) break; if (_sp > XB_SPIN_CAP) { atomicAdd(&(bar)[XB_TMO], 1u); break; } } } } while (0)
struct XcdBarrier { unsigned* bar; unsigned x; volatile LDSP(unsigned) st; };
__device__ __forceinline__ XcdBarrier xcd_barrier_post(unsigned* bar, volatile LDSP(unsigned) st) {
  XcdBarrier b; b.bar = bar; b.x = xb_xcc_id(); b.st = st;
  if (threadIdx.x == 0) (void)xb_add(&bar[XB_XCNT(b.x)], 1u);
  return b;
}
__device__ __forceinline__ void xcd_barrier_complete(unsigned* bar, unsigned x, unsigned& nloc, unsigned& nx) {
  const unsigned G = gridDim.x * gridDim.y * gridDim.z;
  unsigned sum, cnt, mine, sp = 0u;
  for (;;) {
    sum = 0u; cnt = 0u; mine = 0u;
#pragma unroll
    for (unsigned j = 0; j < 16; ++j) { const unsigned c = xb_ld(&bar[XB_XCNT(j)]); sum += c; cnt += (c > 0u) ? 1u : 0u; mine = (j == x) ? c : mine; }
    if (sum == G) break;
    __builtin_amdgcn_s_sleep(1);
    if ((++sp & 255u) == 0u) { if (xb_ld(&bar[XB_TMO])) break; if (sp > XB_SPIN_CAP) { atomicAdd(&bar[XB_TMO], 1u); break; } }
  }
  nloc = mine > 0u ? mine : 1u; nx = cnt > 0u ? cnt : 1u;
}
__device__ __forceinline__ void xcd_barrier(const XcdBarrier& b) {
  asm volatile("s_waitcnt vmcnt(0)" ::: "memory");
  __syncthreads();
  if (threadIdx.x == 0) {
    unsigned* bar = b.bar;
    __builtin_amdgcn_s_waitcnt(0);
    unsigned nloc = b.st[0], nx = b.st[1];
    if (nloc == 0u) { xcd_barrier_complete(bar, b.x, nloc, nx); b.st[0] = nloc; b.st[1] = nx; }
    const unsigned old = xb_add(&bar[XB_XSUB(b.x)], 1u);
    const unsigned gen = old / nloc;
    if (old + 1u == (gen + 1u) * nloc) {
      __builtin_amdgcn_fence(__ATOMIC_RELEASE, "agent");
      asm volatile("s_waitcnt vmcnt(0)" ::: "memory");
      const unsigned og = xb_add(&bar[XB_TOP], 1u);
      const unsigned tg = og / nx;
      if (og + 1u == (tg + 1u) * nx) xb_add(&bar[XB_TOPGEN], 1u);
      else XB_SPIN(xb_ld(&bar[XB_TOPGEN]) == tg, bar);
      __builtin_amdgcn_fence(__ATOMIC_ACQUIRE, "agent");
      xb_add(&bar[XB_XGEN(b.x)], 1u);
      asm volatile("s_waitcnt vmcnt(0)" ::: "memory");
    } else {
      XB_SPIN(xb_ld(&bar[XB_XGEN(b.x)]) == gen, bar);
      __builtin_amdgcn_fence(__ATOMIC_ACQUIRE, "agent");
      asm volatile("s_waitcnt vmcnt(0)" ::: "memory");
    }
  }
  __syncthreads();
}

__global__ void __launch_bounds__(512) mega(Params p) {
  extern __shared__ __attribute__((aligned(16))) char smem[];
  cg::grid_group grid = cg::this_grid();
  const int G = gridDim.x, bid = blockIdx.x;
  volatile LDSP(unsigned) xst = (volatile LDSP(unsigned))(smem + LDS_TOTAL - 16);
  if (threadIdx.x == 0) { xst[0] = 0u; xst[1] = 0u; xst[2] = 0u; xst[3] = 0u; }
  __syncthreads();
  XcdBarrier xb = xcd_barrier_post((unsigned*)(p.ws + W_BAR), xst);
  phase_convert(p, smem);
  row_pass(p, 0, smem);
  grid.sync();
#pragma unroll 1
  for (int l = 0; l < NL; ++l) {
    for (int it = bid; it < 32; it += G) mlstm_scalars(p, l, it, smem);
    REP(0) {
      const bf16_t* A = (const bf16_t*)(p.ws + W_XB);
      const bf16_t* Bt = (const bf16_t*)(p.ws + W_WTIN) + (size_t)l * NPJ * D;
      const float* bias = p.in[I_BIN] + (size_t)l * INW;
      bf16_t* const P = (bf16_t*)(p.ws + W_P);
      bool primed = false;
#pragma unroll 1
      for (int L = bid; L < 66 * 52; L += G) {
        int pm, pn; tile_map(L, 66, 52, pm, pn, 4);
        f32x4 acc[2][2][4][2];
        gemm_tile(A, Bt, pm * 256, pn * 256, smem, acc, primed);
        EPI_IDX
        float4 bvv[2][2];
#pragma unroll
        for (int bj = 0; bj < 2; ++bj)
#pragma unroll
          for (int n = 0; n < 2; ++n) {
            const int col = pn * 256 + bj * 128 + wc * 32 + n * 16 + fq * 4;
            bvv[bj][n] = *(const float4*)(bias + col + (col >= 5120 ? 8 : 0));
          }
        asm volatile("s_waitcnt vmcnt(0)" ::: "memory");
        primed = (L + G < 66 * 52);
        if (primed) { int pm2, pn2; tile_map(L + G, 66, 52, pm2, pn2, 4); gemm_tile(A, Bt, pm2 * 256, pn2 * 256, smem, acc, false, true); }
        const bool vbt = (pm < 64) && (pn >= 24) && (pn < 28);
        float st1[2][4], st2[2][4];
#pragma unroll
        for (int ai = 0; ai < 2; ++ai)
#pragma unroll
          for (int m = 0; m < 4; ++m) { st1[ai][m] = 0.f; st2[ai][m] = 0.f; }
        EPI_LOOP {
          const int row = pm * 256 + ai * 128 + wr * 64 + m * 16 + fr, col = pn * 256 + bj * 128 + wc * 32 + n * 16 + fq * 4;
          const float4 bv = bvv[bj][n];
          const float v0 = acc[ai][bj][m][n][0] + bv.x, v1 = acc[ai][bj][m][n][1] + bv.y;
          const float v2 = acc[ai][bj][m][n][2] + bv.z, v3 = acc[ai][bj][m][n][3] + bv.w;
          if (vbt) {
            st1[ai][m] += (v0 + v1) + (v2 + v3);
            st2[ai][m] += (v0 * v0 + v1 * v1) + (v2 * v2 + v3 * v3);
          }
          uint2 o;
          o.x = pk2(v0, v1);
          o.y = pk2(v2, v3);
          *(uint2*)(P + (size_t)row * NPJ + col) = o;
        }
        if (vbt) {
          float2* st = (float2*)(p.ws + W_ST) + (size_t)((pn - 24) * 4 + wc) * NPR;
#pragma unroll
          for (int ai = 0; ai < 2; ++ai)
#pragma unroll
            for (int m = 0; m < 4; ++m) {
              float s1 = st1[ai][m], s2 = st2[ai][m];
              s1 += SHX(s1, 16); s1 += SHX(s1, 32);
              s2 += SHX(s2, 16); s2 += SHX(s2, 32);
              if (fq == 0) st[pm * 256 + ai * 128 + wr * 64 + m * 16 + fr] = float2{s1, s2};
            }
        }
      }
    }
    GSYNC;
    {
      constexpr int Q_S = 656, Q_X4 = Q_S + 8, Q_F1 = Q_X4 + 256, Q_X5 = Q_F1 + 8, Q_FN = Q_X5 + 128, Q_F2 = Q_FN + 128, Q_LR = Q_F2 + 512,
                    Q_F3 = Q_LR + 128, Q_G2 = Q_F3 + 512;
      unsigned* qbase = (unsigned*)(p.ws + W_QCT) + l * 64;
      volatile LDSP(int) qslot = (volatile LDSP(int))(smem + LDS_TOTAL - 32);
      if (threadIdx.x == 0) qslot[0] = (int)xb_add(qbase, 1u);
      __syncthreads();
      int it = qslot[0];
#pragma unroll 1
      while (it < Q_G2) {
        __syncthreads();
        int nxt = 0;
        int r = it, fq_ = -1, fbh = 0;
        if (r >= Q_X4 && r < Q_F1) { fq_ = 15 - ((r - Q_X4) >> 5); fbh = (r - Q_X4) & 31; }
        else if (r >= Q_FN && r < Q_F2) { fq_ = 7 - ((r - Q_FN) >> 5); fbh = (r - Q_FN) & 31; }
        else if (r >= Q_LR && r < Q_F3) { fq_ = 3 - ((r - Q_LR) >> 5); fbh = (r - Q_LR) & 31; }
        if (fq_ < 0 && threadIdx.x == 0) nxt = (int)xb_add(qbase, 1u);
        if (fq_ >= 0) { mlstm_flash(p, l, fbh, fq_, smem); if (threadIdx.x == 0) nxt = (int)xb_add(qbase, 1u); }
        else if (r < Q_S) {
          if (r < 512) mlstm_sample(p, l, r >> 2, r & 3, smem);
          else if (r < 640) gmlp_sample(p, l, r - 512, smem);
          else lru_tile(p, l, (r - 640) >> 2, r & 3, true, smem);
          dep_signal_wt(qbase + 16);
        }
        else if (r < Q_X4) { r -= Q_S; dep_wait(qbase + 16, 656u); x4_unit(p, l, 64 + (r >> 2), r & 3, smem); dep_signal(qbase + 32 + 16 * (r >> 2)); }
        else if (r < Q_X5) { r -= Q_F1; dep_wait(qbase + 32 + 16 * (r >> 2), 4u); x5_unit(p, l, 64 + (r >> 2), r & 3, smem); }
        else if (r < Q_FN) { r -= Q_X5; mlstm_final(p, l, r >> 2, r & 3, smem); }
        else if (r < Q_LR) { r -= Q_F2; lru_tile(p, l, r >> 2, r & 3, false, smem); }
        else { r -= Q_F3; gmlp_prompt(p, l, r >> 6, (r >> 2) & 15, r & 3, smem); }
        if (threadIdx.x == 0) qslot[0] = nxt;
        __syncthreads();
        it = qslot[0];
      }
    }
    GSYNC;
    for (int it = bid; it < 256; it += G) lru_fix(p, l, it >> 1, it & 1);
    GSYNC;
#pragma unroll 1
    for (int L = bid; L < 64 * 4; L += G) { int pm, pn; tile_map(L, 64, 4, pm, pn); x4_unit(p, l, pm, pn, smem); }
    GSYNC;
#pragma unroll 1
    for (int L = bid; L < 64 * 4; L += G) { int pm, pn; tile_map(L, 64, 4, pm, pn); x5_unit(p, l, pm, pn, smem); }
    GSYNC;
    row_pass(p, l + 1, smem);
    GSYNC;
  }
}

extern "C" void kernel_launch(void* const* d_in, const int* in_sizes, int n_in, void* d_out, int out_size, void* d_ws,
                              size_t ws_size, hipStream_t stream) {
  constexpr size_t kLds = LDS_TOTAL;
  static int grid_blocks = 0;
  if (!grid_blocks) {
    int dev = 0, cus = 0, per_cu = 0;
    (void)hipGetDevice(&dev);
    (void)hipDeviceGetAttribute(&cus, hipDeviceAttributeMultiprocessorCount, dev);
    (void)hipFuncSetAttribute((const void*)mega, hipFuncAttributeMaxDynamicSharedMemorySize, (int)kLds);
    (void)hipOccupancyMaxActiveBlocksPerMultiprocessor(&per_cu, (const void*)mega, 512, kLds);
    if (per_cu < 1) per_cu = 1;
    grid_blocks = cus * per_cu;
    if (grid_blocks % 8) grid_blocks -= grid_blocks % 8;
    if (ws_size < W_END || n_in != 27 || (size_t)out_size != O_END)
      fprintf(stderr, "kernel_launch: unexpected sizes ws %zu (need %zu) n_in %d out %d (expect %zu)\n", ws_size,
              (size_t)W_END, n_in, out_size, (size_t)O_END);
  }
  (void)hipMemsetAsync((char*)d_ws + W_BAR, 0, W_CTL_END - W_BAR, stream);
  Params p{};
  for (int i = 0; i < 27; ++i) p.in[i] = (const float*)d_in[i];
  p.out = (float*)d_out;
  p.ws = (char*)d_ws;
  void* args[] = {&p};
  hipError_t e = hipLaunchCooperativeKernel((const void*)mega, dim3(grid_blocks), dim3(512), args, kLds, stream);
  if (e != hipSuccess) fprintf(stderr, "cooperative launch failed: %s (grid %d)\n", hipGetErrorString(e), grid_blocks);
}
```
